# Optimizing an MI355X kernel written in HIP

```python
import jax, jax.numpy as jnp
from jax import lax
import numpy as np

D_MODEL = 1024
BATCH = 32
SEQ = 2048
DEPTH = 4

N_MIXERS = 3
N_MOD = 9
D_FF = 2816
EPS = 1e-6
RG_WIDTH = D_MODEL
RG_HEADS = 8
RG_BLOCK = RG_WIDTH // RG_HEADS
CONV_WIDTH = 4
RG_C = 8.0
HG_EXPAND = 128
HG_HEADS = D_MODEL // HG_EXPAND
GLA_HEADS = 4
GLA_KEY_DIM = D_MODEL // 2
GLA_VAL_DIM = D_MODEL
GLA_DK = GLA_KEY_DIM // GLA_HEADS
GLA_DV = GLA_VAL_DIM // GLA_HEADS
GLA_RANK = 16
GLA_LOGIT_NORM = 16.0
GLA_IN = 2 * GLA_KEY_DIM + 2 * GLA_VAL_DIM + GLA_RANK
CHUNK = 16

N_RG = len(range(0, DEPTH, N_MIXERS))
N_HG = len(range(1, DEPTH, N_MIXERS))
N_GLA = len(range(2, DEPTH, N_MIXERS))

kernel_name = 'hybrid_rglru_hgrn2_gla_macaron_adaln'


def rmsnorm(x, w):
    x32 = x.astype(jnp.float32)
    y = x32 * lax.rsqrt(jnp.mean(x32 * x32, axis=-1, keepdims=True) + EPS)
    return y.astype(x.dtype) * w


def modulate(h, shift, scale):
    return h * (1.0 + scale[:, None, :]) + shift[:, None, :]


def swiglu(h, w13, w2):
    gate, up = jnp.split(h @ w13, 2, axis=-1)
    return (jax.nn.silu(gate) * up) @ w2


def chunk_gla(q, k, v, log_f, scale):
    B, S, H, DK = q.shape
    DV = v.shape[-1]
    n = S // CHUNK

    def blocks(t):
        return t.astype(jnp.float32).reshape(B, n, CHUNK, H, t.shape[-1]).transpose(1, 0, 3, 2, 4)

    qb = blocks(q) * scale
    kb, vb = blocks(k), blocks(v)
    bcum = jnp.cumsum(blocks(log_f), axis=3)
    causal = jnp.tril(jnp.ones((CHUNK, CHUNK), bool))[:, :, None]

    def step(state, inp):
        q_c, k_c, v_c, b_c = inp
        o_inter = jnp.einsum('bhik,bhkv->bhiv', q_c * jnp.exp(b_c), state)
        rel = jnp.where(causal, b_c[:, :, :, None, :] - b_c[:, :, None, :, :], -jnp.inf)
        scores = jnp.einsum('bhik,bhjk,bhijk->bhij', q_c, k_c, jnp.exp(rel))
        o = o_inter + jnp.einsum('bhij,bhjv->bhiv', scores, v_c)
        b_last = b_c[:, :, -1:, :]
        state = (jnp.exp(b_last[:, :, 0, :, None]) * state
                 + jnp.einsum('bhjk,bhjv->bhkv', k_c * jnp.exp(b_last - b_c), v_c))
        return state, o

    state0 = jnp.zeros((B, H, DK, DV), jnp.float32)
    _, ob = lax.scan(step, state0, (qb, kb, vb, bcum))
    return ob.transpose(1, 0, 3, 2, 4).reshape(B, S, H, DV).astype(v.dtype)


def rglru_mixer(h, w_in, conv_w, conv_b, gate_w, gate_b, lam, w_out):
    B, S, _ = h.shape
    y_br, x_br = jnp.split(h @ w_in, 2, axis=-1)
    y_br = jax.nn.gelu(y_br)
    xp = jnp.pad(x_br, ((0, 0), (CONV_WIDTH - 1, 0), (0, 0)))
    xc = sum((xp[:, j:j + S] * conv_w[j] for j in range(CONV_WIDTH)), conv_b)
    xh = xc.reshape(B, S, RG_HEADS, RG_BLOCK)
    gates = jnp.einsum('bshi,hij->bshj', xh, gate_w) + gate_b
    gate_x, gate_a = jnp.split(gates.astype(jnp.float32), 2, axis=-1)
    gate_x = jax.nn.sigmoid(gate_x).reshape(B, S, RG_WIDTH)
    gate_a = jax.nn.sigmoid(gate_a).reshape(B, S, RG_WIDTH)
    log_a = -RG_C * gate_a * jax.nn.softplus(-lam.astype(jnp.float32))
    a = jnp.exp(log_a)
    mult = jnp.sqrt(-jnp.expm1(2.0 * log_a))
    mult = jnp.where(jnp.arange(S)[None, :, None] == 0, 1.0, mult)
    u = gate_x * xc.astype(jnp.float32) * mult

    def step(hc, inp):
        a_t, u_t = inp
        hn = a_t * hc + u_t
        return hn, hn

    _, hs = lax.scan(step, jnp.zeros((B, RG_WIDTH), jnp.float32),
                     (a.transpose(1, 0, 2), u.transpose(1, 0, 2)))
    hs = hs.transpose(1, 0, 2).astype(h.dtype)
    return (hs * y_br) @ w_out


def hgrn2_mixer(h, w_in, lb, norm_w, w_out):
    B, S, _ = h.shape
    q, fz, i_in, g = jnp.split(h @ w_in, 4, axis=-1)
    fz32 = fz.astype(jnp.float32)
    lb = lb.astype(jnp.float32)
    log_f = jnp.logaddexp(jnp.log(lb), jnp.log1p(-lb) + jax.nn.log_sigmoid(fz32))
    k = (1.0 - lb) * jax.nn.sigmoid(-fz32)
    heads = lambda t: t.reshape(B, S, HG_HEADS, HG_EXPAND)
    o = chunk_gla(heads(q), heads(k), heads(i_in), heads(log_f), 1.0)
    o = rmsnorm(o.reshape(B, S, D_MODEL), norm_w) * jax.nn.sigmoid(g)
    return o @ w_out


def gla_mixer(h, w_in, gate_w2, gate_b, norm_w, w_out):
    B, S, _ = h.shape
    q, k, v, g, a_low = jnp.split(
        h @ w_in,
        [GLA_KEY_DIM, 2 * GLA_KEY_DIM, 2 * GLA_KEY_DIM + GLA_VAL_DIM, 2 * GLA_KEY_DIM + 2 * GLA_VAL_DIM],
        axis=-1)
    log_a = jax.nn.log_sigmoid((a_low @ gate_w2 + gate_b).astype(jnp.float32)) / GLA_LOGIT_NORM
    kh = lambda t: t.reshape(B, S, GLA_HEADS, GLA_DK)
    vh = lambda t: t.reshape(B, S, GLA_HEADS, GLA_DV)
    o = chunk_gla(kh(q), kh(k), vh(v), kh(log_a), GLA_DK ** -0.5)
    o = rmsnorm(o, norm_w) * jax.nn.silu(vh(g))
    return o.reshape(B, S, GLA_VAL_DIM) @ w_out


def setup_inputs(seed: int = 0) -> dict:
    key = jax.random.key(seed)
    ks = jax.random.split(key, 24)
    nrm = lambda k, shape, s: jax.random.normal(k, shape, jnp.float32) * s
    u = jax.random.uniform(ks[13], (N_RG, RG_WIDTH), jnp.float32)
    a8 = 0.9 + 0.099 * u
    s = a8 ** (1.0 / RG_C)
    rg_lambda = jnp.log(s) - jnp.log1p(-s)
    return {
        'x': nrm(ks[0], (BATCH, SEQ, D_MODEL), 1.0),
        'c': nrm(ks[1], (BATCH, D_MODEL), 1.0),
        'ada_w': nrm(ks[2], (DEPTH, D_MODEL, N_MOD * D_MODEL), 0.5 * D_MODEL ** -0.5),
        'ada_b': nrm(ks[3], (DEPTH, N_MOD * D_MODEL), 0.01),
        'norm_w': 1.0 + nrm(ks[4], (DEPTH, 3, D_MODEL), 0.02),
        'final_norm_w': 1.0 + nrm(ks[5], (D_MODEL,), 0.02),
        'ffn_w13': nrm(ks[6], (DEPTH, 2, D_MODEL, 2 * D_FF), D_MODEL ** -0.5),
        'ffn_w2': nrm(ks[7], (DEPTH, 2, D_FF, D_MODEL), D_FF ** -0.5),
        'rg_w_in': nrm(ks[8], (N_RG, D_MODEL, 2 * RG_WIDTH), D_MODEL ** -0.5),
        'rg_conv_w': nrm(ks[9], (N_RG, CONV_WIDTH, RG_WIDTH), CONV_WIDTH ** -0.5),
        'rg_conv_b': nrm(ks[10], (N_RG, RG_WIDTH), 0.01),
        'rg_gate_w': nrm(ks[11], (N_RG, RG_HEADS, RG_BLOCK, 2 * RG_BLOCK), RG_BLOCK ** -0.5),
        'rg_gate_b': nrm(ks[12], (N_RG, RG_HEADS, 2 * RG_BLOCK), 0.01),
        'rg_lambda': rg_lambda,
        'rg_w_out': nrm(ks[14], (N_RG, RG_WIDTH, D_MODEL), RG_WIDTH ** -0.5),
        'hg_w_in': nrm(ks[15], (N_HG, D_MODEL, 4 * D_MODEL), D_MODEL ** -0.5),
        'hg_lb_logits': nrm(ks[16], (DEPTH, D_MODEL), 0.1),
        'hg_norm_w': 1.0 + nrm(ks[17], (N_HG, D_MODEL), 0.02),
        'hg_w_out': nrm(ks[18], (N_HG, D_MODEL, D_MODEL), D_MODEL ** -0.5),
        'gla_w_in': nrm(ks[19], (N_GLA, D_MODEL, GLA_IN), D_MODEL ** -0.5),
        'gla_gate_w2': nrm(ks[20], (N_GLA, GLA_RANK, GLA_KEY_DIM), GLA_RANK ** -0.5),
        'gla_gate_b': nrm(ks[21], (N_GLA, GLA_KEY_DIM), 0.01),
        'gla_norm_w': 1.0 + nrm(ks[22], (N_GLA, GLA_DV), 0.02),
        'gla_w_out': nrm(ks[23], (N_GLA, GLA_VAL_DIM, D_MODEL), GLA_VAL_DIM ** -0.5),
    }


def reference(x, c, ada_w, ada_b, norm_w, final_norm_w, ffn_w13, ffn_w2,
              rg_w_in, rg_conv_w, rg_conv_b, rg_gate_w, rg_gate_b, rg_lambda, rg_w_out,
              hg_w_in, hg_lb_logits, hg_norm_w, hg_w_out,
              gla_w_in, gla_gate_w2, gla_gate_b, gla_norm_w, gla_w_out):
    c_act = jax.nn.silu(c)
    p = jax.nn.softmax(hg_lb_logits.astype(jnp.float32), axis=0)
    lower_bounds = jnp.cumsum(p, axis=0) - p[0]
    i_rg = i_hg = i_gla = 0
    for l in range(DEPTH):
        mod = c_act @ ada_w[l] + ada_b[l]
        sh1, sc1, g1, sh2, sc2, g2, sh3, sc3, g3 = jnp.split(mod, N_MOD, axis=-1)
        h = modulate(rmsnorm(x, norm_w[l, 0]), sh1, sc1)
        x = x + 0.5 * g1[:, None, :] * swiglu(h, ffn_w13[l, 0], ffn_w2[l, 0])
        h = modulate(rmsnorm(x, norm_w[l, 1]), sh2, sc2)
        m = l % N_MIXERS
        if m == 0:
            y = rglru_mixer(h, rg_w_in[i_rg], rg_conv_w[i_rg], rg_conv_b[i_rg], rg_gate_w[i_rg],
                            rg_gate_b[i_rg], rg_lambda[i_rg], rg_w_out[i_rg])
            i_rg += 1
        elif m == 1:
            y = hgrn2_mixer(h, hg_w_in[i_hg], lower_bounds[l], hg_norm_w[i_hg], hg_w_out[i_hg])
            i_hg += 1
        else:
            y = gla_mixer(h, gla_w_in[i_gla], gla_gate_w2[i_gla], gla_gate_b[i_gla],
                          gla_norm_w[i_gla], gla_w_out[i_gla])
            i_gla += 1
        x = x + g2[:, None, :] * y
        h = modulate(rmsnorm(x, norm_w[l, 2]), sh3, sc3)
        x = x + 0.5 * g3[:, None, :] * swiglu(h, ffn_w13[l, 1], ffn_w2[l, 1])
    return rmsnorm(x, final_norm_w)
```

```cpp
#include <hip/hip_runtime.h>
#include <cstdio>
#include <cstdint>
#include <cmath>
#ifndef MK_N_LAUNCHES
#define MK_N_LAUNCHES 1
#endif
namespace pg8 {
#define PG8_LAS __attribute__((address_space(3)))
typedef unsigned short bf16_t;
typedef short bf16x8 __attribute__((ext_vector_type(8)));
typedef float f32x4 __attribute__((ext_vector_type(4)));
typedef unsigned u32x4 __attribute__((ext_vector_type(4)));
constexpr int BM = 256, BK = 64, HALF = 128, HTB = HALF * BK * 2  , STAGE_BYTES = 8 * HTB, NXCD = 8, WGM = 8;

__host__ __device__ __forceinline__ int lds_byte(int r, int c) { const int st = (r >> 4) * 2 + (c >> 5), rr = r & 15, cc = c & 31, ob = rr * 64 + cc * 2; return st * 1024 + (ob ^ (((ob >> 9) & 1) << 5)); }
__host__ __device__ __forceinline__ void stage_rc(int b, int& R, int& C) { const int st = b / 1024, sb = b % 1024, swz = sb ^ (((sb >> 9) & 1) << 5); R = (st >> 1) * 16 + swz / 64; C = (st & 1) * 32 + (swz % 64) / 2; }
__host__ __device__ __forceinline__ int perm32(int rho) { const int n = rho >> 4, i = rho & 15; return 8 * (i >> 2) + 4 * n + (i & 3); }

struct Unit { int pm, pn; };
struct Gemm { const bf16_t* A; const bf16_t* Bt; int M, N, K; };

struct StaticOrder {
    int nM, nN, nwg, G, c;
    __host__ __device__ void init(int M, int N, int G_, int c_) { nM = M / BM; nN = N / BM; nwg = nM * nN; G = G_; c = c_; }
    __host__ __device__ bool next(int i, Unit& u) const {
        const long L = (long)i * G + c; if (L >= nwg) return false;
        int wgid = (int)L; { const int q = nwg / NXCD, r = nwg % NXCD, xcd = wgid % NXCD, off = wgid / NXCD; wgid = (xcd < r ? xcd * (q + 1) : r * (q + 1) + (xcd - r) * q) + off; }
        const int nig = WGM * nN, gid = wgid / nig, fm = gid * WGM, gsz = (nM - fm) < WGM ? (nM - fm) : WGM;
        u.pm = fm + ((wgid % nig) % gsz); u.pn = (wgid % nig) / gsz; return true;
    }
    __device__ __forceinline__ void a_ready(const Unit&) const {}
    __device__ __forceinline__ void done(const Unit&) const {}
};

typedef float f32x2_t __attribute__((ext_vector_type(2))); typedef __bf16 bf16x2_t __attribute__((ext_vector_type(2)));
__device__ __forceinline__ unsigned cvt_pk_bf16(float lo, float hi) { const f32x2_t v = {lo, hi}; const bf16x2_t b = __builtin_convertvector(v, bf16x2_t); return __builtin_bit_cast(unsigned, b); }
__device__ __forceinline__ u32x4 pack8(const f32x4 a, const f32x4 b) { u32x4 w; w.x = cvt_pk_bf16(a[0], a[1]); w.y = cvt_pk_bf16(a[2], a[3]); w.z = cvt_pk_bf16(b[0], b[1]); w.w = cvt_pk_bf16(b[2], b[3]); return w; }
__device__ __forceinline__ float fast_sigmoid(float x) { return __builtin_amdgcn_rcpf(1.0f + __builtin_amdgcn_exp2f(-1.4426950408889634f * x)); }
__device__ __forceinline__ f32x4 sigmoid4(const f32x4 v) { f32x4 o; o[0] = fast_sigmoid(v[0]); o[1] = fast_sigmoid(v[1]); o[2] = fast_sigmoid(v[2]); o[3] = fast_sigmoid(v[3]); return o; }
__device__ __forceinline__ f32x4 silu4(const f32x4 v) { return v * sigmoid4(v); }
__device__ __forceinline__ f32x4 gelu_tanh4(const f32x4 v) { const f32x4 z = v * (1.5957691216057308f + 0.07135481627260025f * (v * v)); return v * sigmoid4(z); }

struct EpiSwiglu {
    static constexpr bool PERM = true, AFTER_DRAIN = false;
    bf16_t* O; int ldc;
    __device__ __forceinline__ void operator()(const f32x4 (&acc)[2][2][4][2], const Unit& u, int wr, int wc, int fr, int fq) const {
        const int row0 = u.pm * BM + wr * 64 + fr, col0 = u.pn * HALF + wc * 32 + 8 * fq;
#pragma unroll
        for (int ai = 0; ai < 2; ++ai)
#pragma unroll
            for (int m = 0; m < 4; ++m) { bf16_t* rowp = O + (size_t)(row0 + ai * HALF + m * 16) * ldc + col0;
                const f32x4 v0 = silu4(acc[ai][0][m][0]) * acc[ai][1][m][0], v1 = silu4(acc[ai][0][m][1]) * acc[ai][1][m][1];
                *(u32x4*)rowp = pack8(v0, v1); }
    }
};
struct EpiRgIn {
    static constexpr bool PERM = true, AFTER_DRAIN = false;
    bf16_t* Y;
    __device__ __forceinline__ void operator()(const f32x4 (&acc)[2][2][4][2], const Unit& u, int wr, int wc, int fr, int fq) const {
        const int row0 = u.pm * BM + wr * 64 + fr; const bool isy = u.pn < 4;
        bf16_t* base = Y + (size_t)(isy ? 0 : 1) * ((size_t)65536 * 1024) + (u.pn & 3) * BM + wc * 32 + 8 * fq;
#pragma unroll
        for (int ai = 0; ai < 2; ++ai)
#pragma unroll
            for (int m = 0; m < 4; ++m) { bf16_t* rowp = base + (size_t)(row0 + ai * HALF + m * 16) * 1024;
#pragma unroll
                for (int bj = 0; bj < 2; ++bj) { f32x4 v0 = acc[ai][bj][m][0], v1 = acc[ai][bj][m][1];
                    if (isy) { v0 = gelu_tanh4(v0); v1 = gelu_tanh4(v1); }
                    *(u32x4*)(rowp + bj * HALF) = pack8(v0, v1); } }
    }
};
struct EpiHgIn {
    static constexpr bool PERM = true, AFTER_DRAIN = false;
    bf16_t* Q; float* LOGF; const float* lb;
    __device__ __forceinline__ void operator()(const f32x4 (&acc)[2][2][4][2], const Unit& u, int wr, int wc, int fr, int fq) const {
        const int row0 = u.pm * BM + wr * 64 + fr, sec = u.pn >> 2, colw = (u.pn & 3) * BM + wc * 32 + 8 * fq;
        if (sec == 1) {
#pragma unroll
            for (int bj = 0; bj < 2; ++bj) { const f32x4 l0 = *(const f32x4*)(lb + colw + bj * HALF), l1 = *(const f32x4*)(lb + colw + bj * HALF + 4);
#pragma unroll
                for (int ai = 0; ai < 2; ++ai)
#pragma unroll
                    for (int m = 0; m < 4; ++m) { float* rowp = LOGF + (size_t)(row0 + ai * HALF + m * 16) * 1024 + colw + bj * HALF;
                        const f32x4 s0 = sigmoid4(acc[ai][bj][m][0]), s1 = sigmoid4(acc[ai][bj][m][1]);
                        const f32x4 f0 = l0 + (1.0f - l0) * s0, f1 = l1 + (1.0f - l1) * s1; f32x4 o0, o1;
#pragma unroll
                        for (int e = 0; e < 4; ++e) { o0[e] = __logf(f0[e]); o1[e] = __logf(f1[e]); }
                        *(f32x4*)rowp = o0; *(f32x4*)(rowp + 4) = o1; } }
        } else {
            bf16_t* base = Q + (size_t)(sec - (sec > 0 ? 1 : 0)) * ((size_t)65536 * 1024) + colw;
#pragma unroll
            for (int ai = 0; ai < 2; ++ai)
#pragma unroll
                for (int m = 0; m < 4; ++m) { bf16_t* rowp = base + (size_t)(row0 + ai * HALF + m * 16) * 1024;
#pragma unroll
                    for (int bj = 0; bj < 2; ++bj) { f32x4 v0 = acc[ai][bj][m][0], v1 = acc[ai][bj][m][1];
                        if (sec == 3) { v0 = sigmoid4(v0); v1 = sigmoid4(v1); }
                        *(u32x4*)(rowp + bj * HALF) = pack8(v0, v1); } }
        }
    }
};
struct EpiGlIn {
    static constexpr bool PERM = true, AFTER_DRAIN = false;
    bf16_t* Q; float* ALOW;
    __device__ __forceinline__ void operator()(const f32x4 (&acc)[2][2][4][2], const Unit& u, int wr, int wc, int fr, int fq) const {
        const int row0 = u.pm * BM + wr * 64 + fr, pn = u.pn;
        if (pn == 12) {
            if (wc == 0 && fq < 2) {
#pragma unroll
                for (int ai = 0; ai < 2; ++ai)
#pragma unroll
                    for (int m = 0; m < 4; ++m) { float* rowp = ALOW + (size_t)(row0 + ai * HALF + m * 16) * 16 + 8 * fq;
                        *(f32x4*)rowp = acc[ai][0][m][0]; *(f32x4*)(rowp + 4) = acc[ai][0][m][1]; }
            }
            return;
        }
        const int g2 = pn >= 2 ? 1 : 0, g4 = pn >= 4 ? 1 : 0, g8 = pn >= 8 ? 1 : 0; const int ld = 512 + 512 * g4;
        bf16_t* base = Q + (size_t)(g2 + g4 + 2 * g8) * ((size_t)65536 * 512) + (pn - 2 * g2 - 2 * g4 - 4 * g8) * BM;
        base += wc * 32 + 8 * fq; const bool act = pn >= 8;
#pragma unroll
        for (int ai = 0; ai < 2; ++ai)
#pragma unroll
            for (int m = 0; m < 4; ++m) { bf16_t* rowp = base + (size_t)(row0 + ai * HALF + m * 16) * ld;
#pragma unroll
                for (int bj = 0; bj < 2; ++bj) { f32x4 v0 = acc[ai][bj][m][0], v1 = acc[ai][bj][m][1];
                    if (act) { v0 = silu4(v0); v1 = silu4(v1); }
                    *(u32x4*)(rowp + bj * HALF) = pack8(v0, v1); } }
    }
};
struct EpiResid {
    static constexpr bool PERM = false, AFTER_DRAIN = false;
    const float* base; float* out; const float* coef; int cstride; float fac; const float* ss;
    __device__ __forceinline__ void operator()(const f32x4 (&acc)[2][2][4][2], const Unit& u, int wr, int wc, int fr, int fq) const {
        const int row0 = u.pm * BM + wr * 64 + fr, col0 = u.pn * BM + wc * 32 + 4 * fq;
        const float* cf = coef + (size_t)(u.pm >> 3) * cstride + col0;
        f32x4 cv[2][2];
#pragma unroll
        for (int bj = 0; bj < 2; ++bj)
#pragma unroll
            for (int n = 0; n < 2; ++n) cv[bj][n] = *(const f32x4*)(cf + bj * HALF + n * 16) * fac;
#pragma unroll
        for (int ai = 0; ai < 2; ++ai)
#pragma unroll
            for (int m = 0; m < 4; ++m) { const int row = row0 + ai * HALF + m * 16; const size_t off = (size_t)row * 1024 + col0;
                float rs = 1.0f;
                if (ss) { const f32x4 a = *(const f32x4*)(ss + (size_t)row * 8), b = *(const f32x4*)(ss + (size_t)row * 8 + 4);
                    rs = 1.0f / sqrtf(((a[0] + a[1]) + (a[2] + a[3]) + (b[0] + b[1]) + (b[2] + b[3])) * (1.0f / 1024.0f) + 1e-6f); }
#pragma unroll
                for (int bj = 0; bj < 2; ++bj)
#pragma unroll
                    for (int n = 0; n < 2; ++n) { const f32x4 bs = *(const f32x4*)(base + off + bj * HALF + n * 16);
                        *(f32x4*)(out + off + bj * HALF + n * 16) = bs + (cv[bj][n] * rs) * acc[ai][bj][m][n]; } }
    }
};

template <class Epi, class Sched, bool ALIGN_EPI = false, bool SP2 = false>
__device__ __forceinline__ void gemm_phase(PG8_LAS unsigned char* lds, const Gemm g, const Sched& S, const Epi& E) {
    int tid_ = threadIdx.x; asm volatile("" : "+v"(tid_));
    const int tid = tid_, wid = __builtin_amdgcn_readfirstlane(tid >> 6), lane = tid & 63, wr = wid >> 2, wc = wid & 3, fr = lane & 15, fq = lane >> 4;
    const int K = g.K, nt = K / BK;
    unsigned voffA[2], voffB[2];
#pragma unroll
    for (int i = 0; i < 2; ++i) { int R, C; stage_rc(tid * 16 + i * 8192, R, C); const int Rb = Epi::PERM ? ((R & ~31) + perm32(R & 31)) : R;
        voffA[i] = (unsigned)(R * K + C) * 2u; voffB[i] = (unsigned)(Rb * K + C) * 2u; }
    const size_t kstep = (size_t)(BK * 2);
    const size_t hstep = (size_t)HALF * K * 2;
    const size_t tstep = 2 * hstep;
    const unsigned ldsw = (unsigned)wid * 1024u;
    const int aoff = lds_byte(wr * 64 + fr, fq * 8), boff = lds_byte(wc * 32 + fr, fq * 8);
#define PG8_SA(b, h) (((b) * 2 + (h)) * HTB)
#define PG8_SB(b, h) ((4 + (b) * 2 + (h)) * HTB)
#define PG8_STAGE(bufoff, gbase, voff) do { _Pragma("unroll") for (int _i = 0; _i < 2; ++_i) \
        __builtin_amdgcn_global_load_lds((const unsigned*)((const char*)(gbase) + (voff)[_i]), (PG8_LAS unsigned*)(lds + (bufoff) + ldsw + _i * 8192), 16, 0, 0); } while (0)
#define PG8_LDA(dst, b, h) do { _Pragma("unroll") for (int m = 0; m < 4; ++m) _Pragma("unroll") for (int k = 0; k < 2; ++k) dst[m][k] = *(const PG8_LAS bf16x8*)(lds + PG8_SA(b, h) + aoff + m * 2048 + k * 1024); } while (0)
#define PG8_LDB(dst, b, h) do { _Pragma("unroll") for (int n = 0; n < 2; ++n) _Pragma("unroll") for (int k = 0; k < 2; ++k) dst[n][k] = *(const PG8_LAS bf16x8*)(lds + PG8_SB(b, h) + boff + n * 2048 + k * 1024); } while (0)
#define PG8_MMA(ai, bj, At, Bt) do { __builtin_amdgcn_s_setprio(1); _Pragma("unroll") for (int m = 0; m < 4; ++m) _Pragma("unroll") for (int n = 0; n < 2; ++n) _Pragma("unroll") for (int k = 0; k < 2; ++k) \
        acc[ai][bj][m][n] = __builtin_amdgcn_mfma_f32_16x16x32_bf16(Bt[n][k], At[m][k], acc[ai][bj][m][n], 0, 0, 0); __builtin_amdgcn_s_setprio(0); } while (0)
#define PG8_WAIT_V(n) asm volatile("s_waitcnt vmcnt(" #n ")" ::: "memory")
#define PG8_WAIT_L(n) asm volatile("s_waitcnt lgkmcnt(" #n ")" ::: "memory")
#define PG8_BAR __builtin_amdgcn_s_barrier()
#define PG8_SCHED __builtin_amdgcn_sched_barrier(0)
    Unit cur, nxt; int ui = 0;
    if (!S.next(0, cur)) return;
    f32x4 acc[2][2][4][2];
#pragma unroll
    for (int a = 0; a < 2; ++a)
#pragma unroll
        for (int b = 0; b < 2; ++b)
#pragma unroll
            for (int m = 0; m < 4; ++m)
#pragma unroll
                for (int n = 0; n < 2; ++n) acc[a][b][m][n] = (f32x4){0.f, 0.f, 0.f, 0.f};
    bf16x8 At[4][2], B0[2][2], B1[2][2];
    const char* cA = (const char*)g.A + (size_t)cur.pm * tstep; const char* cB = (const char*)g.Bt + (size_t)cur.pn * tstep;
    S.a_ready(cur);
    if constexpr (SP2) {
        PG8_STAGE(PG8_SB(0, 0), cB, voffB); PG8_STAGE(PG8_SB(0, 1), cB + hstep, voffB); PG8_STAGE(PG8_SA(0, 0), cA, voffA); PG8_STAGE(PG8_SA(0, 1), cA + hstep, voffA);
        if (wr == 1) PG8_BAR;
        PG8_WAIT_V(2); PG8_BAR;
        PG8_STAGE(PG8_SB(1, 0), cB + kstep, voffB); PG8_STAGE(PG8_SA(1, 0), cA + kstep, voffA); PG8_STAGE(PG8_SB(1, 1), cB + hstep + kstep, voffB);
        PG8_WAIT_V(6); PG8_BAR;
    } else {
        PG8_STAGE(PG8_SB(0, 0), cB, voffB); PG8_STAGE(PG8_SA(0, 0), cA, voffA); PG8_STAGE(PG8_SB(0, 1), cB + hstep, voffB); PG8_STAGE(PG8_SA(0, 1), cA + hstep, voffA);
        if (wr == 1) PG8_BAR;
        PG8_WAIT_V(4); PG8_BAR;
        PG8_STAGE(PG8_SB(1, 0), cB + kstep, voffB); PG8_STAGE(PG8_SA(1, 0), cA + kstep, voffA); PG8_STAGE(PG8_SB(1, 1), cB + hstep + kstep, voffB);
        PG8_WAIT_V(6); PG8_BAR;
    }
    for (;;) {
        const bool has_next = S.next(ui + 1, nxt);
        const char* nA = has_next ? (const char*)g.A + (size_t)nxt.pm * tstep : cA; const char* nB = has_next ? (const char*)g.Bt + (size_t)nxt.pn * tstep : cB;
        for (int t = 0; t < nt; t += 2) {
            const bool last = (t == nt - 2);
            const char* a1 = cA + (size_t)(t + 1) * kstep;
            const char* a2 = last ? nA : cA + (size_t)(t + 2) * kstep; const char* b2 = last ? nB : cB + (size_t)(t + 2) * kstep;
            const char* a3 = a2 + kstep; const char* b3 = b2 + kstep;
            if (last && has_next) S.a_ready(nxt);
            if constexpr (SP2) {
            PG8_LDB(B0, 0, 0); PG8_LDB(B1, 0, 1); PG8_SCHED; PG8_LDA(At, 0, 0); PG8_STAGE(PG8_SA(1, 1), a1 + hstep, voffA);
            PG8_WAIT_V(8); PG8_WAIT_L(0); PG8_BAR; PG8_MMA(0, 0, At, B0); PG8_MMA(0, 1, At, B1); PG8_BAR; PG8_SCHED;
            PG8_LDA(At, 0, 1); PG8_STAGE(PG8_SB(0, 0), b2, voffB); PG8_STAGE(PG8_SB(0, 1), b2 + hstep, voffB); PG8_STAGE(PG8_SA(0, 0), a2, voffA);
            PG8_WAIT_V(8); PG8_WAIT_L(0); PG8_BAR; PG8_MMA(1, 0, At, B0); PG8_MMA(1, 1, At, B1); PG8_BAR; PG8_SCHED;
            PG8_LDB(B0, 1, 0); PG8_LDB(B1, 1, 1); PG8_SCHED; PG8_LDA(At, 1, 0); PG8_STAGE(PG8_SA(0, 1), a2 + hstep, voffA);
            PG8_WAIT_V(8); PG8_WAIT_L(0); PG8_BAR; PG8_MMA(0, 0, At, B0); PG8_MMA(0, 1, At, B1); PG8_BAR; PG8_SCHED;
            PG8_LDA(At, 1, 1); PG8_STAGE(PG8_SB(1, 0), b3, voffB); PG8_STAGE(PG8_SB(1, 1), b3 + hstep, voffB); PG8_STAGE(PG8_SA(1, 0), a3, voffA);
            PG8_WAIT_V(8); PG8_WAIT_L(0); PG8_BAR; PG8_MMA(1, 0, At, B0); PG8_MMA(1, 1, At, B1); PG8_BAR; PG8_SCHED;
            } else {
            PG8_LDB(B0, 0, 0); PG8_SCHED; PG8_LDA(At, 0, 0); PG8_STAGE(PG8_SA(1, 1), a1 + hstep, voffA);
            PG8_WAIT_L(8); PG8_BAR; PG8_WAIT_L(0); PG8_MMA(0, 0, At, B0); PG8_BAR; PG8_SCHED;
            PG8_LDB(B1, 0, 1); PG8_STAGE(PG8_SB(0, 0), b2, voffB);
            PG8_BAR; PG8_WAIT_L(0); PG8_MMA(0, 1, At, B1); PG8_BAR;
            PG8_LDA(At, 0, 1); PG8_STAGE(PG8_SA(0, 0), a2, voffA);
            PG8_BAR; PG8_WAIT_L(0); PG8_MMA(1, 0, At, B0); PG8_BAR; PG8_SCHED;
            PG8_STAGE(PG8_SB(0, 1), b2 + hstep, voffB);
            PG8_WAIT_V(6); PG8_BAR; PG8_MMA(1, 1, At, B1); PG8_BAR;
            PG8_LDB(B0, 1, 0); PG8_SCHED; PG8_LDA(At, 1, 0); PG8_STAGE(PG8_SA(0, 1), a2 + hstep, voffA);
            PG8_WAIT_L(8); PG8_BAR; PG8_WAIT_L(0); PG8_MMA(0, 0, At, B0); PG8_BAR; PG8_SCHED;
            PG8_LDB(B1, 1, 1); PG8_STAGE(PG8_SB(1, 0), b3, voffB);
            PG8_BAR; PG8_WAIT_L(0); PG8_MMA(0, 1, At, B1); PG8_BAR;
            PG8_LDA(At, 1, 1); PG8_STAGE(PG8_SA(1, 0), a3, voffA);
            PG8_BAR; PG8_WAIT_L(0); PG8_MMA(1, 0, At, B0); PG8_BAR; PG8_SCHED;
            PG8_STAGE(PG8_SB(1, 1), b3 + hstep, voffB);
            PG8_WAIT_V(6); PG8_BAR; PG8_MMA(1, 1, At, B1); PG8_BAR;
            }
        }
        if constexpr (ALIGN_EPI) { if (wr == 0) PG8_BAR; }
        if constexpr (!Epi::AFTER_DRAIN) { E(acc, cur, wr, wc, fr, fq); S.done(cur); }
        if (!has_next) break;
#pragma unroll
        for (int a = 0; a < 2; ++a)
#pragma unroll
            for (int b = 0; b < 2; ++b)
#pragma unroll
                for (int m = 0; m < 4; ++m)
#pragma unroll
                    for (int n = 0; n < 2; ++n) acc[a][b][m][n] = (f32x4){0.f, 0.f, 0.f, 0.f};
        cur = nxt; cA = nA; cB = nB; ++ui;
        if constexpr (ALIGN_EPI) { if (wr == 1) PG8_BAR; }
    }
    PG8_WAIT_V(0);
    if constexpr (!ALIGN_EPI) { if (wr == 0) PG8_BAR; }
    PG8_BAR;
    if constexpr (Epi::AFTER_DRAIN) { E.fused(acc, cur, wr, wc, fr, fq, lds, wid, lane); S.done(cur); }
#undef PG8_SA
#undef PG8_SB
#undef PG8_STAGE
#undef PG8_LDA
#undef PG8_LDB
#undef PG8_MMA
#undef PG8_WAIT_V
#undef PG8_WAIT_L
#undef PG8_BAR
#undef PG8_SCHED
}
}
constexpr int NWAVES = 8;
constexpr int BATCH = 32, SEQ = 2048, D = 1024, M = BATCH * SEQ, FF = 2816, DEPTH = 4, NMOD = 9;
constexpr int GLA_IN = 3088, GLA_INP = 3328;
constexpr float EPS = 1e-6f;
constexpr size_t MiB = 1u << 20;
constexpr size_t WS_CTL = 0, CTL_ZERO_BYTES = 1 * MiB;
constexpr size_t WS_MOD = 2 * MiB;
constexpr size_t WS_LB = 6 * MiB + 512 * 1024;
constexpr size_t WS_SS = 7 * MiB;
constexpr size_t WS_W13 = 10 * MiB, W13_BYTES = (size_t)2 * FF * D * 2;
constexpr size_t WS_W2 = 98 * MiB, W2_BYTES = (size_t)D * FF * 2;
constexpr size_t WS_RGIN = 142 * MiB, RGIN_BYTES = (size_t)2048 * D * 2;
constexpr size_t WS_RGG = 150 * MiB, RGG_BYTES = (size_t)8 * 256 * 128 * 2;
constexpr size_t WS_RGOUT = 151 * MiB, SQ_BYTES = (size_t)D * D * 2;
constexpr size_t WS_HGIN = 155 * MiB;
constexpr size_t WS_HGOUT = 163 * MiB;
constexpr size_t WS_GLIN = 165 * MiB;
constexpr size_t WS_GLOUT = 172 * MiB;
constexpr size_t WS_H = 176 * MiB;
constexpr size_t WS_SCR = 304 * MiB;
constexpr size_t ACT_BYTES = (size_t)M * D * 2;
constexpr size_t WS_END = WS_SCR + 5 * ACT_BYTES;
static_assert(WS_W13 + 8 * W13_BYTES <= WS_W2 && WS_W2 + 8 * W2_BYTES <= WS_RGIN && WS_RGIN + 2 * RGIN_BYTES <= WS_RGG && WS_RGG + 2 * RGG_BYTES <= WS_RGOUT && WS_RGOUT + 2 * SQ_BYTES <= WS_HGIN, "ws map 1");
static_assert(WS_HGIN + 4 * SQ_BYTES <= WS_HGOUT && WS_HGOUT + SQ_BYTES <= WS_GLIN && WS_GLIN + (size_t)GLA_INP * D * 2 <= WS_GLOUT && WS_GLOUT + SQ_BYTES <= WS_H && WS_H + ACT_BYTES <= WS_SCR, "ws map 2");
static_assert((size_t)M * FF * 2 <= 5 * ACT_BYTES, "hid fits");
constexpr int CW_TMO = 0, CW_BAR = 4096;
constexpr int RING_BYTES = 131072, LDSCTL_OFF = RING_BYTES, MISC_OFF = LDSCTL_OFF + 320, LDS_BYTES = 147456;

#define GAS __attribute__((address_space(1)))
#define LAS __attribute__((address_space(3)))
typedef unsigned short bf16;
typedef unsigned v4u __attribute__((ext_vector_type(4)));
typedef unsigned v2u __attribute__((ext_vector_type(2)));
typedef float f32x4 __attribute__((ext_vector_type(4)));
typedef float f32x16 __attribute__((ext_vector_type(16)));
typedef short bf16x8 __attribute__((ext_vector_type(8)));
typedef GAS unsigned gu32;
#define RLX_AGENT __ATOMIC_RELAXED, __HIP_MEMORY_SCOPE_AGENT
#define LDS_WAIT() asm volatile("s_waitcnt lgkmcnt(0)" ::: "memory")
#define VM_WAIT() asm volatile("s_waitcnt vmcnt(0)" ::: "memory")
__device__ __forceinline__ unsigned pk2(float lo, float hi) { return pg8::cvt_pk_bf16(lo, hi); }
__device__ __forceinline__ unsigned f2bf(float f) { return pg8::cvt_pk_bf16(f, 0.f) & 0xffffu; }
__device__ __forceinline__ float bf2f(unsigned h) { return __builtin_bit_cast(float, h << 16); }
__device__ __forceinline__ float sigmoidf_(float x) { return 1.0f / (1.0f + expf(-x)); }

#define XB_TMO      128
#define XB_XCNT(j)  (256  + 64 * (j))
#define XB_XSUB(j)  (1280 + 64 * (j))
#define XB_XGEN(j)  (2304 + 64 * (j))
#define XB_TOP      3328
#define XB_TOPGEN   3392
#define XCD_BAR_WORDS 3456
#define XB_SPIN_CAP (1u << 18)

__device__ __forceinline__ unsigned xb_ld(unsigned* p)              { return __hip_atomic_load(p, __ATOMIC_RELAXED, __HIP_MEMORY_SCOPE_AGENT); }
__device__ __forceinline__ unsigned xb_add(unsigned* p, unsigned v) { return __hip_atomic_fetch_add(p, v, __ATOMIC_RELAXED, __HIP_MEMORY_SCOPE_AGENT); }
__device__ __forceinline__ unsigned xb_xcc_id() { return (unsigned)__builtin_amdgcn_s_getreg((3 << 11) | 20) & 0xFu; }
#define XB_SPIN(cond, bar) do { unsigned _sp = 0; while (cond) { __builtin_amdgcn_s_sleep(1); \
    if ((++_sp & 255u) == 0u) { if (xb_ld(&(bar)[XB_TMO])) break; if (_sp > XB_SPIN_CAP) { atomicAdd(&(bar)[XB_TMO], 1u); break; } } } } while (0)

struct XcdBarrier {
    unsigned* bar; unsigned x;
    volatile LAS unsigned* st;
};

__device__ __forceinline__ XcdBarrier xcd_barrier_post(unsigned* bar, volatile LAS unsigned* st) {
    XcdBarrier b; b.bar = bar; b.x = xb_xcc_id(); b.st = st;
    if (threadIdx.x == 0) (void)xb_add(&bar[XB_XCNT(b.x)], 1u);
    return b;
}
__device__ __forceinline__ void xcd_barrier_complete(unsigned* bar, unsigned x, unsigned& nloc, unsigned& nx) {
    const unsigned G = gridDim.x * gridDim.y * gridDim.z;
    unsigned sum, cnt, mine, sp = 0u;
    for (;;) {
        sum = 0u; cnt = 0u; mine = 0u;
#pragma unroll
        for (unsigned j = 0; j < 16; ++j) { const unsigned c = xb_ld(&bar[XB_XCNT(j)]); sum += c; cnt += (c > 0u) ? 1u : 0u; mine = (j == x) ? c : mine; }
        if (sum == G) break;
        __builtin_amdgcn_s_sleep(1);
        if ((++sp & 255u) == 0u) { if (xb_ld(&bar[XB_TMO])) break; if (sp > XB_SPIN_CAP) { atomicAdd(&bar[XB_TMO], 1u); break; } }
    }
    nloc = mine > 0u ? mine : 1u; nx = cnt > 0u ? cnt : 1u;
}

__device__ __forceinline__ void xcd_barrier(const XcdBarrier& b) {
    asm volatile("s_waitcnt vmcnt(0)" ::: "memory");
    __syncthreads();
    if (threadIdx.x == 0) {
        unsigned* bar = b.bar;
        __builtin_amdgcn_s_waitcnt(0);
        unsigned nloc = b.st[0], nx = b.st[1];
        if (nloc == 0u) { xcd_barrier_complete(bar, b.x, nloc, nx); b.st[0] = nloc; b.st[1] = nx; }
        const unsigned old = xb_add(&bar[XB_XSUB(b.x)], 1u);
        const unsigned gen = old / nloc;
        if (old + 1u == (gen + 1u) * nloc) {
            __builtin_amdgcn_fence(__ATOMIC_RELEASE, "agent");
            asm volatile("s_waitcnt vmcnt(0)" ::: "memory");
            const unsigned og = xb_add(&bar[XB_TOP], 1u);
            const unsigned tg = og / nx;
            if (og + 1u == (tg + 1u) * nx) xb_add(&bar[XB_TOPGEN], 1u);
            else XB_SPIN(xb_ld(&bar[XB_TOPGEN]) == tg, bar);
            __builtin_amdgcn_fence(__ATOMIC_ACQUIRE, "agent");
            xb_add(&bar[XB_XGEN(b.x)], 1u);
            asm volatile("s_waitcnt vmcnt(0)" ::: "memory");
        } else {
            XB_SPIN(xb_ld(&bar[XB_XGEN(b.x)]) == gen, bar);
            __builtin_amdgcn_fence(__ATOMIC_ACQUIRE, "agent");
            asm volatile("s_waitcnt vmcnt(0)" ::: "memory");
        }
    }
    __syncthreads();
}
struct Frame {
    LAS unsigned char* lds;
    volatile LAS unsigned* MISC;
    gu32* ctl;
    int tid, lane, wave, vcu, G;
};
__device__ __forceinline__ float wave_sum(float v) {
#pragma unroll
    for (int o = 1; o < 64; o <<= 1) v += __shfl_xor(v, o);
    return v;
}
__device__ __forceinline__ void conv_item(const float* W, int N, int k0, int n0, int nvalid, bf16* WT, int Kd, int drow0, LAS float* scr, int lane) {
    const bool ok = (lane & 31) < nvalid;
#pragma unroll 8
    for (int i = 0; i < 32; ++i) { const int kk = 2 * i + (lane >> 5); scr[kk * 33 + (lane & 31)] = ok ? W[(size_t)(k0 + kk) * N + n0 + (lane & 31)] : 0.f; }
    LDS_WAIT(); asm volatile("" ::: "memory");
    const int c = lane & 7;
#pragma unroll
    for (int j = 0; j < 4; ++j) { const int n = (lane >> 3) + 8 * j; const LAS float* s = scr + (8 * c) * 33 + n;
        v4u o; o.x = pk2(s[0 * 33], s[1 * 33]); o.y = pk2(s[2 * 33], s[3 * 33]); o.z = pk2(s[4 * 33], s[5 * 33]); o.w = pk2(s[6 * 33], s[7 * 33]);
        *(GAS v4u*)(WT + (size_t)(drow0 + n) * Kd + k0 + 8 * c) = o; }
    LDS_WAIT(); asm volatile("" ::: "memory");
}
struct ProIn { const float *c, *ada_w, *ada_b, *w13, *w2, *rg_w_in, *rg_gate_w, *rg_w_out, *hg_w_in, *hg_lb, *hg_w_out, *gla_w_in, *gla_w_out; };
__device__ __forceinline__ void p0_prologue(Frame& F, const ProIn& P, unsigned char* ws) {
    int lane_ = F.lane; asm volatile("" : "+v"(lane_)); const int lane = lane_;
    int gw_ = F.wave * F.G + F.vcu; asm volatile("" : "+s"(gw_)); const int gw = gw_, NGW = F.G * NWAVES;
    float* MOD = (float*)(ws + WS_MOD);
    for (int blk = gw; blk < DEPTH * NMOD * D / 32; blk += NGW) {
        const int n0 = blk * 32, l = n0 / (NMOD * D), nn = n0 % (NMOD * D);
        const float* Wp = P.ada_w + (size_t)l * D * (NMOD * D) + nn + (lane & 31) + (size_t)(lane >> 5) * (NMOD * D);
        const float* Cp = P.c + (size_t)(lane & 31) * D + (lane >> 5);
        f32x16 acc = {};
        for (int k0 = 0; k0 < D; k0 += 16) {
            float wv[8], cv[8];
#pragma unroll
            for (int i = 0; i < 8; ++i) { wv[i] = Wp[(size_t)(k0 + 2 * i) * (NMOD * D)]; cv[i] = Cp[k0 + 2 * i]; }
#pragma unroll
            for (int i = 0; i < 8; ++i) { const float ca = cv[i] / (1.0f + expf(-cv[i])); acc = __builtin_amdgcn_mfma_f32_32x32x2f32(ca, wv[i], acc, 0, 0, 0); }
        }
        const float bias = P.ada_b[(size_t)l * (NMOD * D) + nn + (lane & 31)];
#pragma unroll
        for (int r = 0; r < 16; ++r) { const int b = (r & 3) + 8 * (r >> 2) + 4 * (lane >> 5); MOD[((size_t)l * BATCH + b) * (NMOD * D) + nn + (lane & 31)] = acc[r] + bias; }
    }
    if (F.vcu == 0) { float* LB = (float*)(ws + WS_LB);
        for (int ch = F.tid; ch < D; ch += NWAVES * 64) { const float g0 = P.hg_lb[ch], g1 = P.hg_lb[D + ch], g2 = P.hg_lb[2 * D + ch], g3 = P.hg_lb[3 * D + ch];
            const float mx = fmaxf(fmaxf(g0, g1), fmaxf(g2, g3)); const float e0 = expf(g0 - mx), e1 = expf(g1 - mx), e2 = expf(g2 - mx), e3 = expf(g3 - mx);
            LB[ch] = e1 / (e0 + e1 + e2 + e3); } }
    LAS float* scr = (LAS float*)(F.lds + F.wave * 16384);
    int gw2_ = F.vcu * NWAVES + F.wave; asm volatile("" : "+s"(gw2_)); const int gw2 = gw2_;
    constexpr int I_W13 = 16 * 176, I_W2 = 44 * 32, I_RGIN = 16 * 64, I_RGG = 2 * 8, I_SQ = 16 * 32, I_HGIN = 16 * 128, I_GLIN = 16 * (GLA_INP / 32);
    constexpr int T0 = 8 * I_W13, T1 = T0 + 8 * I_W2, T2 = T1 + 2 * I_RGIN, T3 = T2 + 16 * I_RGG, T4 = T3 + 2 * I_SQ, T5 = T4 + I_HGIN, T6 = T5 + I_SQ, T7 = T6 + I_GLIN, T8 = T7 + I_SQ;
    for (int it = gw2; it < T8; it += NGW) {
        int r = it;
        if (r < T0) { const int mi = r / I_W13, q = r % I_W13, kb = q / 176, nb = q % 176, n0 = nb * 32;
            const int drow = n0 < FF ? (n0 / 128) * 256 + (n0 % 128) : ((n0 - FF) / 128) * 256 + 128 + ((n0 - FF) % 128);
            conv_item(P.w13 + (size_t)mi * D * 2 * FF, 2 * FF, kb * 64, n0, 32, (bf16*)(ws + WS_W13 + mi * W13_BYTES), D, drow, scr, lane); continue; }
        r -= T0;
        if (r < 8 * I_W2) { const int mi = r / I_W2, q = r % I_W2, kb = q / 32, nb = q % 32;
            conv_item(P.w2 + (size_t)mi * FF * D, D, kb * 64, nb * 32, 32, (bf16*)(ws + WS_W2 + mi * W2_BYTES), FF, nb * 32, scr, lane); continue; }
        r -= 8 * I_W2;
        if (r < 2 * I_RGIN) { const int mi = r / I_RGIN, q = r % I_RGIN, kb = q / 64, nb = q % 64;
            conv_item(P.rg_w_in + (size_t)mi * D * 2048, 2048, kb * 64, nb * 32, 32, (bf16*)(ws + WS_RGIN + mi * RGIN_BYTES), D, nb * 32, scr, lane); continue; }
        r -= 2 * I_RGIN;
        if (r < 16 * I_RGG) { const int mi = r / I_RGG, q = r % I_RGG, kb = q / 8, nb = q % 8;
            conv_item(P.rg_gate_w + (size_t)mi * 128 * 256, 256, kb * 64, nb * 32, 32, (bf16*)(ws + WS_RGG) + (size_t)mi * 256 * 128, 128, nb * 32, scr, lane); continue; }
        r -= 16 * I_RGG;
        if (r < 2 * I_SQ) { const int mi = r / I_SQ, q = r % I_SQ, kb = q / 32, nb = q % 32;
            conv_item(P.rg_w_out + (size_t)mi * D * D, D, kb * 64, nb * 32, 32, (bf16*)(ws + WS_RGOUT + mi * SQ_BYTES), D, nb * 32, scr, lane); continue; }
        r -= 2 * I_SQ;
        if (r < I_HGIN) { const int kb = r / 128, nb = r % 128;
            conv_item(P.hg_w_in, 4096, kb * 64, nb * 32, 32, (bf16*)(ws + WS_HGIN), D, nb * 32, scr, lane); continue; }
        r -= I_HGIN;
        if (r < I_SQ) { const int kb = r / 32, nb = r % 32;
            conv_item(P.hg_w_out, D, kb * 64, nb * 32, 32, (bf16*)(ws + WS_HGOUT), D, nb * 32, scr, lane); continue; }
        r -= I_SQ;
        if (r < I_GLIN) { const int kb = r / (GLA_INP / 32), nb = r % (GLA_INP / 32), n0 = nb * 32; const int nv = GLA_IN - n0 < 0 ? 0 : (GLA_IN - n0 > 32 ? 32 : GLA_IN - n0);
            conv_item(P.gla_w_in, GLA_IN, kb * 64, nv > 0 ? n0 : 0, nv, (bf16*)(ws + WS_GLIN), D, n0, scr, lane); continue; }
        r -= I_GLIN;
        { const int kb = r / 32, nb = r % 32;
            conv_item(P.gla_w_out, D, kb * 64, nb * 32, 32, (bf16*)(ws + WS_GLOUT), D, nb * 32, scr, lane); }
    }
}
__device__ __forceinline__ void norm_phase(Frame& F, const float* x, const float* nw, const float* shift, const float* scale, bf16* H) {
    int lane_ = F.lane; asm volatile("" : "+v"(lane_)); const int lane = lane_;
    int gw_ = F.vcu * NWAVES + F.wave; asm volatile("" : "+s"(gw_)); const int gw = gw_, NGW = F.G * NWAVES;
    for (int strip = gw; strip < M / 32; strip += NGW) {
        const int b = (strip * 32) / SEQ;
        f32x4 gv[4], sv[4];
#pragma unroll
        for (int j = 0; j < 4; ++j) { const int col = 4 * lane + 256 * j;
            gv[j] = *(const f32x4*)(nw + col) * (1.0f + *(const f32x4*)(scale + (size_t)b * (NMOD * D) + col)); sv[j] = *(const f32x4*)(shift + (size_t)b * (NMOD * D) + col); }
        for (int rr = 0; rr < 32; ++rr) { const size_t row = (size_t)strip * 32 + rr;
            const GAS f32x4* xr = (const GAS f32x4*)(x + row * D) + lane;
            f32x4 v[4]; float s = 0.f;
#pragma unroll
            for (int j = 0; j < 4; ++j) { v[j] = xr[64 * j]; s += (v[j].x * v[j].x + v[j].y * v[j].y) + (v[j].z * v[j].z + v[j].w * v[j].w); }
            const float rstd = 1.0f / sqrtf(wave_sum(s) * (1.f / D) + EPS);
            GAS v2u* o8 = (GAS v2u*)(H + row * D) + lane;
#pragma unroll
            for (int j = 0; j < 4; ++j) { const f32x4 o = v[j] * rstd * gv[j] + sv[j]; v2u w; w.x = pk2(o.x, o.y); w.y = pk2(o.z, o.w); o8[64 * j] = w; }
        }
    }
}
__device__ __forceinline__ void final_norm_phase(Frame& F, const float* x, const float* w, float* out) {
    int lane_ = F.lane; asm volatile("" : "+v"(lane_)); const int lane = lane_;
    int gw_ = F.vcu * NWAVES + F.wave; asm volatile("" : "+s"(gw_)); const int gw = gw_, NGW = F.G * NWAVES;
    f32x4 gv[4];
#pragma unroll
    for (int j = 0; j < 4; ++j) gv[j] = *(const f32x4*)(w + 4 * lane + 256 * j);
    for (int strip = gw; strip < M / 32; strip += NGW) {
        for (int rr = 0; rr < 32; ++rr) { const size_t row = (size_t)strip * 32 + rr;
            const GAS f32x4* xr = (const GAS f32x4*)(x + row * D) + lane;
            f32x4 v[4]; float s = 0.f;
#pragma unroll
            for (int j = 0; j < 4; ++j) { v[j] = xr[64 * j]; s += (v[j].x * v[j].x + v[j].y * v[j].y) + (v[j].z * v[j].z + v[j].w * v[j].w); }
            const float rstd = 1.0f / sqrtf(wave_sum(s) * (1.f / D) + EPS);
            GAS f32x4* o = (GAS f32x4*)(out + row * D) + lane;
#pragma unroll
            for (int j = 0; j < 4; ++j) o[64 * j] = v[j] * rstd * gv[j];
        }
    }
}
#define MFMA16(a, b, c) __builtin_amdgcn_mfma_f32_16x16x32_bf16((a), (b), (c), 0, 0, 0)
__device__ __forceinline__ bf16x8 ld_b128(const LAS unsigned char* p) { return *(const LAS bf16x8*)p; }
__device__ __forceinline__ bf16x8 ld_2xb64(const LAS unsigned char* p0, const LAS unsigned char* p1) { const v2u a = *(const LAS v2u*)p0, b = *(const LAS v2u*)p1; v4u w; w.x = a.x; w.y = a.y; w.z = b.x; w.w = b.y; return __builtin_bit_cast(bf16x8, w); }
__device__ __forceinline__ bf16x8 pack8f(const f32x4 a, const f32x4 b) { return __builtin_bit_cast(bf16x8, pg8::pack8(a, b)); }
#ifndef DBG_R4
#define DBG_R4 4
#endif
typedef __amdgpu_buffer_rsrc_t rsrc_t;
__device__ __forceinline__ rsrc_t mk_rsrc(const void* p) { return __builtin_amdgcn_make_buffer_rsrc((void*)p, 0, 0x7fffffff, 0x00020000); }
__device__ __forceinline__ float bld_bf(rsrc_t r, unsigned voff, unsigned soff) { return bf2f((unsigned)__builtin_amdgcn_raw_buffer_load_b16(r, voff, soff, 0)); }
__device__ __forceinline__ unsigned short bld_u16(rsrc_t r, unsigned voff, unsigned soff) { return __builtin_amdgcn_raw_buffer_load_b16(r, voff, soff, 0); }
__device__ __forceinline__ float bld_f32(rsrc_t r, unsigned voff, unsigned soff) { return __builtin_bit_cast(float, __builtin_amdgcn_raw_buffer_load_b32(r, voff, soff, 0)); }
__device__ __forceinline__ v4u bld_b128(rsrc_t r, unsigned voff, unsigned soff) { return __builtin_amdgcn_raw_buffer_load_b128(r, voff, soff, 0); }
struct RgArgs { const bf16* Y; const bf16* XB; bf16* HY; const bf16* WgT; const float *gate_b, *lam, *conv_w, *conv_b; };
__device__ __forceinline__ void rg_scan_phase(Frame& F, const RgArgs A) {
    LAS unsigned char* L = F.lds;
    LAS float* XC = (LAS float*)L;
    LAS unsigned char* XCB = L + 16384;
    LAS float* AL = (LAS float*)(L + 25088);
    LAS float* UL = (LAS float*)(L + 41472);
    LAS float* HS = (LAS float*)(L + 57856);
    int tid_ = threadIdx.x; asm volatile("" : "+v"(tid_));
    const int tid = tid_, lane = tid & 63, wave = __builtin_amdgcn_readfirstlane(tid >> 6), q = lane >> 4, l15 = lane & 15;
    const int cch = tid & 127, tg = wave >> 1, chl = 16 * wave + l15;
    for (int unit = blockIdx.x; unit < BATCH * 8; unit += gridDim.x) {
        const int b = unit >> 3, hd = unit & 7, colbase = hd * 128; const size_t rowbase = (size_t)b * SEQ;
        const bf16* Wg = A.WgT + (size_t)hd * 256 * 128;
        bf16x8 Bx[4], Ba[4];
#pragma unroll
        for (int s = 0; s < 4; ++s) { Bx[s] = *(const bf16x8*)(Wg + (size_t)chl * 128 + 32 * s + 8 * q); Ba[s] = *(const bf16x8*)(Wg + (size_t)(128 + chl) * 128 + 32 * s + 8 * q); }
        const float bx = A.gate_b[hd * 256 + chl], ba = A.gate_b[hd * 256 + 128 + chl];
        const float lamv = A.lam[colbase + chl]; const float sp8 = 8.0f * (fmaxf(-lamv, 0.f) + log1pf(expf(-fabsf(lamv))));
        const float cw0 = A.conv_w[colbase + cch], cw1 = A.conv_w[D + colbase + cch], cw2 = A.conv_w[2 * D + colbase + cch], cw3 = A.conv_w[3 * D + colbase + cch], cb = A.conv_b[colbase + cch];
        float h = 0.f;
        const rsrc_t rxb = mk_rsrc(A.XB + rowbase * D + colbase), ry = mk_rsrc(A.Y + rowbase * D + colbase), rhy = mk_rsrc(A.HY + rowbase * D + colbase);
        const unsigned vo = (unsigned)(8 * tg * D + cch) * 2u;
        float xb[11], yv[8], yn[8];
#pragma unroll
        for (int i = 0; i < 11; ++i) { const int t = 8 * tg - 3 + i; const float v = bld_bf(rxb, (unsigned)cch * 2u, (unsigned)(t < 0 ? 0 : t) * 2048u); xb[i] = t >= 0 ? v : 0.f; }
#pragma unroll
        for (int i = 0; i < 8; ++i) yv[i] = bld_bf(ry, vo, (unsigned)i * 2048u);
        for (int step = 0; step < SEQ / 32; ++step) {
            const int t0 = step * 32;
            float xc[8];
#pragma unroll
            for (int i = 0; i < 8; ++i) { xc[i] = cb + cw0 * xb[i] + cw1 * xb[i + 1] + cw2 * xb[i + 2] + cw3 * xb[i + 3];
                XC[(8 * tg + i) * 128 + cch] = xc[i]; *(LAS unsigned short*)(XCB + (8 * tg + i) * 272 + cch * 2) = (unsigned short)f2bf(xc[i]); }
            if (step + 1 < SEQ / 32) {
#pragma unroll
                for (int i = 0; i < 11; ++i) xb[i] = bld_bf(rxb, vo, (unsigned)(t0 + 32 - 3 + i) * 2048u);
#pragma unroll
                for (int i = 0; i < 8; ++i) yn[i] = bld_bf(ry, vo, (unsigned)(t0 + 32 + i) * 2048u);
            }
            __syncthreads();
            f32x4 ax[2], aa[2];
#pragma unroll
            for (int tb = 0; tb < 2; ++tb) { ax[tb] = (f32x4){0.f, 0.f, 0.f, 0.f}; aa[tb] = (f32x4){0.f, 0.f, 0.f, 0.f};
#pragma unroll
                for (int s = 0; s < 4; ++s) { const bf16x8 a = ld_b128(XCB + (16 * tb + l15) * 272 + 64 * s + 16 * q); ax[tb] = MFMA16(a, Bx[s], ax[tb]); aa[tb] = MFMA16(a, Ba[s], aa[tb]); } }
#pragma unroll
            for (int tb = 0; tb < 2; ++tb)
#pragma unroll
                for (int r = 0; r < 4; ++r) { const int t = 16 * tb + 4 * q + r;
                    const float gx = ax[tb][r] + bx, ga = aa[tb][r] + ba;
                    const float la = -sigmoidf_(ga) * sp8; const float a = expf(la); float mult = sqrtf(-expm1f(2.0f * la)); if (t0 + t == 0) mult = 1.0f;
                    const float u = sigmoidf_(gx) * XC[t * 128 + chl] * mult;
                    AL[t * 128 + chl] = a; UL[t * 128 + chl] = u; }
            __syncthreads();
            if (tid < 128) {
#pragma unroll 8
                for (int t = 0; t < 32; ++t) { h = AL[t * 128 + tid] * h + UL[t * 128 + tid]; HS[t * 128 + tid] = h; } }
            __syncthreads();
#pragma unroll
            for (int i = 0; i < 8; ++i) { const int t = 8 * tg + i; __builtin_amdgcn_raw_buffer_store_b16((unsigned short)f2bf(HS[t * 128 + cch] * yv[i]), rhy, vo, (unsigned)(t0 + i) * 2048u, 0); yv[i] = yn[i]; }
        }
        __syncthreads();
    }
}
struct GlaArgs { const bf16* Q; const bf16* K; const float* LOGF; const bf16* V; const bf16* G; const float* ALOW; const float *w2, *gb, *nw; bf16* OUT; float* SS; };
template <int DV, bool GLA>
__device__ __forceinline__ void gla_scan_phase(Frame& F, const GlaArgs A) {
    constexpr int NH = GLA ? 4 : 8, NCB = DV / 128, QLD = GLA ? 512 : 1024, NV = DV / 16, VTG = 512 / DV  , VTOK = 32 / VTG;
    LAS unsigned char* L = F.lds;
    LAS unsigned char* QT = L;
    LAS unsigned char* KT = L + 8704;
    LAS unsigned char* KHT = L + 17408;
    LAS unsigned char* VT = L + 27648;
    LAS float* DEC = (LAS float*)(L + 48128);
    LAS float* GT = (LAS float*)(L + 48640);
    LAS float* OB = (LAS float*)(L + 50688);
    LAS float* ALS = (LAS float*)(L + 83456);
    LAS float* NWL = (LAS float*)(L + 87552);
    int tid_ = threadIdx.x; asm volatile("" : "+v"(tid_));
    const int tid = tid_, lane = tid & 63, wave = __builtin_amdgcn_readfirstlane(tid >> 6), q = lane >> 4, l15 = lane & 15;
    const int kc = tid & 127, tg = wave >> 1, vdv = tid & (DV - 1), vtg = wave / (DV / 64), ot = tid >> 4, oc = tid & 15;
    for (int unit = blockIdx.x; unit < BATCH * NH; unit += gridDim.x) {
        const int b = unit / NH, hd = unit % NH; const size_t rowbase = (size_t)b * SEQ;
        f32x4 S[NCB][8];
#pragma unroll
        for (int cb = 0; cb < NCB; ++cb)
#pragma unroll
            for (int kt = 0; kt < 8; ++kt) S[cb][kt] = (f32x4){0.f, 0.f, 0.f, 0.f};
        const rsrc_t rq = mk_rsrc(A.Q + rowbase * QLD + hd * 128), rk = mk_rsrc(GLA ? (const void*)(A.K + rowbase * QLD + hd * 128) : (const void*)(A.LOGF + rowbase * D + hd * 128));
        const rsrc_t rv = mk_rsrc(A.V + rowbase * D + hd * DV), rg = mk_rsrc(A.G + rowbase * D + hd * DV), ro = mk_rsrc(A.OUT + rowbase * D + hd * DV), ral = mk_rsrc(GLA ? A.ALOW + rowbase * 16 : nullptr);
        const unsigned voq = (unsigned)(8 * tg * QLD + kc) * 2u, vok = GLA ? voq : (unsigned)(8 * tg * D + kc) * 4u, vov = (unsigned)(VTOK * vtg * D + vdv) * 2u, vog = (unsigned)(ot * D + oc * NV) * 2u;
        constexpr unsigned QST = QLD * 2u, KST = GLA ? QLD * 2u : D * 4u, VST = D * 2u;
        float w2r[16]; float gbv = 0.f;
        if (GLA) {
#pragma unroll
            for (int r = 0; r < 16; ++r) w2r[r] = A.w2[r * 512 + hd * 128 + kc];
            gbv = A.gb[hd * 128 + kc]; }
        if (tid < DV) NWL[tid] = A.nw[(GLA ? 0 : hd * 128) + tid];
        float qv[8], kv[8], alv = 0.f; unsigned short vv[VTOK]; v4u gg[NV / 8], ggn[NV / 8];
#pragma unroll
        for (int i = 0; i < 8; ++i) { qv[i] = bld_bf(rq, voq, (unsigned)i * QST); kv[i] = GLA ? bld_bf(rk, vok, (unsigned)i * KST) : bld_f32(rk, vok, (unsigned)i * KST); }
#pragma unroll
        for (int i = 0; i < VTOK; ++i) vv[i] = bld_u16(rv, vov, (unsigned)i * VST);
#pragma unroll
        for (int e = 0; e < NV / 8; ++e) gg[e] = bld_b128(rg, vog + 16u * e, 0u);
        if (GLA) { ALS[tid] = bld_f32(ral, (unsigned)tid * 4u, 0u); alv = bld_f32(ral, (unsigned)tid * 4u, 32u * 64u); }
        __syncthreads();
        for (int n = 0; n < SEQ / 32; ++n) {
            const unsigned r0 = (unsigned)n * 32u;
            float g[8], bl[8], kt_[8];
#pragma unroll
            for (int i = 0; i < 8; ++i) {
                if (GLA) { const LAS float* al = ALS + (n & 1) * 512 + (8 * tg + i) * 16; float z = gbv;
#pragma unroll
                    for (int r4 = 0; r4 < DBG_R4; ++r4) { const f32x4 a4 = *(const LAS f32x4*)(al + 4 * r4); z += a4[0] * w2r[4 * r4] + a4[1] * w2r[4 * r4 + 1] + a4[2] * w2r[4 * r4 + 2] + a4[3] * w2r[4 * r4 + 3]; }
                    g[i] = (fminf(z, 0.f) - log1pf(expf(-fabsf(z)))) * (1.0f / 16.0f); kt_[i] = kv[i]; }
                else { g[i] = kv[i]; kt_[i] = -expm1f(kv[i]); } }
            { float c = 0.f;
#pragma unroll
                for (int i = 0; i < 8; ++i) { c += g[i]; bl[i] = c; }
                GT[tg * 128 + kc] = c; }
            __syncthreads();
            { const float g0 = GT[kc], g1 = GT[128 + kc], g2 = GT[256 + kc], g3 = GT[384 + kc];
                const float off = (tg > 0 ? g0 : 0.f) + (tg > 1 ? g1 : 0.f) + (tg > 2 ? g2 : 0.f), tot = (g0 + g1) + (g2 + g3);
                const float qs = GLA ? 0.08838834764831845f : 1.0f;
                float kh[8];
#pragma unroll
                for (int i = 0; i < 8; ++i) { const float bb = bl[i] + off; const int t = 8 * tg + i;
                    *(LAS unsigned short*)(QT + t * 272 + kc * 2) = (unsigned short)f2bf(qv[i] * qs * expf(bb));
                    *(LAS unsigned short*)(KT + t * 272 + kc * 2) = (unsigned short)f2bf(kt_[i] * expf(-bb));
                    kh[i] = kt_[i] * expf(tot - bb); }
                v4u w; w.x = pk2(kh[0], kh[1]); w.y = pk2(kh[2], kh[3]); w.z = pk2(kh[4], kh[5]); w.w = pk2(kh[6], kh[7]);
                *(LAS v4u*)(KHT + kc * 80 + 16 * tg) = w;
                if (tg == 0) DEC[kc] = expf(tot); }
#pragma unroll
            for (int i8 = 0; i8 < VTOK / 8; ++i8) { v4u w; w.x = vv[8 * i8] | ((unsigned)vv[8 * i8 + 1] << 16); w.y = vv[8 * i8 + 2] | ((unsigned)vv[8 * i8 + 3] << 16); w.z = vv[8 * i8 + 4] | ((unsigned)vv[8 * i8 + 5] << 16); w.w = vv[8 * i8 + 6] | ((unsigned)vv[8 * i8 + 7] << 16);
                *(LAS v4u*)(VT + vdv * 80 + (VTOK * vtg + 8 * i8) * 2) = w; }
            if (n + 1 < SEQ / 32) { const unsigned rn = r0 + 32u;
#pragma unroll
                for (int i = 0; i < 8; ++i) { qv[i] = bld_bf(rq, voq, (rn + i) * QST); kv[i] = GLA ? bld_bf(rk, vok, (rn + i) * KST) : bld_f32(rk, vok, (rn + i) * KST); }
#pragma unroll
                for (int i = 0; i < VTOK; ++i) vv[i] = bld_u16(rv, vov, (rn + i) * VST);
#pragma unroll
                for (int e = 0; e < NV / 8; ++e) ggn[e] = bld_b128(rg, vog + 16u * e, rn * VST); }
            __syncthreads();
            if (GLA) { ALS[((n + 1) & 1) * 512 + tid] = alv; if (n + 2 < SEQ / 32) alv = bld_f32(ral, (unsigned)tid * 4u, (r0 + 64u) * 64u); }
            f32x4 P00 = {0.f, 0.f, 0.f, 0.f}, P01 = P00, P11 = P00;
#pragma unroll
            for (int s = 0; s < 4; ++s) { const bf16x8 KA0 = ld_b128(KT + l15 * 272 + 64 * s + 16 * q), KA1 = ld_b128(KT + (16 + l15) * 272 + 64 * s + 16 * q);
                const bf16x8 QB0 = ld_b128(QT + l15 * 272 + 64 * s + 16 * q), QB1 = ld_b128(QT + (16 + l15) * 272 + 64 * s + 16 * q);
                P00 = MFMA16(KA0, QB0, P00); P01 = MFMA16(KA0, QB1, P01); P11 = MFMA16(KA1, QB1, P11); }
#pragma unroll
            for (int r = 0; r < 4; ++r) if (l15 < 4 * q + r) { P00[r] = 0.f; P11[r] = 0.f; }
            const bf16x8 PA0 = pack8f(P00, (f32x4){0.f, 0.f, 0.f, 0.f}), PA1 = pack8f(P01, P11);
            bf16x8 VB[NCB];
#pragma unroll
            for (int cb = 0; cb < NCB; ++cb) { const LAS unsigned char* vr = VT + (16 * (wave * NCB + cb) + l15) * 80 + 8 * q; VB[cb] = ld_2xb64(vr, vr + 32); }
            f32x4 O[NCB][2];
#pragma unroll
            for (int cb = 0; cb < NCB; ++cb)
#pragma unroll
                for (int tb = 0; tb < 2; ++tb) O[cb][tb] = (f32x4){0.f, 0.f, 0.f, 0.f};
#pragma unroll
            for (int s = 0; s < 4; ++s) {
                bf16x8 QA[2];
#pragma unroll
                for (int tb = 0; tb < 2; ++tb) { const LAS unsigned char* qr = QT + (16 * tb + l15) * 272 + 64 * s + 8 * q; QA[tb] = ld_2xb64(qr, qr + 32); }
#pragma unroll
                for (int cb = 0; cb < NCB; ++cb) { const bf16x8 SB = pack8f(S[cb][2 * s], S[cb][2 * s + 1]);
                    O[cb][0] = MFMA16(QA[0], SB, O[cb][0]); O[cb][1] = MFMA16(QA[1], SB, O[cb][1]); } }
#pragma unroll
            for (int cb = 0; cb < NCB; ++cb) { O[cb][0] = MFMA16(PA0, VB[cb], O[cb][0]); O[cb][1] = MFMA16(PA1, VB[cb], O[cb][1]); }
#pragma unroll
            for (int kt = 0; kt < 8; ++kt) { const f32x4 dec = *(const LAS f32x4*)(DEC + 16 * kt + 4 * q);
                const LAS unsigned char* kr = KHT + (16 * kt + l15) * 80 + 8 * q; const bf16x8 KH = ld_2xb64(kr, kr + 32);
#pragma unroll
                for (int cb = 0; cb < NCB; ++cb) S[cb][kt] = MFMA16(KH, VB[cb], S[cb][kt] * dec); }
#pragma unroll
            for (int cb = 0; cb < NCB; ++cb)
#pragma unroll
                for (int tb = 0; tb < 2; ++tb)
#pragma unroll
                    for (int r = 0; r < 4; ++r) OB[(16 * tb + 4 * q + r) * DV + 16 * (wave * NCB + cb) + l15] = O[cb][tb][r];
#ifdef DBG_TRIVIAL
#pragma unroll
            for (int cb = 0; cb < NCB; ++cb)
#pragma unroll
                for (int tb = 0; tb < 2; ++tb)
#pragma unroll
                    for (int r = 0; r < 4; ++r) { const int t = 16 * tb + 4 * q + r, dv = 16 * (wave * NCB + cb) + l15;
                        float vsum = 0.f; if (DBG_TRIVIAL & 1) vsum += bf2f(*(const LAS unsigned short*)(VT + dv * 80 + t * 2)); if (DBG_TRIVIAL & 2) vsum += bf2f(*(const LAS unsigned short*)(QT + t * 272 + (dv & 127) * 2)); if (DBG_TRIVIAL & 4) vsum += bf2f(*(const LAS unsigned short*)(KHT + (dv & 127) * 80 + t * 2)); if (DBG_TRIVIAL & 8) vsum += 1.0f + 0.001f * (float)(t + dv);
                        OB[t * DV + dv] = vsum; }
#endif
            __syncthreads();
            { float o[NV]; float ss = 0.f;
#pragma unroll
                for (int e4 = 0; e4 < NV / 4; ++e4) { const f32x4 v = *(const LAS f32x4*)(OB + ot * DV + oc * NV + 4 * e4); o[4 * e4] = v[0]; o[4 * e4 + 1] = v[1]; o[4 * e4 + 2] = v[2]; o[4 * e4 + 3] = v[3]; ss += (v[0] * v[0] + v[1] * v[1]) + (v[2] * v[2] + v[3] * v[3]); }
                ss += __shfl_xor(ss, 1); ss += __shfl_xor(ss, 2); ss += __shfl_xor(ss, 4); ss += __shfl_xor(ss, 8);
                float rs = 1.0f;
                if (GLA) rs = 1.0f / sqrtf(ss * (1.0f / DV) + EPS); else if (oc == 0) A.SS[(rowbase + r0 + ot) * 8 + hd] = ss;
#pragma unroll
                for (int e8 = 0; e8 < NV / 8; ++e8) { const v4u gw_ = gg[e8]; float gf[8]; float nwr[NV];
                    { const f32x4 n0 = *(const LAS f32x4*)(NWL + oc * NV + 8 * e8), n1 = *(const LAS f32x4*)(NWL + oc * NV + 8 * e8 + 4); nwr[8 * e8] = n0[0]; nwr[8 * e8 + 1] = n0[1]; nwr[8 * e8 + 2] = n0[2]; nwr[8 * e8 + 3] = n0[3]; nwr[8 * e8 + 4] = n1[0]; nwr[8 * e8 + 5] = n1[1]; nwr[8 * e8 + 6] = n1[2]; nwr[8 * e8 + 7] = n1[3]; }
                    gf[0] = bf2f(gw_.x & 0xffffu); gf[1] = bf2f(gw_.x >> 16); gf[2] = bf2f(gw_.y & 0xffffu); gf[3] = bf2f(gw_.y >> 16); gf[4] = bf2f(gw_.z & 0xffffu); gf[5] = bf2f(gw_.z >> 16); gf[6] = bf2f(gw_.w & 0xffffu); gf[7] = bf2f(gw_.w >> 16);
                    v4u w; w.x = pk2(o[8 * e8] * rs * nwr[8 * e8] * gf[0], o[8 * e8 + 1] * rs * nwr[8 * e8 + 1] * gf[1]); w.y = pk2(o[8 * e8 + 2] * rs * nwr[8 * e8 + 2] * gf[2], o[8 * e8 + 3] * rs * nwr[8 * e8 + 3] * gf[3]);
                    w.z = pk2(o[8 * e8 + 4] * rs * nwr[8 * e8 + 4] * gf[4], o[8 * e8 + 5] * rs * nwr[8 * e8 + 5] * gf[5]); w.w = pk2(o[8 * e8 + 6] * rs * nwr[8 * e8 + 6] * gf[6], o[8 * e8 + 7] * rs * nwr[8 * e8 + 7] * gf[7]);
                    __builtin_amdgcn_raw_buffer_store_b128(w, ro, vog + 16u * e8, r0 * VST, 0); gg[e8] = ggn[e8]; } }
        }
        __syncthreads();
    }
}
constexpr int NPH = 1 + DEPTH * 10 + 1;
struct Args { const float* in[24]; float* out; unsigned char* ws; int ph_lo, ph_hi; };
#define AS4 __attribute__((address_space(4)))
#define KARG() ({ const AS4 Args* _p = (const AS4 Args*)__builtin_amdgcn_kernarg_segment_ptr(); asm volatile("" : "+s"(_p)); _p; })
#define KIN(i) ((const float*)KARG()->in[i])
#define KWS() ((unsigned char*)KARG()->ws)
__global__ void __launch_bounds__(NWAVES * 64, 2) mk_fwd(Args args_unused) {
    extern __shared__ __attribute__((aligned(16))) unsigned char lds[];
    Frame F;
    F.lds = (LAS unsigned char*)lds;
    F.MISC = (volatile LAS unsigned*)(F.lds + MISC_OFF);
    F.tid = threadIdx.x; F.lane = F.tid & 63; F.wave = __builtin_amdgcn_readfirstlane(F.tid >> 6);
    F.G = gridDim.x; { const int bx = blockIdx.x; F.vcu = (F.G % 8 == 0) ? (bx % 8) * (F.G / 8) + bx / 8 : bx; }
    F.ctl = (gu32*)(KWS() + WS_CTL);
    for (int u = F.tid; u < (LDS_BYTES - LDSCTL_OFF) / 4; u += NWAVES * 64) ((LAS unsigned*)(F.lds + LDSCTL_OFF))[u] = 0u;
    __syncthreads();
    XcdBarrier bar = xcd_barrier_post((unsigned*)(F.ctl + CW_BAR), F.MISC + 8);
#if MK_N_LAUNCHES == 1
#define RUN() true
#define SEAM() xcd_barrier(bar)
#else
    int pi = 0;
#define RUN() (KARG()->ph_lo == pi)
#define SEAM() (++pi)
#endif
    if (RUN()) { const AS4 Args* a = KARG(); ProIn P{a->in[1], a->in[2], a->in[3], a->in[6], a->in[7], a->in[8], a->in[11], a->in[14], a->in[15], a->in[16], a->in[18], a->in[19], a->in[23]};
        p0_prologue(F, P, KWS()); }
    SEAM();
    for (int l = 0; l < DEPTH; ++l) {
        for (int s = 0; s < 3; ++s) {
#ifdef DBG_NSUB
            if (l * 3 + s >= DBG_NSUB) continue;
#endif
            if (RUN()) { unsigned char* ws = KWS(); const float* modl = (const float*)(ws + WS_MOD) + (size_t)l * BATCH * (NMOD * D);
                const float* xcur = (l == 0 && s == 0) ? KIN(0) : (const float*)KARG()->out;
                norm_phase(F, xcur, KIN(4) + ((size_t)l * 3 + s) * D, modl + (3 * s) * D, modl + (3 * s + 1) * D, (bf16*)(ws + WS_H)); }
            SEAM();
            if (RUN()) { unsigned char* ws = KWS(); const bf16* H = (const bf16*)(ws + WS_H); unsigned char* SCR = ws + WS_SCR; const int mx = l % 3, mi = l / 3;
                if (s != 1) { const int fi = l * 2 + (s >> 1);
                    pg8::Gemm g{H, (const bf16*)(ws + WS_W13 + fi * W13_BYTES), M, 2 * FF, D}; pg8::StaticOrder S; S.init(M, 2 * FF, F.G, (int)blockIdx.x);
                    pg8::EpiSwiglu E{(bf16*)SCR, FF};
                    pg8::gemm_phase<pg8::EpiSwiglu, pg8::StaticOrder, true, true>(F.lds, g, S, E);
                }
#ifndef NO_MIXIN
                else if (mx == 0) {
                    pg8::Gemm g{H, (const bf16*)(ws + WS_RGIN + mi * RGIN_BYTES), M, 2048, D}; pg8::StaticOrder S; S.init(M, 2048, F.G, (int)blockIdx.x);
                    pg8::EpiRgIn E{(bf16*)SCR};
                    pg8::gemm_phase<pg8::EpiRgIn, pg8::StaticOrder, true, true>(F.lds, g, S, E);
                } else if (mx == 1) {
                    pg8::Gemm g{H, (const bf16*)(ws + WS_HGIN), M, 4096, D}; pg8::StaticOrder S; S.init(M, 4096, F.G, (int)blockIdx.x);
                    pg8::EpiHgIn E{(bf16*)SCR, (float*)(SCR + 3 * ACT_BYTES), (const float*)(ws + WS_LB)};
                    pg8::gemm_phase<pg8::EpiHgIn, pg8::StaticOrder, true, true>(F.lds, g, S, E);
                } else {
                    pg8::Gemm g{H, (const bf16*)(ws + WS_GLIN), M, GLA_INP, D}; pg8::StaticOrder S; S.init(M, GLA_INP, F.G, (int)blockIdx.x);
                    pg8::EpiGlIn E{(bf16*)SCR, (float*)(SCR + 3 * ACT_BYTES)};
                    pg8::gemm_phase<pg8::EpiGlIn, pg8::StaticOrder, true, true>(F.lds, g, S, E);
                }
#endif
            }
            SEAM();
            if (s == 1) {
                if (RUN()) {
#ifndef NO_SCANS
                    unsigned char* ws = KWS(); bf16* H = (bf16*)(ws + WS_H); unsigned char* SCR = ws + WS_SCR; const int mx = l % 3, mi = l / 3;
                    if (mx == 0) { RgArgs A{(const bf16*)SCR, (const bf16*)(SCR + ACT_BYTES), H, (const bf16*)(ws + WS_RGG + mi * RGG_BYTES), KIN(12) + (size_t)mi * 8 * 256, KIN(13) + (size_t)mi * D, KIN(9) + (size_t)mi * 4 * D, KIN(10) + (size_t)mi * D};
                        rg_scan_phase(F, A); }
                    else if (mx == 1) { GlaArgs A{(const bf16*)SCR, nullptr, (const float*)(SCR + 3 * ACT_BYTES), (const bf16*)(SCR + ACT_BYTES), (const bf16*)(SCR + 2 * ACT_BYTES), nullptr, nullptr, nullptr, KIN(17), H, (float*)(ws + WS_SS)};
                        gla_scan_phase<128, false>(F, A); }
                    else { GlaArgs A{(const bf16*)SCR, (const bf16*)(SCR + ACT_BYTES / 2), nullptr, (const bf16*)(SCR + ACT_BYTES), (const bf16*)(SCR + 2 * ACT_BYTES), (const float*)(SCR + 3 * ACT_BYTES), KIN(20), KIN(21), KIN(22), H, nullptr};
#if defined(DBG_COPY)
                        { int tq_ = threadIdx.x; asm volatile("" : "+v"(tq_)); const int gw = blockIdx.x * 512 + tq_;
                          for (size_t e = gw; e < (size_t)M * D; e += (size_t)gridDim.x * 512) { const size_t row = e >> 10; const int col = (int)(e & 1023);
                              float v = 0.f;
                              if (DBG_COPY & 1) v += bf2f(A.V[e]);
                              if (DBG_COPY & 2) v += bf2f(A.G[e]);
                              if (DBG_COPY & 4) v += bf2f(A.Q[row * 512 + (col & 511)]);
                              if (DBG_COPY & 8) v += bf2f(A.K[row * 512 + (col & 511)]);
                              if (DBG_COPY & 16) v += A.ALOW[row * 16 + (col & 15)];
                              H[e] = (bf16)f2bf(v); } }
#elif !defined(DBG_SKIP_GLSCAN)
                        gla_scan_phase<256, true>(F, A);
#endif
                    }
#endif
                }
                SEAM();
            }
            if (RUN()) { unsigned char* ws = KWS(); const int mx = l % 3, mi = l / 3;
                const float* xcur = (l == 0 && s == 0) ? KIN(0) : (const float*)KARG()->out;
                const float* modl = (const float*)(ws + WS_MOD) + (size_t)l * BATCH * (NMOD * D);
                const bf16* Ap; const bf16* Bp; int K; float fac; const float* ssp = nullptr;
                if (s != 1) { Ap = (const bf16*)(ws + WS_SCR); Bp = (const bf16*)(ws + WS_W2 + (l * 2 + (s >> 1)) * W2_BYTES); K = FF; fac = 0.5f; }
                else { Ap = (const bf16*)(ws + WS_H); K = D; fac = 1.0f;
                    if (mx == 0) Bp = (const bf16*)(ws + WS_RGOUT + mi * SQ_BYTES); else if (mx == 1) { Bp = (const bf16*)(ws + WS_HGOUT); ssp = (const float*)(ws + WS_SS); } else Bp = (const bf16*)(ws + WS_GLOUT); }
                pg8::Gemm g{Ap, Bp, M, D, K}; pg8::StaticOrder S; S.init(M, D, F.G, (int)blockIdx.x);
                pg8::EpiResid E{xcur, KARG()->out, modl + (3 * s + 2) * D, NMOD * D, fac, ssp};
                pg8::gemm_phase<pg8::EpiResid, pg8::StaticOrder, true, true>(F.lds, g, S, E);
            }
            SEAM();
        }
    }
#if defined(DBG_NSUB) && DBG_NSUB == 0
    if (RUN()) { float* xo = KARG()->out; final_norm_phase(F, KIN(0), KIN(5), xo); }
#else
    if (RUN()) { float* xo = KARG()->out; final_norm_phase(F, xo, KIN(5), xo); }
#endif
#undef RUN
#undef SEAM
}

extern "C" void kernel_launch(void* const* d_in, const int* in_sizes, int n_in, void* d_out, int out_size, void* d_ws, size_t ws_size, hipStream_t stream) {
    static int grid = 0;
    if (grid == 0) {
        if (n_in != 24 || in_sizes[0] != M * D || out_size != M * D || ws_size < WS_END) { fprintf(stderr, "kernel_launch: unexpected shapes (n_in %d, in0 %d, out %d, ws %zu < %zu); nothing launched\n", n_in, n_in > 0 ? in_sizes[0] : -1, out_size, ws_size, (size_t)WS_END); grid = -1; return; }
        int dev = 0, cus = 0, per_cu = 0;
        if (hipGetDevice(&dev) != hipSuccess || hipDeviceGetAttribute(&cus, hipDeviceAttributeMultiprocessorCount, dev) != hipSuccess) { grid = -1; return; }
        if (hipFuncSetAttribute((const void*)mk_fwd, hipFuncAttributeMaxDynamicSharedMemorySize, LDS_BYTES) != hipSuccess) { fprintf(stderr, "kernel_launch: hipFuncSetAttribute failed\n"); grid = -1; return; }
        if (hipOccupancyMaxActiveBlocksPerMultiprocessor(&per_cu, (const void*)mk_fwd, NWAVES * 64, LDS_BYTES) != hipSuccess || per_cu < 1)
            fprintf(stderr, "kernel_launch: note: occupancy query reports %d workgroups per CU\n", per_cu);
        (void)hipGetLastError();
        grid = cus;
    }
    if (grid < 0) return;
    if (hipMemsetAsync((char*)d_ws + WS_CTL, 0, CTL_ZERO_BYTES, stream) != hipSuccess) return;
    Args a{};
    for (int i = 0; i < 24; ++i) a.in[i] = (const float*)d_in[i];
    a.out = (float*)d_out; a.ws = (unsigned char*)d_ws;
#if MK_N_LAUNCHES == 1
    a.ph_lo = 0; a.ph_hi = NPH;
    hipLaunchKernelGGL(mk_fwd, dim3(grid), dim3(NWAVES * 64), LDS_BYTES, stream, a);
#else
    for (int p = 0; p < NPH; ++p) { a.ph_lo = p; a.ph_hi = p + 1; hipLaunchKernelGGL(mk_fwd, dim3(grid), dim3(NWAVES * 64), LDS_BYTES, stream, a); }
#endif
}
```

```cpp
#include <hip/hip_runtime.h>
#include <cstdio>
#include <cstdint>
#include <cmath>
#ifndef MK_N_LAUNCHES
#define MK_N_LAUNCHES 1
#endif
namespace pg8 {
#define PG8_LAS __attribute__((address_space(3)))
typedef unsigned short bf16_t;
typedef short bf16x8 __attribute__((ext_vector_type(8)));
typedef float f32x4 __attribute__((ext_vector_type(4)));
typedef unsigned u32x4 __attribute__((ext_vector_type(4)));
constexpr int BM = 256, BK = 64, HALF = 128, HTB = HALF * BK * 2  , STAGE_BYTES = 8 * HTB, NXCD = 8, WGM = 8;

__host__ __device__ __forceinline__ int lds_byte(int r, int c) { const int st = (r >> 4) * 2 + (c >> 5), rr = r & 15, cc = c & 31, ob = rr * 64 + cc * 2; return st * 1024 + (ob ^ (((ob >> 9) & 1) << 5)); }
__host__ __device__ __forceinline__ void stage_rc(int b, int& R, int& C) { const int st = b / 1024, sb = b % 1024, swz = sb ^ (((sb >> 9) & 1) << 5); R = (st >> 1) * 16 + swz / 64; C = (st & 1) * 32 + (swz % 64) / 2; }
__host__ __device__ __forceinline__ int perm32(int rho) { const int n = rho >> 4, i = rho & 15; return 8 * (i >> 2) + 4 * n + (i & 3); }

struct Unit { int pm, pn; };
struct Gemm { const bf16_t* A; const bf16_t* Bt; int M, N, K; };

struct StaticOrder {
    int nM, nN, nwg, G, c;
    __host__ __device__ void init(int M, int N, int G_, int c_) { nM = M / BM; nN = N / BM; nwg = nM * nN; G = G_; c = c_; }
    __host__ __device__ bool next(int i, Unit& u) const {
        const long L = (long)i * G + c; if (L >= nwg) return false;
        int wgid = (int)L; { const int q = nwg / NXCD, r = nwg % NXCD, xcd = wgid % NXCD, off = wgid / NXCD; wgid = (xcd < r ? xcd * (q + 1) : r * (q + 1) + (xcd - r) * q) + off; }
        const int nig = WGM * nN, gid = wgid / nig, fm = gid * WGM, gsz = (nM - fm) < WGM ? (nM - fm) : WGM;
        u.pm = fm + ((wgid % nig) % gsz); u.pn = (wgid % nig) / gsz; return true;
    }
    __device__ __forceinline__ void a_ready(const Unit&) const {}
    __device__ __forceinline__ void done(const Unit&) const {}
};

typedef float f32x2_t __attribute__((ext_vector_type(2))); typedef __bf16 bf16x2_t __attribute__((ext_vector_type(2)));
__device__ __forceinline__ unsigned cvt_pk_bf16(float lo, float hi) { const f32x2_t v = {lo, hi}; const bf16x2_t b = __builtin_convertvector(v, bf16x2_t); return __builtin_bit_cast(unsigned, b); }
__device__ __forceinline__ u32x4 pack8(const f32x4 a, const f32x4 b) { u32x4 w; w.x = cvt_pk_bf16(a[0], a[1]); w.y = cvt_pk_bf16(a[2], a[3]); w.z = cvt_pk_bf16(b[0], b[1]); w.w = cvt_pk_bf16(b[2], b[3]); return w; }
__device__ __forceinline__ float fast_sigmoid(float x) { return __builtin_amdgcn_rcpf(1.0f + __builtin_amdgcn_exp2f(-1.4426950408889634f * x)); }
__device__ __forceinline__ f32x4 sigmoid4(const f32x4 v) { f32x4 o; o[0] = fast_sigmoid(v[0]); o[1] = fast_sigmoid(v[1]); o[2] = fast_sigmoid(v[2]); o[3] = fast_sigmoid(v[3]); return o; }
__device__ __forceinline__ f32x4 silu4(const f32x4 v) { return v * sigmoid4(v); }
__device__ __forceinline__ f32x4 gelu_tanh4(const f32x4 v) { const f32x4 z = v * (1.5957691216057308f + 0.07135481627260025f * (v * v)); return v * sigmoid4(z); }

struct EpiSwiglu {
    static constexpr bool PERM = true, AFTER_DRAIN = false;
    bf16_t* O; int ldc;
    __device__ __forceinline__ void operator()(const f32x4 (&acc)[2][2][4][2], const Unit& u, int wr, int wc, int fr, int fq) const {
        const int row0 = u.pm * BM + wr * 64 + fr, col0 = u.pn * HALF + wc * 32 + 8 * fq;
#pragma unroll
        for (int ai = 0; ai < 2; ++ai)
#pragma unroll
            for (int m = 0; m < 4; ++m) { bf16_t* rowp = O + (size_t)(row0 + ai * HALF + m * 16) * ldc + col0;
                const f32x4 v0 = silu4(acc[ai][0][m][0]) * acc[ai][1][m][0], v1 = silu4(acc[ai][0][m][1]) * acc[ai][1][m][1];
                *(u32x4*)rowp = pack8(v0, v1); }
    }
};
struct EpiRgIn {
    static constexpr bool PERM = true, AFTER_DRAIN = false;
    bf16_t* Y;
    __device__ __forceinline__ void operator()(const f32x4 (&acc)[2][2][4][2], const Unit& u, int wr, int wc, int fr, int fq) const {
        const int row0 = u.pm * BM + wr * 64 + fr; const bool isy = u.pn < 4;
        bf16_t* base = Y + (size_t)(isy ? 0 : 1) * ((size_t)65536 * 1024) + (u.pn & 3) * BM + wc * 32 + 8 * fq;
#pragma unroll
        for (int ai = 0; ai < 2; ++ai)
#pragma unroll
            for (int m = 0; m < 4; ++m) { bf16_t* rowp = base + (size_t)(row0 + ai * HALF + m * 16) * 1024;
#pragma unroll
                for (int bj = 0; bj < 2; ++bj) { f32x4 v0 = acc[ai][bj][m][0], v1 = acc[ai][bj][m][1];
                    if (isy) { v0 = gelu_tanh4(v0); v1 = gelu_tanh4(v1); }
                    *(u32x4*)(rowp + bj * HALF) = pack8(v0, v1); } }
    }
};
struct EpiHgIn {
    static constexpr bool PERM = true, AFTER_DRAIN = false;
    bf16_t* Q; float* LOGF; const float* lb;
    __device__ __forceinline__ void operator()(const f32x4 (&acc)[2][2][4][2], const Unit& u, int wr, int wc, int fr, int fq) const {
        const int row0 = u.pm * BM + wr * 64 + fr, sec = u.pn >> 2, colw = (u.pn & 3) * BM + wc * 32 + 8 * fq;
        if (sec == 1) {
#pragma unroll
            for (int bj = 0; bj < 2; ++bj) { const f32x4 l0 = *(const f32x4*)(lb + colw + bj * HALF), l1 = *(const f32x4*)(lb + colw + bj * HALF + 4);
#pragma unroll
                for (int ai = 0; ai < 2; ++ai)
#pragma unroll
                    for (int m = 0; m < 4; ++m) { float* rowp = LOGF + (size_t)(row0 + ai * HALF + m * 16) * 1024 + colw + bj * HALF;
                        const f32x4 s0 = sigmoid4(acc[ai][bj][m][0]), s1 = sigmoid4(acc[ai][bj][m][1]);
                        const f32x4 f0 = l0 + (1.0f - l0) * s0, f1 = l1 + (1.0f - l1) * s1; f32x4 o0, o1;
#pragma unroll
                        for (int e = 0; e < 4; ++e) { o0[e] = __logf(f0[e]); o1[e] = __logf(f1[e]); }
                        *(f32x4*)rowp = o0; *(f32x4*)(rowp + 4) = o1; } }
        } else {
            bf16_t* base = Q + (size_t)(sec - (sec > 0 ? 1 : 0)) * ((size_t)65536 * 1024) + colw;
#pragma unroll
            for (int ai = 0; ai < 2; ++ai)
#pragma unroll
                for (int m = 0; m < 4; ++m) { bf16_t* rowp = base + (size_t)(row0 + ai * HALF + m * 16) * 1024;
#pragma unroll
                    for (int bj = 0; bj < 2; ++bj) { f32x4 v0 = acc[ai][bj][m][0], v1 = acc[ai][bj][m][1];
                        if (sec == 3) { v0 = sigmoid4(v0); v1 = sigmoid4(v1); }
                        *(u32x4*)(rowp + bj * HALF) = pack8(v0, v1); } }
        }
    }
};
struct EpiGlIn {
    static constexpr bool PERM = true, AFTER_DRAIN = false;
    bf16_t* Q; float* ALOW;
    __device__ __forceinline__ void operator()(const f32x4 (&acc)[2][2][4][2], const Unit& u, int wr, int wc, int fr, int fq) const {
        const int row0 = u.pm * BM + wr * 64 + fr, pn = u.pn;
        if (pn == 12) {
            if (wc == 0 && fq < 2) {
#pragma unroll
                for (int ai = 0; ai < 2; ++ai)
#pragma unroll
                    for (int m = 0; m < 4; ++m) { float* rowp = ALOW + (size_t)(row0 + ai * HALF + m * 16) * 16 + 8 * fq;
                        *(f32x4*)rowp = acc[ai][0][m][0]; *(f32x4*)(rowp + 4) = acc[ai][0][m][1]; }
            }
            return;
        }
        const int g2 = pn >= 2 ? 1 : 0, g4 = pn >= 4 ? 1 : 0, g8 = pn >= 8 ? 1 : 0; const int ld = 512 + 512 * g4;
        bf16_t* base = Q + (size_t)(g2 + g4 + 2 * g8) * ((size_t)65536 * 512) + (pn - 2 * g2 - 2 * g4 - 4 * g8) * BM;
        base += wc * 32 + 8 * fq; const bool act = pn >= 8;
#pragma unroll
        for (int ai = 0; ai < 2; ++ai)
#pragma unroll
            for (int m = 0; m < 4; ++m) { bf16_t* rowp = base + (size_t)(row0 + ai * HALF + m * 16) * ld;
#pragma unroll
                for (int bj = 0; bj < 2; ++bj) { f32x4 v0 = acc[ai][bj][m][0], v1 = acc[ai][bj][m][1];
                    if (act) { v0 = silu4(v0); v1 = silu4(v1); }
                    *(u32x4*)(rowp + bj * HALF) = pack8(v0, v1); } }
    }
};
struct EpiResid {
    static constexpr bool PERM = false, AFTER_DRAIN = false;
    const float* base; float* out; const float* coef; int cstride; float fac; const float* ss;
    __device__ __forceinline__ void operator()(const f32x4 (&acc)[2][2][4][2], const Unit& u, int wr, int wc, int fr, int fq) const {
        const int row0 = u.pm * BM + wr * 64 + fr, col0 = u.pn * BM + wc * 32 + 4 * fq;
        const float* cf = coef + (size_t)(u.pm >> 3) * cstride + col0;
        f32x4 cv[2][2];
#pragma unroll
        for (int bj = 0; bj < 2; ++bj)
#pragma unroll
            for (int n = 0; n < 2; ++n) cv[bj][n] = *(const f32x4*)(cf + bj * HALF + n * 16) * fac;
#pragma unroll
        for (int ai = 0; ai < 2; ++ai)
#pragma unroll
            for (int m = 0; m < 4; ++m) { const int row = row0 + ai * HALF + m * 16; const size_t off = (size_t)row * 1024 + col0;
                float rs = 1.0f;
                if (ss) { const f32x4 a = *(const f32x4*)(ss + (size_t)row * 8), b = *(const f32x4*)(ss + (size_t)row * 8 + 4);
                    rs = 1.0f / sqrtf(((a[0] + a[1]) + (a[2] + a[3]) + (b[0] + b[1]) + (b[2] + b[3])) * (1.0f / 1024.0f) + 1e-6f); }
#pragma unroll
                for (int bj = 0; bj < 2; ++bj)
#pragma unroll
                    for (int n = 0; n < 2; ++n) { const f32x4 bs = *(const f32x4*)(base + off + bj * HALF + n * 16);
                        *(f32x4*)(out + off + bj * HALF + n * 16) = bs + (cv[bj][n] * rs) * acc[ai][bj][m][n]; } }
    }
};

template <class Epi, class Sched, bool ALIGN_EPI = false, bool SP2 = false>
__device__ __forceinline__ void gemm_phase(PG8_LAS unsigned char* lds, const Gemm g, const Sched& S, const Epi& E, const int wave_id) {
    int tid_ = wave_id * 64 + (int)__builtin_amdgcn_mbcnt_hi(~0u, __builtin_amdgcn_mbcnt_lo(~0u, 0u)); asm volatile("" : "+v"(tid_));
    const int tid = tid_, wid = wave_id, lane = tid & 63, wr = wid >> 2, wc = wid & 3, fr = lane & 15, fq = lane >> 4;
    const int K = g.K, nt = K / BK;
    unsigned voffA[2], voffB[2];
#pragma unroll
    for (int i = 0; i < 2; ++i) { int R, C; stage_rc(tid * 16 + i * 8192, R, C); const int Rb = Epi::PERM ? ((R & ~31) + perm32(R & 31)) : R;
        voffA[i] = (unsigned)(R * K + C) * 2u; voffB[i] = (unsigned)(Rb * K + C) * 2u; }
    const size_t kstep = (size_t)(BK * 2);
    const size_t hstep = (size_t)HALF * K * 2;
    const size_t tstep = 2 * hstep;
    const unsigned ldsw = (unsigned)wid * 1024u;
    const int aoff = lds_byte(wr * 64 + fr, fq * 8), boff = lds_byte(wc * 32 + fr, fq * 8);
#define PG8_SA(b, h) (((b) * 2 + (h)) * HTB)
#define PG8_SB(b, h) ((4 + (b) * 2 + (h)) * HTB)
#define PG8_STAGE(bufoff, gbase, voff) do { _Pragma("unroll") for (int _i = 0; _i < 2; ++_i) \
        __builtin_amdgcn_global_load_lds((const unsigned*)((const char*)(gbase) + (voff)[_i]), (PG8_LAS unsigned*)(lds + (bufoff) + ldsw + _i * 8192), 16, 0, 0); } while (0)
#define PG8_LDA(dst, b, h) do { _Pragma("unroll") for (int m = 0; m < 4; ++m) _Pragma("unroll") for (int k = 0; k < 2; ++k) dst[m][k] = *(const PG8_LAS bf16x8*)(lds + PG8_SA(b, h) + aoff + m * 2048 + k * 1024); } while (0)
#define PG8_LDB(dst, b, h) do { _Pragma("unroll") for (int n = 0; n < 2; ++n) _Pragma("unroll") for (int k = 0; k < 2; ++k) dst[n][k] = *(const PG8_LAS bf16x8*)(lds + PG8_SB(b, h) + boff + n * 2048 + k * 1024); } while (0)
#define PG8_MMA(ai, bj, At, Bt) do { __builtin_amdgcn_s_setprio(1); _Pragma("unroll") for (int m = 0; m < 4; ++m) _Pragma("unroll") for (int n = 0; n < 2; ++n) _Pragma("unroll") for (int k = 0; k < 2; ++k) \
        acc[ai][bj][m][n] = __builtin_amdgcn_mfma_f32_16x16x32_bf16(Bt[n][k], At[m][k], acc[ai][bj][m][n], 0, 0, 0); __builtin_amdgcn_s_setprio(0); } while (0)
#define PG8_WAIT_V(n) asm volatile("s_waitcnt vmcnt(" #n ")" ::: "memory")
#define PG8_WAIT_L(n) asm volatile("s_waitcnt lgkmcnt(" #n ")" ::: "memory")
#define PG8_BAR __builtin_amdgcn_s_barrier()
#define PG8_SCHED __builtin_amdgcn_sched_barrier(0)
    Unit cur, nxt; int ui = 0;
    if (!S.next(0, cur)) return;
    f32x4 acc[2][2][4][2];
#pragma unroll
    for (int a = 0; a < 2; ++a)
#pragma unroll
        for (int b = 0; b < 2; ++b)
#pragma unroll
            for (int m = 0; m < 4; ++m)
#pragma unroll
                for (int n = 0; n < 2; ++n) acc[a][b][m][n] = (f32x4){0.f, 0.f, 0.f, 0.f};
    bf16x8 At[4][2], B0[2][2], B1[2][2];
    const char* cA = (const char*)g.A + (size_t)cur.pm * tstep; const char* cB = (const char*)g.Bt + (size_t)cur.pn * tstep;
    S.a_ready(cur);
    if constexpr (SP2) {
        PG8_STAGE(PG8_SB(0, 0), cB, voffB); PG8_STAGE(PG8_SB(0, 1), cB + hstep, voffB); PG8_STAGE(PG8_SA(0, 0), cA, voffA); PG8_STAGE(PG8_SA(0, 1), cA + hstep, voffA);
        if (wr == 1) PG8_BAR;
        PG8_WAIT_V(2); PG8_BAR;
        PG8_STAGE(PG8_SB(1, 0), cB + kstep, voffB); PG8_STAGE(PG8_SA(1, 0), cA + kstep, voffA); PG8_STAGE(PG8_SB(1, 1), cB + hstep + kstep, voffB);
        PG8_WAIT_V(6); PG8_BAR;
    } else {
        PG8_STAGE(PG8_SB(0, 0), cB, voffB); PG8_STAGE(PG8_SA(0, 0), cA, voffA); PG8_STAGE(PG8_SB(0, 1), cB + hstep, voffB); PG8_STAGE(PG8_SA(0, 1), cA + hstep, voffA);
        if (wr == 1) PG8_BAR;
        PG8_WAIT_V(4); PG8_BAR;
        PG8_STAGE(PG8_SB(1, 0), cB + kstep, voffB); PG8_STAGE(PG8_SA(1, 0), cA + kstep, voffA); PG8_STAGE(PG8_SB(1, 1), cB + hstep + kstep, voffB);
        PG8_WAIT_V(6); PG8_BAR;
    }
    for (;;) {
        const bool has_next = S.next(ui + 1, nxt);
        const char* nA = has_next ? (const char*)g.A + (size_t)nxt.pm * tstep : cA; const char* nB = has_next ? (const char*)g.Bt + (size_t)nxt.pn * tstep : cB;
        for (int t = 0; t < nt; t += 2) {
            const bool last = (t == nt - 2);
            const char* a1 = cA + (size_t)(t + 1) * kstep;
            const char* a2 = last ? nA : cA + (size_t)(t + 2) * kstep; const char* b2 = last ? nB : cB + (size_t)(t + 2) * kstep;
            const char* a3 = a2 + kstep; const char* b3 = b2 + kstep;
            if (last && has_next) S.a_ready(nxt);
            if constexpr (SP2) {
            PG8_LDB(B0, 0, 0); PG8_LDB(B1, 0, 1); PG8_SCHED; PG8_LDA(At, 0, 0); PG8_STAGE(PG8_SA(1, 1), a1 + hstep, voffA);
            PG8_WAIT_V(8); PG8_WAIT_L(0); PG8_BAR; PG8_MMA(0, 0, At, B0); PG8_MMA(0, 1, At, B1); PG8_BAR; PG8_SCHED;
            PG8_LDA(At, 0, 1); PG8_STAGE(PG8_SB(0, 0), b2, voffB); PG8_STAGE(PG8_SB(0, 1), b2 + hstep, voffB); PG8_STAGE(PG8_SA(0, 0), a2, voffA);
            PG8_WAIT_V(8); PG8_WAIT_L(0); PG8_BAR; PG8_MMA(1, 0, At, B0); PG8_MMA(1, 1, At, B1); PG8_BAR; PG8_SCHED;
            PG8_LDB(B0, 1, 0); PG8_LDB(B1, 1, 1); PG8_SCHED; PG8_LDA(At, 1, 0); PG8_STAGE(PG8_SA(0, 1), a2 + hstep, voffA);
            PG8_WAIT_V(8); PG8_WAIT_L(0); PG8_BAR; PG8_MMA(0, 0, At, B0); PG8_MMA(0, 1, At, B1); PG8_BAR; PG8_SCHED;
            PG8_LDA(At, 1, 1); PG8_STAGE(PG8_SB(1, 0), b3, voffB); PG8_STAGE(PG8_SB(1, 1), b3 + hstep, voffB); PG8_STAGE(PG8_SA(1, 0), a3, voffA);
            PG8_WAIT_V(8); PG8_WAIT_L(0); PG8_BAR; PG8_MMA(1, 0, At, B0); PG8_MMA(1, 1, At, B1); PG8_BAR; PG8_SCHED;
            } else {
            PG8_LDB(B0, 0, 0); PG8_SCHED; PG8_LDA(At, 0, 0); PG8_STAGE(PG8_SA(1, 1), a1 + hstep, voffA);
            PG8_WAIT_L(8); PG8_BAR; PG8_WAIT_L(0); PG8_MMA(0, 0, At, B0); PG8_BAR; PG8_SCHED;
            PG8_LDB(B1, 0, 1); PG8_STAGE(PG8_SB(0, 0), b2, voffB);
            PG8_BAR; PG8_WAIT_L(0); PG8_MMA(0, 1, At, B1); PG8_BAR;
            PG8_LDA(At, 0, 1); PG8_STAGE(PG8_SA(0, 0), a2, voffA);
            PG8_BAR; PG8_WAIT_L(0); PG8_MMA(1, 0, At, B0); PG8_BAR; PG8_SCHED;
            PG8_STAGE(PG8_SB(0, 1), b2 + hstep, voffB);
            PG8_WAIT_V(6); PG8_BAR; PG8_MMA(1, 1, At, B1); PG8_BAR;
            PG8_LDB(B0, 1, 0); PG8_SCHED; PG8_LDA(At, 1, 0); PG8_STAGE(PG8_SA(0, 1), a2 + hstep, voffA);
            PG8_WAIT_L(8); PG8_BAR; PG8_WAIT_L(0); PG8_MMA(0, 0, At, B0); PG8_BAR; PG8_SCHED;
            PG8_LDB(B1, 1, 1); PG8_STAGE(PG8_SB(1, 0), b3, voffB);
            PG8_BAR; PG8_WAIT_L(0); PG8_MMA(0, 1, At, B1); PG8_BAR;
            PG8_LDA(At, 1, 1); PG8_STAGE(PG8_SA(1, 0), a3, voffA);
            PG8_BAR; PG8_WAIT_L(0); PG8_MMA(1, 0, At, B0); PG8_BAR; PG8_SCHED;
            PG8_STAGE(PG8_SB(1, 1), b3 + hstep, voffB);
            PG8_WAIT_V(6); PG8_BAR; PG8_MMA(1, 1, At, B1); PG8_BAR;
            }
        }
        if constexpr (ALIGN_EPI) { if (wr == 0) PG8_BAR; }
        if constexpr (!Epi::AFTER_DRAIN) { E(acc, cur, wr, wc, fr, fq); S.done(cur); }
        if (!has_next) break;
#pragma unroll
        for (int a = 0; a < 2; ++a)
#pragma unroll
            for (int b = 0; b < 2; ++b)
#pragma unroll
                for (int m = 0; m < 4; ++m)
#pragma unroll
                    for (int n = 0; n < 2; ++n) acc[a][b][m][n] = (f32x4){0.f, 0.f, 0.f, 0.f};
        cur = nxt; cA = nA; cB = nB; ++ui;
        if constexpr (ALIGN_EPI) { if (wr == 1) PG8_BAR; }
    }
    PG8_WAIT_V(0);
    if constexpr (!ALIGN_EPI) { if (wr == 0) PG8_BAR; }
    PG8_BAR;
    if constexpr (Epi::AFTER_DRAIN) { E.fused(acc, cur, wr, wc, fr, fq, lds, wid, lane); S.done(cur); }
#undef PG8_SA
#undef PG8_SB
#undef PG8_STAGE
#undef PG8_LDA
#undef PG8_LDB
#undef PG8_MMA
#undef PG8_WAIT_V
#undef PG8_WAIT_L
#undef PG8_BAR
#undef PG8_SCHED
}
}
constexpr int NWAVES = 8;
constexpr int BATCH = 32, SEQ = 2048, D = 1024, M = BATCH * SEQ, FF = 2816, DEPTH = 4, NMOD = 9;
constexpr int GLA_IN = 3088, GLA_INP = 3328;
constexpr float EPS = 1e-6f;
constexpr size_t MiB = 1u << 20;
constexpr size_t WS_CTL = 0, CTL_ZERO_BYTES = 1 * MiB;
constexpr size_t WS_MOD = 2 * MiB;
constexpr size_t WS_LB = 6 * MiB + 512 * 1024;
constexpr size_t WS_SS = 7 * MiB;
constexpr size_t WS_W13 = 10 * MiB, W13_BYTES = (size_t)2 * FF * D * 2;
constexpr size_t WS_W2 = 98 * MiB, W2_BYTES = (size_t)D * FF * 2;
constexpr size_t WS_RGIN = 142 * MiB, RGIN_BYTES = (size_t)2048 * D * 2;
constexpr size_t WS_RGG = 150 * MiB, RGG_BYTES = (size_t)8 * 256 * 128 * 2;
constexpr size_t WS_RGOUT = 151 * MiB, SQ_BYTES = (size_t)D * D * 2;
constexpr size_t WS_HGIN = 155 * MiB;
constexpr size_t WS_HGOUT = 163 * MiB;
constexpr size_t WS_GLIN = 165 * MiB;
constexpr size_t WS_GLOUT = 172 * MiB;
constexpr size_t WS_H = 176 * MiB;
constexpr size_t WS_SCR = 304 * MiB;
constexpr size_t ACT_BYTES = (size_t)M * D * 2;
constexpr size_t WS_END = WS_SCR + 5 * ACT_BYTES;
static_assert(WS_W13 + 8 * W13_BYTES <= WS_W2 && WS_W2 + 8 * W2_BYTES <= WS_RGIN && WS_RGIN + 2 * RGIN_BYTES <= WS_RGG && WS_RGG + 2 * RGG_BYTES <= WS_RGOUT && WS_RGOUT + 2 * SQ_BYTES <= WS_HGIN, "ws map 1");
static_assert(WS_HGIN + 4 * SQ_BYTES <= WS_HGOUT && WS_HGOUT + SQ_BYTES <= WS_GLIN && WS_GLIN + (size_t)GLA_INP * D * 2 <= WS_GLOUT && WS_GLOUT + SQ_BYTES <= WS_H && WS_H + ACT_BYTES <= WS_SCR, "ws map 2");
static_assert((size_t)M * FF * 2 <= 5 * ACT_BYTES, "hid fits");
constexpr int CW_TMO = 0, CW_BAR = 4096;
constexpr int RING_BYTES = 131072, LDSCTL_OFF = RING_BYTES, MISC_OFF = LDSCTL_OFF + 320, LDS_BYTES = 147456;

#define GAS __attribute__((address_space(1)))
#define LAS __attribute__((address_space(3)))
typedef unsigned short bf16;
typedef unsigned v4u __attribute__((ext_vector_type(4)));
typedef unsigned v2u __attribute__((ext_vector_type(2)));
typedef float f32x4 __attribute__((ext_vector_type(4)));
typedef float f32x16 __attribute__((ext_vector_type(16)));
typedef short bf16x8 __attribute__((ext_vector_type(8)));
typedef GAS unsigned gu32;
#define RLX_AGENT __ATOMIC_RELAXED, __HIP_MEMORY_SCOPE_AGENT
#define LDS_WAIT() asm volatile("s_waitcnt lgkmcnt(0)" ::: "memory")
#define VM_WAIT() asm volatile("s_waitcnt vmcnt(0)" ::: "memory")
__device__ __forceinline__ unsigned pk2(float lo, float hi) { return pg8::cvt_pk_bf16(lo, hi); }
__device__ __forceinline__ unsigned f2bf(float f) { return pg8::cvt_pk_bf16(f, 0.f) & 0xffffu; }
__device__ __forceinline__ float bf2f(unsigned h) { return __builtin_bit_cast(float, h << 16); }
__device__ __forceinline__ float sigmoidf_(float x) { return 1.0f / (1.0f + expf(-x)); }

__device__ __forceinline__ int lane_id() { return (int)__builtin_amdgcn_mbcnt_hi(~0u, __builtin_amdgcn_mbcnt_lo(~0u, 0u)); }
#define XB_TMO      128
#define XB_XCNT(j)  (256  + 64 * (j))
#define XB_XSUB(j)  (1280 + 64 * (j))
#define XB_XGEN(j)  (2304 + 64 * (j))
#define XB_TOP      3328
#define XB_TOPGEN   3392
#define XCD_BAR_WORDS 3456
#define XB_SPIN_CAP (1u << 18)

__device__ __forceinline__ unsigned xb_ld(unsigned* p)              { return __hip_atomic_load(p, __ATOMIC_RELAXED, __HIP_MEMORY_SCOPE_AGENT); }
__device__ __forceinline__ unsigned xb_add(unsigned* p, unsigned v) { return __hip_atomic_fetch_add(p, v, __ATOMIC_RELAXED, __HIP_MEMORY_SCOPE_AGENT); }
__device__ __forceinline__ unsigned xb_xcc_id() { return (unsigned)__builtin_amdgcn_s_getreg((3 << 11) | 20) & 0xFu; }
#define XB_SPIN(cond, bar) do { unsigned _sp = 0; while (cond) { __builtin_amdgcn_s_sleep(1); \
    if ((++_sp & 255u) == 0u) { if (xb_ld(&(bar)[XB_TMO])) break; if (_sp > XB_SPIN_CAP) { atomicAdd(&(bar)[XB_TMO], 1u); break; } } } } while (0)

struct XcdBarrier {
    unsigned* bar; unsigned x; int wave;
    volatile LAS unsigned* st;
};

__device__ __forceinline__ XcdBarrier xcd_barrier_post(unsigned* bar, volatile LAS unsigned* st) {
    XcdBarrier b; b.bar = bar; b.x = xb_xcc_id(); b.st = st;
    if (threadIdx.x == 0) (void)xb_add(&bar[XB_XCNT(b.x)], 1u);
    return b;
}
__device__ __forceinline__ void xcd_barrier_complete(unsigned* bar, unsigned x, unsigned& nloc, unsigned& nx) {
    const unsigned G = gridDim.x * gridDim.y * gridDim.z;
    unsigned sum, cnt, mine, sp = 0u;
    for (;;) {
        sum = 0u; cnt = 0u; mine = 0u;
#pragma unroll
        for (unsigned j = 0; j < 16; ++j) { const unsigned c = xb_ld(&bar[XB_XCNT(j)]); sum += c; cnt += (c > 0u) ? 1u : 0u; mine = (j == x) ? c : mine; }
        if (sum == G) break;
        __builtin_amdgcn_s_sleep(1);
        if ((++sp & 255u) == 0u) { if (xb_ld(&bar[XB_TMO])) break; if (sp > XB_SPIN_CAP) { atomicAdd(&bar[XB_TMO], 1u); break; } }
    }
    nloc = mine > 0u ? mine : 1u; nx = cnt > 0u ? cnt : 1u;
}

__device__ __forceinline__ void xcd_barrier(const XcdBarrier& b) {
    asm volatile("s_waitcnt vmcnt(0)" ::: "memory");
    __syncthreads();
    if (b.wave == 0 && (int)__builtin_amdgcn_mbcnt_hi(~0u, __builtin_amdgcn_mbcnt_lo(~0u, 0u)) == 0) {
        unsigned* bar = b.bar; unsigned bx_ = b.x; asm volatile("" : "+s"(bar), "+s"(bx_));
        __builtin_amdgcn_s_waitcnt(0);
        unsigned nloc = b.st[0], nx = b.st[1];
        if (nloc == 0u) { xcd_barrier_complete(bar, bx_, nloc, nx); b.st[0] = nloc; b.st[1] = nx; }
        const unsigned old = xb_add(&bar[XB_XSUB(bx_)], 1u);
        const unsigned gen = old / nloc;
        if (old + 1u == (gen + 1u) * nloc) {
            __builtin_amdgcn_fence(__ATOMIC_RELEASE, "agent");
            asm volatile("s_waitcnt vmcnt(0)" ::: "memory");
            const unsigned og = xb_add(&bar[XB_TOP], 1u);
            const unsigned tg = og / nx;
            if (og + 1u == (tg + 1u) * nx) xb_add(&bar[XB_TOPGEN], 1u);
            else XB_SPIN(xb_ld(&bar[XB_TOPGEN]) == tg, bar);
            __builtin_amdgcn_fence(__ATOMIC_ACQUIRE, "agent");
            xb_add(&bar[XB_XGEN(bx_)], 1u);
            asm volatile("s_waitcnt vmcnt(0)" ::: "memory");
        } else {
            XB_SPIN(xb_ld(&bar[XB_XGEN(bx_)]) == gen, bar);
            __builtin_amdgcn_fence(__ATOMIC_ACQUIRE, "agent");
            asm volatile("s_waitcnt vmcnt(0)" ::: "memory");
        }
    }
    __syncthreads();
}
struct Frame {
    LAS unsigned char* lds;
    volatile LAS unsigned* MISC;
    gu32* ctl;
    int wave, vcu, G;
};
__device__ __forceinline__ float wave_sum(float v) {
#pragma unroll
    for (int o = 1; o < 64; o <<= 1) v += __shfl_xor(v, o);
    return v;
}
__device__ __forceinline__ void conv_item(const float* W, int N, int k0, int n0, int nvalid, bf16* WT, int Kd, int drow0, LAS float* scr, int lane) {
    const bool ok = (lane & 31) < nvalid;
#pragma unroll 8
    for (int i = 0; i < 32; ++i) { const int kk = 2 * i + (lane >> 5); scr[kk * 33 + (lane & 31)] = ok ? W[(size_t)(k0 + kk) * N + n0 + (lane & 31)] : 0.f; }
    LDS_WAIT(); asm volatile("" ::: "memory");
    const int c = lane & 7;
#pragma unroll
    for (int j = 0; j < 4; ++j) { const int n = (lane >> 3) + 8 * j; const LAS float* s = scr + (8 * c) * 33 + n;
        v4u o; o.x = pk2(s[0 * 33], s[1 * 33]); o.y = pk2(s[2 * 33], s[3 * 33]); o.z = pk2(s[4 * 33], s[5 * 33]); o.w = pk2(s[6 * 33], s[7 * 33]);
        *(GAS v4u*)(WT + (size_t)(drow0 + n) * Kd + k0 + 8 * c) = o; }
    LDS_WAIT(); asm volatile("" ::: "memory");
}
struct ProIn { const float *c, *ada_w, *ada_b, *w13, *w2, *rg_w_in, *rg_gate_w, *rg_w_out, *hg_w_in, *hg_lb, *hg_w_out, *gla_w_in, *gla_w_out; };
__device__ __forceinline__ void p0_prologue(Frame& F, const ProIn& P, unsigned char* ws) {
    int lane_ = lane_id(); asm volatile("" : "+v"(lane_)); const int lane = lane_;
    int gw_ = F.wave * F.G + F.vcu; asm volatile("" : "+s"(gw_)); const int gw = gw_, NGW = F.G * NWAVES;
    float* MOD = (float*)(ws + WS_MOD);
    for (int blk = gw; blk < DEPTH * NMOD * D / 32; blk += NGW) {
        const int n0 = blk * 32, l = n0 / (NMOD * D), nn = n0 % (NMOD * D);
        const float* Wp = P.ada_w + (size_t)l * D * (NMOD * D) + nn + (lane & 31) + (size_t)(lane >> 5) * (NMOD * D);
        const float* Cp = P.c + (size_t)(lane & 31) * D + (lane >> 5);
        f32x16 acc = {};
        for (int k0 = 0; k0 < D; k0 += 16) {
            float wv[8], cv[8];
#pragma unroll
            for (int i = 0; i < 8; ++i) { wv[i] = Wp[(size_t)(k0 + 2 * i) * (NMOD * D)]; cv[i] = Cp[k0 + 2 * i]; }
#pragma unroll
            for (int i = 0; i < 8; ++i) { const float ca = cv[i] / (1.0f + expf(-cv[i])); acc = __builtin_amdgcn_mfma_f32_32x32x2f32(ca, wv[i], acc, 0, 0, 0); }
        }
        const float bias = P.ada_b[(size_t)l * (NMOD * D) + nn + (lane & 31)];
#pragma unroll
        for (int r = 0; r < 16; ++r) { const int b = (r & 3) + 8 * (r >> 2) + 4 * (lane >> 5); MOD[((size_t)l * BATCH + b) * (NMOD * D) + nn + (lane & 31)] = acc[r] + bias; }
    }
    if (F.vcu == 0) { float* LB = (float*)(ws + WS_LB);
        for (int ch = F.wave * 64 + lane; ch < D; ch += NWAVES * 64) { const float g0 = P.hg_lb[ch], g1 = P.hg_lb[D + ch], g2 = P.hg_lb[2 * D + ch], g3 = P.hg_lb[3 * D + ch];
            const float mx = fmaxf(fmaxf(g0, g1), fmaxf(g2, g3)); const float e0 = expf(g0 - mx), e1 = expf(g1 - mx), e2 = expf(g2 - mx), e3 = expf(g3 - mx);
            LB[ch] = e1 / (e0 + e1 + e2 + e3); } }
    LAS float* scr = (LAS float*)(F.lds + F.wave * 16384);
    int gw2_ = F.vcu * NWAVES + F.wave; asm volatile("" : "+s"(gw2_)); const int gw2 = gw2_;
    constexpr int I_W13 = 16 * 176, I_W2 = 44 * 32, I_RGIN = 16 * 64, I_RGG = 2 * 8, I_SQ = 16 * 32, I_HGIN = 16 * 128, I_GLIN = 16 * (GLA_INP / 32);
    constexpr int T0 = 8 * I_W13, T1 = T0 + 8 * I_W2, T2 = T1 + 2 * I_RGIN, T3 = T2 + 16 * I_RGG, T4 = T3 + 2 * I_SQ, T5 = T4 + I_HGIN, T6 = T5 + I_SQ, T7 = T6 + I_GLIN, T8 = T7 + I_SQ;
    for (int it = gw2; it < T8; it += NGW) {
        int r = it;
        if (r < T0) { const int mi = r / I_W13, q = r % I_W13, kb = q / 176, nb = q % 176, n0 = nb * 32;
            const int drow = n0 < FF ? (n0 / 128) * 256 + (n0 % 128) : ((n0 - FF) / 128) * 256 + 128 + ((n0 - FF) % 128);
            conv_item(P.w13 + (size_t)mi * D * 2 * FF, 2 * FF, kb * 64, n0, 32, (bf16*)(ws + WS_W13 + mi * W13_BYTES), D, drow, scr, lane); continue; }
        r -= T0;
        if (r < 8 * I_W2) { const int mi = r / I_W2, q = r % I_W2, kb = q / 32, nb = q % 32;
            conv_item(P.w2 + (size_t)mi * FF * D, D, kb * 64, nb * 32, 32, (bf16*)(ws + WS_W2 + mi * W2_BYTES), FF, nb * 32, scr, lane); continue; }
        r -= 8 * I_W2;
        if (r < 2 * I_RGIN) { const int mi = r / I_RGIN, q = r % I_RGIN, kb = q / 64, nb = q % 64;
            conv_item(P.rg_w_in + (size_t)mi * D * 2048, 2048, kb * 64, nb * 32, 32, (bf16*)(ws + WS_RGIN + mi * RGIN_BYTES), D, nb * 32, scr, lane); continue; }
        r -= 2 * I_RGIN;
        if (r < 16 * I_RGG) { const int mi = r / I_RGG, q = r % I_RGG, kb = q / 8, nb = q % 8;
            conv_item(P.rg_gate_w + (size_t)mi * 128 * 256, 256, kb * 64, nb * 32, 32, (bf16*)(ws + WS_RGG) + (size_t)mi * 256 * 128, 128, nb * 32, scr, lane); continue; }
        r -= 16 * I_RGG;
        if (r < 2 * I_SQ) { const int mi = r / I_SQ, q = r % I_SQ, kb = q / 32, nb = q % 32;
            conv_item(P.rg_w_out + (size_t)mi * D * D, D, kb * 64, nb * 32, 32, (bf16*)(ws + WS_RGOUT + mi * SQ_BYTES), D, nb * 32, scr, lane); continue; }
        r -= 2 * I_SQ;
        if (r < I_HGIN) { const int kb = r / 128, nb = r % 128;
            conv_item(P.hg_w_in, 4096, kb * 64, nb * 32, 32, (bf16*)(ws + WS_HGIN), D, nb * 32, scr, lane); continue; }
        r -= I_HGIN;
        if (r < I_SQ) { const int kb = r / 32, nb = r % 32;
            conv_item(P.hg_w_out, D, kb * 64, nb * 32, 32, (bf16*)(ws + WS_HGOUT), D, nb * 32, scr, lane); continue; }
        r -= I_SQ;
        if (r < I_GLIN) { const int kb = r / (GLA_INP / 32), nb = r % (GLA_INP / 32), n0 = nb * 32; const int nv = GLA_IN - n0 < 0 ? 0 : (GLA_IN - n0 > 32 ? 32 : GLA_IN - n0);
            conv_item(P.gla_w_in, GLA_IN, kb * 64, nv > 0 ? n0 : 0, nv, (bf16*)(ws + WS_GLIN), D, n0, scr, lane); continue; }
        r -= I_GLIN;
        { const int kb = r / 32, nb = r % 32;
            conv_item(P.gla_w_out, D, kb * 64, nb * 32, 32, (bf16*)(ws + WS_GLOUT), D, nb * 32, scr, lane); }
    }
}
__device__ __forceinline__ void norm_phase(Frame& F, const float* x, const float* nw, const float* shift, const float* scale, bf16* H) {
    int lane_ = lane_id(); asm volatile("" : "+v"(lane_)); const int lane = lane_;
    int gw_ = F.vcu * NWAVES + F.wave; asm volatile("" : "+s"(gw_)); const int gw = gw_, NGW = F.G * NWAVES;
    for (int strip = gw; strip < M / 32; strip += NGW) {
        const int b = (strip * 32) / SEQ;
        f32x4 gv[4], sv[4];
#pragma unroll
        for (int j = 0; j < 4; ++j) { const int col = 4 * lane + 256 * j;
            gv[j] = *(const f32x4*)(nw + col) * (1.0f + *(const f32x4*)(scale + (size_t)b * (NMOD * D) + col)); sv[j] = *(const f32x4*)(shift + (size_t)b * (NMOD * D) + col); }
        for (int rr = 0; rr < 32; ++rr) { const size_t row = (size_t)strip * 32 + rr;
            const GAS f32x4* xr = (const GAS f32x4*)(x + row * D) + lane;
            f32x4 v[4]; float s = 0.f;
#pragma unroll
            for (int j = 0; j < 4; ++j) { v[j] = xr[64 * j]; s += (v[j].x * v[j].x + v[j].y * v[j].y) + (v[j].z * v[j].z + v[j].w * v[j].w); }
            const float rstd = 1.0f / sqrtf(wave_sum(s) * (1.f / D) + EPS);
            GAS v2u* o8 = (GAS v2u*)(H + row * D) + lane;
#pragma unroll
            for (int j = 0; j < 4; ++j) { const f32x4 o = v[j] * rstd * gv[j] + sv[j]; v2u w; w.x = pk2(o.x, o.y); w.y = pk2(o.z, o.w); o8[64 * j] = w; }
        }
    }
}
__device__ __forceinline__ void final_norm_phase(Frame& F, const float* x, const float* w, float* out) {
    int lane_ = lane_id(); asm volatile("" : "+v"(lane_)); const int lane = lane_;
    int gw_ = F.vcu * NWAVES + F.wave; asm volatile("" : "+s"(gw_)); const int gw = gw_, NGW = F.G * NWAVES;
    f32x4 gv[4];
#pragma unroll
    for (int j = 0; j < 4; ++j) gv[j] = *(const f32x4*)(w + 4 * lane + 256 * j);
    for (int strip = gw; strip < M / 32; strip += NGW) {
        for (int rr = 0; rr < 32; ++rr) { const size_t row = (size_t)strip * 32 + rr;
            const GAS f32x4* xr = (const GAS f32x4*)(x + row * D) + lane;
            f32x4 v[4]; float s = 0.f;
#pragma unroll
            for (int j = 0; j < 4; ++j) { v[j] = xr[64 * j]; s += (v[j].x * v[j].x + v[j].y * v[j].y) + (v[j].z * v[j].z + v[j].w * v[j].w); }
            const float rstd = 1.0f / sqrtf(wave_sum(s) * (1.f / D) + EPS);
            GAS f32x4* o = (GAS f32x4*)(out + row * D) + lane;
#pragma unroll
            for (int j = 0; j < 4; ++j) o[64 * j] = v[j] * rstd * gv[j];
        }
    }
}
#define MFMA16(a, b, c) __builtin_amdgcn_mfma_f32_16x16x32_bf16((a), (b), (c), 0, 0, 0)
__device__ __forceinline__ bf16x8 ld_b128(const LAS unsigned char* p) { return *(const LAS bf16x8*)p; }
__device__ __forceinline__ bf16x8 ld_2xb64(const LAS unsigned char* p0, const LAS unsigned char* p1) { const v2u a = *(const LAS v2u*)p0, b = *(const LAS v2u*)p1; v4u w; w.x = a.x; w.y = a.y; w.z = b.x; w.w = b.y; return __builtin_bit_cast(bf16x8, w); }
__device__ __forceinline__ bf16x8 pack8f(const f32x4 a, const f32x4 b) { return __builtin_bit_cast(bf16x8, pg8::pack8(a, b)); }
#define LOG2E 1.4426950408889634f
#define LN2 0.6931471805599453f
__device__ __forceinline__ float fexp2(float x) { return __builtin_amdgcn_exp2f(x); }
__device__ __forceinline__ float frcp(float x) { return __builtin_amdgcn_rcpf(x); }
__device__ __forceinline__ float fsigm(float x) { return frcp(1.0f + fexp2(-LOG2E * x)); }
#ifndef DBG_R4
#define DBG_R4 4
#endif
typedef __amdgpu_buffer_rsrc_t rsrc_t;
__device__ __forceinline__ rsrc_t mk_rsrc(const void* p) { return __builtin_amdgcn_make_buffer_rsrc((void*)p, 0, 0x7fffffff, 0x00020000); }
__device__ __forceinline__ float bld_bf(rsrc_t r, unsigned voff, unsigned soff) { return bf2f((unsigned)__builtin_amdgcn_raw_buffer_load_b16(r, voff, soff, 0)); }
__device__ __forceinline__ unsigned short bld_u16(rsrc_t r, unsigned voff, unsigned soff) { return __builtin_amdgcn_raw_buffer_load_b16(r, voff, soff, 0); }
__device__ __forceinline__ float bld_f32(rsrc_t r, unsigned voff, unsigned soff) { return __builtin_bit_cast(float, __builtin_amdgcn_raw_buffer_load_b32(r, voff, soff, 0)); }
__device__ __forceinline__ v4u bld_b128(rsrc_t r, unsigned voff, unsigned soff) { return __builtin_amdgcn_raw_buffer_load_b128(r, voff, soff, 0); }
struct RgArgs { const bf16* Y; const bf16* XB; bf16* HY; const bf16* WgT; const float *gate_b, *lam, *conv_w, *conv_b; };
__device__ __forceinline__ void rg_scan_phase(Frame& F, const RgArgs A) {
    LAS unsigned char* L = F.lds;
    LAS float* XC = (LAS float*)L;
    LAS unsigned char* XCB = L + 16384;
    LAS float* AL = (LAS float*)(L + 25088);
    LAS float* UL = (LAS float*)(L + 41472);
    LAS float* HS = (LAS float*)(L + 57856);
    int tid_ = F.wave * 64 + lane_id(); asm volatile("" : "+v"(tid_));
    const int tid = tid_, lane = tid & 63, wave = F.wave, q = lane >> 4, l15 = lane & 15;
    const int cch = tid & 127, tg = wave >> 1, chl = 16 * wave + l15;
    for (int unit = blockIdx.x; unit < BATCH * 8; unit += gridDim.x) {
        const int b = unit >> 3, hd = unit & 7, colbase = hd * 128; const size_t rowbase = (size_t)b * SEQ;
        const bf16* Wg = A.WgT + (size_t)hd * 256 * 128;
        bf16x8 Bx[4], Ba[4];
#pragma unroll
        for (int s = 0; s < 4; ++s) { Bx[s] = *(const bf16x8*)(Wg + (size_t)chl * 128 + 32 * s + 8 * q); Ba[s] = *(const bf16x8*)(Wg + (size_t)(128 + chl) * 128 + 32 * s + 8 * q); }
        const float bx = A.gate_b[hd * 256 + chl], ba = A.gate_b[hd * 256 + 128 + chl];
        const float lamv = A.lam[colbase + chl]; const float sp8 = 8.0f * (fmaxf(-lamv, 0.f) + log1pf(expf(-fabsf(lamv))));
        const float cw0 = A.conv_w[colbase + cch], cw1 = A.conv_w[D + colbase + cch], cw2 = A.conv_w[2 * D + colbase + cch], cw3 = A.conv_w[3 * D + colbase + cch], cb = A.conv_b[colbase + cch];
        float h = 0.f;
        const rsrc_t rxb = mk_rsrc(A.XB + rowbase * D + colbase), ry = mk_rsrc(A.Y + rowbase * D + colbase), rhy = mk_rsrc(A.HY + rowbase * D + colbase);
        const unsigned vo = (unsigned)(8 * tg * D + cch) * 2u;
        float xb[11], yv[8], yn[8];
#pragma unroll
        for (int i = 0; i < 11; ++i) { const int t = 8 * tg - 3 + i; const float v = bld_bf(rxb, (unsigned)cch * 2u, (unsigned)(t < 0 ? 0 : t) * 2048u); xb[i] = t >= 0 ? v : 0.f; }
#pragma unroll
        for (int i = 0; i < 8; ++i) yv[i] = bld_bf(ry, vo, (unsigned)i * 2048u);
        for (int step = 0; step < SEQ / 32; ++step) {
            const int t0 = step * 32;
            float xc[8];
#pragma unroll
            for (int i = 0; i < 8; ++i) { xc[i] = cb + cw0 * xb[i] + cw1 * xb[i + 1] + cw2 * xb[i + 2] + cw3 * xb[i + 3];
                XC[(8 * tg + i) * 128 + cch] = xc[i]; *(LAS unsigned short*)(XCB + (8 * tg + i) * 272 + cch * 2) = (unsigned short)f2bf(xc[i]); }
            if (step + 1 < SEQ / 32) {
#pragma unroll
                for (int i = 0; i < 11; ++i) xb[i] = bld_bf(rxb, vo, (unsigned)(t0 + 32 - 3 + i) * 2048u);
#pragma unroll
                for (int i = 0; i < 8; ++i) yn[i] = bld_bf(ry, vo, (unsigned)(t0 + 32 + i) * 2048u);
            }
            __syncthreads();
            f32x4 ax[2], aa[2];
#pragma unroll
            for (int tb = 0; tb < 2; ++tb) { ax[tb] = (f32x4){0.f, 0.f, 0.f, 0.f}; aa[tb] = (f32x4){0.f, 0.f, 0.f, 0.f};
#pragma unroll
                for (int s = 0; s < 4; ++s) { const bf16x8 a = ld_b128(XCB + (16 * tb + l15) * 272 + 64 * s + 16 * q); ax[tb] = MFMA16(a, Bx[s], ax[tb]); aa[tb] = MFMA16(a, Ba[s], aa[tb]); } }
#pragma unroll
            for (int tb = 0; tb < 2; ++tb)
#pragma unroll
                for (int r = 0; r < 4; ++r) { const int t = 16 * tb + 4 * q + r;
                    const float gx = ax[tb][r] + bx, ga = aa[tb][r] + ba;
                    const float la = -fsigm(ga) * sp8; const float a = fexp2(LOG2E * la);
                    const float x2 = 2.0f * la;
                    const float ser = -x2 * (1.0f + x2 * (0.5f + x2 * (0.16666667f + x2 * (0.041666668f + x2 * 0.008333334f))));
                    float m2 = x2 > -0.25f ? ser : 1.0f - a * a; float mult = __builtin_amdgcn_sqrtf(m2); if (t0 + t == 0) mult = 1.0f;
                    const float u = fsigm(gx) * XC[t * 128 + chl] * mult;
                    AL[t * 128 + chl] = a; UL[t * 128 + chl] = u; }
            __syncthreads();
            float av[8], uv[8]; float P = 1.0f, Hl = 0.f;
#pragma unroll
            for (int i = 0; i < 8; ++i) { av[i] = AL[(8 * tg + i) * 128 + cch]; uv[i] = UL[(8 * tg + i) * 128 + cch]; Hl = av[i] * Hl + uv[i]; P *= av[i]; }
            HS[tg * 128 + cch] = P; HS[512 + tg * 128 + cch] = Hl;
            __syncthreads();
            { const float p0 = HS[cch], p1 = HS[128 + cch], p2 = HS[256 + cch], p3 = HS[384 + cch], h0 = HS[512 + cch], h1 = HS[640 + cch], h2 = HS[768 + cch], h3 = HS[896 + cch];
                const float c1 = p0 * h + h0, c2 = p1 * c1 + h1, c3 = p2 * c2 + h2, c4 = p3 * c3 + h3;
                float hh = tg == 0 ? h : (tg == 1 ? c1 : (tg == 2 ? c2 : c3)); h = c4;
#pragma unroll
                for (int i = 0; i < 8; ++i) { hh = av[i] * hh + uv[i]; __builtin_amdgcn_raw_buffer_store_b16((unsigned short)f2bf(hh * yv[i]), rhy, vo, (unsigned)(t0 + i) * 2048u, 0); yv[i] = yn[i]; } }
        }
        __syncthreads();
    }
}
struct GlaArgs { const bf16* Q; const bf16* K; const float* LOGF; const bf16* V; const bf16* G; const float* ALOW; const float *w2, *gb, *nw; bf16* OUT; float* SS; };
template <int DV, bool GLA>
__device__ __forceinline__ void gla_scan_phase(Frame& F, const GlaArgs A) {
    constexpr int NH = GLA ? 4 : 8, NCB = DV / 128, QLD = GLA ? 512 : 1024, NV = DV / 16, VTG = 512 / DV  , VTOK = 32 / VTG;
    LAS unsigned char* L = F.lds;
    LAS unsigned char* QT = L;
    LAS unsigned char* KT = L + 8704;
    LAS unsigned char* KHT = L + 17408;
    LAS unsigned char* VT = L + 27648;
    LAS float* DEC = (LAS float*)(L + 48128);
    LAS float* GT = (LAS float*)(L + 48640);
    LAS float* OB = (LAS float*)(L + 50688);
    LAS float* ALS = (LAS float*)(L + 83456);
    LAS float* NWL = (LAS float*)(L + 87552);
    int tid_ = F.wave * 64 + lane_id(); asm volatile("" : "+v"(tid_));
    const int tid = tid_, lane = tid & 63, wave = F.wave, q = lane >> 4, l15 = lane & 15;
    const int kc = tid & 127, tg = wave >> 1, vdv = tid & (DV - 1), vtg = wave / (DV / 64), ot = tid >> 4, oc = tid & 15;
    for (int unit = blockIdx.x; unit < BATCH * NH; unit += gridDim.x) {
        const int b = unit / NH, hd = unit % NH; const size_t rowbase = (size_t)b * SEQ;
        f32x4 S[NCB][8];
#pragma unroll
        for (int cb = 0; cb < NCB; ++cb)
#pragma unroll
            for (int kt = 0; kt < 8; ++kt) S[cb][kt] = (f32x4){0.f, 0.f, 0.f, 0.f};
        const rsrc_t rq = mk_rsrc(A.Q + rowbase * QLD + hd * 128), rk = mk_rsrc(GLA ? (const void*)(A.K + rowbase * QLD + hd * 128) : (const void*)(A.LOGF + rowbase * D + hd * 128));
        const rsrc_t rv = mk_rsrc(A.V + rowbase * D + hd * DV), rg = mk_rsrc(A.G + rowbase * D + hd * DV), ro = mk_rsrc(A.OUT + rowbase * D + hd * DV), ral = mk_rsrc(GLA ? A.ALOW + rowbase * 16 : nullptr);
        const unsigned voq = (unsigned)(8 * tg * QLD + kc) * 2u, vok = GLA ? voq : (unsigned)(8 * tg * D + kc) * 4u, vov = (unsigned)(VTOK * vtg * D + vdv) * 2u, vog = (unsigned)(ot * D + oc * NV) * 2u;
        constexpr unsigned QST = QLD * 2u, KST = GLA ? QLD * 2u : D * 4u, VST = D * 2u;
        float w2r[16]; float gbv = 0.f;
        if (GLA) {
#pragma unroll
            for (int r = 0; r < 16; ++r) w2r[r] = A.w2[r * 512 + hd * 128 + kc];
            gbv = A.gb[hd * 128 + kc]; }
        if (tid < DV) NWL[tid] = A.nw[(GLA ? 0 : hd * 128) + tid];
        float qv[8], kv[8], alv = 0.f; unsigned short vv[VTOK]; v4u gg[NV / 8], ggn[NV / 8];
#pragma unroll
        for (int i = 0; i < 8; ++i) { qv[i] = bld_bf(rq, voq, (unsigned)i * QST); kv[i] = GLA ? bld_bf(rk, vok, (unsigned)i * KST) : bld_f32(rk, vok, (unsigned)i * KST); }
#pragma unroll
        for (int i = 0; i < VTOK; ++i) vv[i] = bld_u16(rv, vov, (unsigned)i * VST);
#pragma unroll
        for (int e = 0; e < NV / 8; ++e) gg[e] = bld_b128(rg, vog + 16u * e, 0u);
        if (GLA) { ALS[tid] = bld_f32(ral, (unsigned)tid * 4u, 0u); alv = bld_f32(ral, (unsigned)tid * 4u, 32u * 64u); }
        __syncthreads();
        for (int n = 0; n < SEQ / 32; ++n) {
            const unsigned r0 = (unsigned)n * 32u;
            float bl[8], kt_[8];
            { float c = 0.f;
#pragma unroll
                for (int i = 0; i < 8; ++i) { float g2;
                    if (GLA) { const LAS float* al = ALS + (n & 1) * 512 + (8 * tg + i) * 16; float z = gbv;
#pragma unroll
                        for (int r4 = 0; r4 < 4; ++r4) { const f32x4 a4 = *(const LAS f32x4*)(al + 4 * r4); z += a4[0] * w2r[4 * r4] + a4[1] * w2r[4 * r4 + 1] + a4[2] * w2r[4 * r4 + 2] + a4[3] * w2r[4 * r4 + 3]; }
                        g2 = (fminf(z, 0.f) * LOG2E - __builtin_amdgcn_logf(1.0f + fexp2(-LOG2E * fabsf(z)))) * (1.0f / 16.0f); kt_[i] = kv[i]; }
                    else { g2 = kv[i] * LOG2E; kt_[i] = 1.0f - fexp2(g2); }
                    c += g2; bl[i] = c; }
                GT[tg * 128 + kc] = c; }
            __syncthreads();
            { const float g0 = GT[kc], g1 = GT[128 + kc], g2 = GT[256 + kc], g3 = GT[384 + kc];
                const float off = (tg > 0 ? g0 : 0.f) + (tg > 1 ? g1 : 0.f) + (tg > 2 ? g2 : 0.f), tot = (g0 + g1) + (g2 + g3);
                const float qs = GLA ? 0.08838834764831845f : 1.0f, etot = fexp2(tot);
                float kh[8];
#pragma unroll
                for (int i = 0; i < 8; ++i) { const float bb = bl[i] + off; const int t = 8 * tg + i; const float e1 = fexp2(bb), e2 = frcp(e1);
                    *(LAS unsigned short*)(QT + t * 272 + kc * 2) = (unsigned short)f2bf(qv[i] * qs * e1);
                    const float k2 = kt_[i] * e2;
                    *(LAS unsigned short*)(KT + t * 272 + kc * 2) = (unsigned short)f2bf(k2);
                    kh[i] = k2 * etot; }
                v4u w; w.x = pk2(kh[0], kh[1]); w.y = pk2(kh[2], kh[3]); w.z = pk2(kh[4], kh[5]); w.w = pk2(kh[6], kh[7]);
                *(LAS v4u*)(KHT + kc * 80 + 16 * tg) = w;
                if (tg == 0) DEC[kc] = etot; }
#pragma unroll
            for (int i8 = 0; i8 < VTOK / 8; ++i8) { v4u w; w.x = vv[8 * i8] | ((unsigned)vv[8 * i8 + 1] << 16); w.y = vv[8 * i8 + 2] | ((unsigned)vv[8 * i8 + 3] << 16); w.z = vv[8 * i8 + 4] | ((unsigned)vv[8 * i8 + 5] << 16); w.w = vv[8 * i8 + 6] | ((unsigned)vv[8 * i8 + 7] << 16);
                *(LAS v4u*)(VT + vdv * 80 + (VTOK * vtg + 8 * i8) * 2) = w; }
            if (n + 1 < SEQ / 32) { const unsigned rn = r0 + 32u;
#pragma unroll
                for (int i = 0; i < 8; ++i) { qv[i] = bld_bf(rq, voq, (rn + i) * QST); kv[i] = GLA ? bld_bf(rk, vok, (rn + i) * KST) : bld_f32(rk, vok, (rn + i) * KST); }
#pragma unroll
                for (int i = 0; i < VTOK; ++i) vv[i] = bld_u16(rv, vov, (rn + i) * VST);
#pragma unroll
                for (int e = 0; e < NV / 8; ++e) ggn[e] = bld_b128(rg, vog + 16u * e, rn * VST); }
            __syncthreads();
            if (GLA) { ALS[((n + 1) & 1) * 512 + tid] = alv; if (n + 2 < SEQ / 32) alv = bld_f32(ral, (unsigned)tid * 4u, (r0 + 64u) * 64u); }
            f32x4 P00 = {0.f, 0.f, 0.f, 0.f}, P01 = P00, P11 = P00;
#pragma unroll
            for (int s = 0; s < 4; ++s) { const bf16x8 KA0 = ld_b128(KT + l15 * 272 + 64 * s + 16 * q), KA1 = ld_b128(KT + (16 + l15) * 272 + 64 * s + 16 * q);
                const bf16x8 QB0 = ld_b128(QT + l15 * 272 + 64 * s + 16 * q), QB1 = ld_b128(QT + (16 + l15) * 272 + 64 * s + 16 * q);
                P00 = MFMA16(KA0, QB0, P00); P01 = MFMA16(KA0, QB1, P01); P11 = MFMA16(KA1, QB1, P11); }
#pragma unroll
            for (int r = 0; r < 4; ++r) if (l15 < 4 * q + r) { P00[r] = 0.f; P11[r] = 0.f; }
            const bf16x8 PA0 = pack8f(P00, (f32x4){0.f, 0.f, 0.f, 0.f}), PA1 = pack8f(P01, P11);
            bf16x8 VB[NCB];
#pragma unroll
            for (int cb = 0; cb < NCB; ++cb) { const LAS unsigned char* vr = VT + (16 * (wave * NCB + cb) + l15) * 80 + 8 * q; VB[cb] = ld_2xb64(vr, vr + 32); }
            f32x4 O[NCB][2];
#pragma unroll
            for (int cb = 0; cb < NCB; ++cb)
#pragma unroll
                for (int tb = 0; tb < 2; ++tb) O[cb][tb] = (f32x4){0.f, 0.f, 0.f, 0.f};
#pragma unroll
            for (int s = 0; s < 4; ++s) {
                bf16x8 QA[2];
#pragma unroll
                for (int tb = 0; tb < 2; ++tb) { const LAS unsigned char* qr = QT + (16 * tb + l15) * 272 + 64 * s + 8 * q; QA[tb] = ld_2xb64(qr, qr + 32); }
#pragma unroll
                for (int cb = 0; cb < NCB; ++cb) { const bf16x8 SB = pack8f(S[cb][2 * s], S[cb][2 * s + 1]);
                    O[cb][0] = MFMA16(QA[0], SB, O[cb][0]); O[cb][1] = MFMA16(QA[1], SB, O[cb][1]); } }
#pragma unroll
            for (int cb = 0; cb < NCB; ++cb) { O[cb][0] = MFMA16(PA0, VB[cb], O[cb][0]); O[cb][1] = MFMA16(PA1, VB[cb], O[cb][1]); }
#pragma unroll
            for (int kt = 0; kt < 8; ++kt) { const f32x4 dec = *(const LAS f32x4*)(DEC + 16 * kt + 4 * q);
                const LAS unsigned char* kr = KHT + (16 * kt + l15) * 80 + 8 * q; const bf16x8 KH = ld_2xb64(kr, kr + 32);
#pragma unroll
                for (int cb = 0; cb < NCB; ++cb) S[cb][kt] = MFMA16(KH, VB[cb], S[cb][kt] * dec); }
#pragma unroll
            for (int cb = 0; cb < NCB; ++cb)
#pragma unroll
                for (int tb = 0; tb < 2; ++tb)
#pragma unroll
                    for (int r = 0; r < 4; ++r) OB[(16 * tb + 4 * q + r) * DV + 16 * (wave * NCB + cb) + l15] = O[cb][tb][r];
#ifdef DBG_TRIVIAL
#pragma unroll
            for (int cb = 0; cb < NCB; ++cb)
#pragma unroll
                for (int tb = 0; tb < 2; ++tb)
#pragma unroll
                    for (int r = 0; r < 4; ++r) { const int t = 16 * tb + 4 * q + r, dv = 16 * (wave * NCB + cb) + l15;
                        float vsum = 0.f; if (DBG_TRIVIAL & 1) vsum += bf2f(*(const LAS unsigned short*)(VT + dv * 80 + t * 2)); if (DBG_TRIVIAL & 2) vsum += bf2f(*(const LAS unsigned short*)(QT + t * 272 + (dv & 127) * 2)); if (DBG_TRIVIAL & 4) vsum += bf2f(*(const LAS unsigned short*)(KHT + (dv & 127) * 80 + t * 2)); if (DBG_TRIVIAL & 8) vsum += 1.0f + 0.001f * (float)(t + dv);
                        OB[t * DV + dv] = vsum; }
#endif
            __syncthreads();
            { float o[NV]; float ss = 0.f;
#pragma unroll
                for (int e4 = 0; e4 < NV / 4; ++e4) { const f32x4 v = *(const LAS f32x4*)(OB + ot * DV + oc * NV + 4 * e4); o[4 * e4] = v[0]; o[4 * e4 + 1] = v[1]; o[4 * e4 + 2] = v[2]; o[4 * e4 + 3] = v[3]; ss += (v[0] * v[0] + v[1] * v[1]) + (v[2] * v[2] + v[3] * v[3]); }
                ss += __shfl_xor(ss, 1); ss += __shfl_xor(ss, 2); ss += __shfl_xor(ss, 4); ss += __shfl_xor(ss, 8);
                float rs = 1.0f;
                if (GLA) rs = 1.0f / sqrtf(ss * (1.0f / DV) + EPS); else if (oc == 0) A.SS[(rowbase + r0 + ot) * 8 + hd] = ss;
#pragma unroll
                for (int e8 = 0; e8 < NV / 8; ++e8) { const v4u gw_ = gg[e8]; float gf[8]; float nwr[NV];
                    { const f32x4 n0 = *(const LAS f32x4*)(NWL + oc * NV + 8 * e8), n1 = *(const LAS f32x4*)(NWL + oc * NV + 8 * e8 + 4); nwr[8 * e8] = n0[0]; nwr[8 * e8 + 1] = n0[1]; nwr[8 * e8 + 2] = n0[2]; nwr[8 * e8 + 3] = n0[3]; nwr[8 * e8 + 4] = n1[0]; nwr[8 * e8 + 5] = n1[1]; nwr[8 * e8 + 6] = n1[2]; nwr[8 * e8 + 7] = n1[3]; }
                    gf[0] = bf2f(gw_.x & 0xffffu); gf[1] = bf2f(gw_.x >> 16); gf[2] = bf2f(gw_.y & 0xffffu); gf[3] = bf2f(gw_.y >> 16); gf[4] = bf2f(gw_.z & 0xffffu); gf[5] = bf2f(gw_.z >> 16); gf[6] = bf2f(gw_.w & 0xffffu); gf[7] = bf2f(gw_.w >> 16);
                    v4u w; w.x = pk2(o[8 * e8] * rs * nwr[8 * e8] * gf[0], o[8 * e8 + 1] * rs * nwr[8 * e8 + 1] * gf[1]); w.y = pk2(o[8 * e8 + 2] * rs * nwr[8 * e8 + 2] * gf[2], o[8 * e8 + 3] * rs * nwr[8 * e8 + 3] * gf[3]);
                    w.z = pk2(o[8 * e8 + 4] * rs * nwr[8 * e8 + 4] * gf[4], o[8 * e8 + 5] * rs * nwr[8 * e8 + 5] * gf[5]); w.w = pk2(o[8 * e8 + 6] * rs * nwr[8 * e8 + 6] * gf[6], o[8 * e8 + 7] * rs * nwr[8 * e8 + 7] * gf[7]);
                    __builtin_amdgcn_raw_buffer_store_b128(w, ro, vog + 16u * e8, r0 * VST, 0); gg[e8] = ggn[e8]; } }
        }
        __syncthreads();
    }
}
constexpr int NPH = 1 + DEPTH * 10 + 1;
struct Args { const float* in[24]; float* out; unsigned char* ws; int ph_lo, ph_hi; };
#define AS4 __attribute__((address_space(4)))
#define KARG() ({ const AS4 Args* _p = (const AS4 Args*)__builtin_amdgcn_kernarg_segment_ptr(); asm volatile("" : "+s"(_p)); _p; })
#define KIN(i) ((const float*)KARG()->in[i])
#define KWS() ((unsigned char*)KARG()->ws)
__global__ void __launch_bounds__(NWAVES * 64, 2) mk_fwd(Args args_unused) {
    extern __shared__ __attribute__((aligned(16))) unsigned char lds[];
    Frame F;
    F.lds = (LAS unsigned char*)lds;
    F.MISC = (volatile LAS unsigned*)(F.lds + MISC_OFF);
    F.wave = __builtin_amdgcn_readfirstlane((int)threadIdx.x >> 6);
    F.G = gridDim.x; { const int bx = blockIdx.x; F.vcu = (F.G % 8 == 0) ? (bx % 8) * (F.G / 8) + bx / 8 : bx; }
    F.ctl = (gu32*)(KWS() + WS_CTL);
    for (int u = threadIdx.x; u < (LDS_BYTES - LDSCTL_OFF) / 4; u += NWAVES * 64) ((LAS unsigned*)(F.lds + LDSCTL_OFF))[u] = 0u;
    __syncthreads();
    XcdBarrier bar = xcd_barrier_post((unsigned*)(F.ctl + CW_BAR), F.MISC + 8); bar.wave = F.wave;
#ifdef PROBE_KIND
#define PB(kind) do { if (((1 << (kind)) & PROBE_KIND) && blockIdx.x == 0 && F.wave == 0 && lane_id() == 0) { volatile unsigned long long* tp_ = (volatile unsigned long long*)(KWS() + 512 * 1024); tp_[0] = __builtin_amdgcn_s_memrealtime(); } } while (0)
#define PE(kind) do { if (((1 << (kind)) & PROBE_KIND) && blockIdx.x == 0 && F.wave == 0 && lane_id() == 0) { volatile unsigned long long* tp_ = (volatile unsigned long long*)(KWS() + 512 * 1024); tp_[1] = tp_[1] + (__builtin_amdgcn_s_memrealtime() - tp_[0]); } } while (0)
#else
#define PB(kind) do {} while (0)
#define PE(kind) do {} while (0)
#endif
#if MK_N_LAUNCHES == 1
#define RUN() true
#define SEAM() xcd_barrier(bar)
#else
    int pi = 0;
#define RUN() (KARG()->ph_lo == pi)
#define SEAM() (++pi)
#endif
    PB(0);
    if (RUN()) { const AS4 Args* a = KARG(); ProIn P{a->in[1], a->in[2], a->in[3], a->in[6], a->in[7], a->in[8], a->in[11], a->in[14], a->in[15], a->in[16], a->in[18], a->in[19], a->in[23]};
        p0_prologue(F, P, KWS()); }
    SEAM(); PE(0);
    for (int l = 0; l < DEPTH; ++l) {
        for (int s = 0; s < 3; ++s) {
#ifdef DBG_NSUB
            if (l * 3 + s >= DBG_NSUB) continue;
#endif
            PB(1);
            if (RUN()) { unsigned char* ws = KWS(); const float* modl = (const float*)(ws + WS_MOD) + (size_t)l * BATCH * (NMOD * D);
                const float* xcur = (l == 0 && s == 0) ? KIN(0) : (const float*)KARG()->out;
                norm_phase(F, xcur, KIN(4) + ((size_t)l * 3 + s) * D, modl + (3 * s) * D, modl + (3 * s + 1) * D, (bf16*)(ws + WS_H)); }
            SEAM(); PE(1);
            PB(s != 1 ? 2 : 4);
            if (RUN()) { unsigned char* ws = KWS(); const bf16* H = (const bf16*)(ws + WS_H); unsigned char* SCR = ws + WS_SCR; const int mx = l % 3, mi = l / 3;
                if (s != 1) { const int fi = l * 2 + (s >> 1);
                    pg8::Gemm g{H, (const bf16*)(ws + WS_W13 + fi * W13_BYTES), M, 2 * FF, D}; pg8::StaticOrder S; S.init(M, 2 * FF, F.G, (int)blockIdx.x);
                    pg8::EpiSwiglu E{(bf16*)SCR, FF};
                    pg8::gemm_phase<pg8::EpiSwiglu, pg8::StaticOrder, true, true>(F.lds, g, S, E, F.wave);
                }
#ifndef NO_MIXIN
                else if (mx == 0) {
                    pg8::Gemm g{H, (const bf16*)(ws + WS_RGIN + mi * RGIN_BYTES), M, 2048, D}; pg8::StaticOrder S; S.init(M, 2048, F.G, (int)blockIdx.x);
                    pg8::EpiRgIn E{(bf16*)SCR};
                    pg8::gemm_phase<pg8::EpiRgIn, pg8::StaticOrder, true, true>(F.lds, g, S, E, F.wave);
                } else if (mx == 1) {
                    pg8::Gemm g{H, (const bf16*)(ws + WS_HGIN), M, 4096, D}; pg8::StaticOrder S; S.init(M, 4096, F.G, (int)blockIdx.x);
                    pg8::EpiHgIn E{(bf16*)SCR, (float*)(SCR + 3 * ACT_BYTES), (const float*)(ws + WS_LB)};
                    pg8::gemm_phase<pg8::EpiHgIn, pg8::StaticOrder, true, true>(F.lds, g, S, E, F.wave);
                } else {
                    pg8::Gemm g{H, (const bf16*)(ws + WS_GLIN), M, GLA_INP, D}; pg8::StaticOrder S; S.init(M, GLA_INP, F.G, (int)blockIdx.x);
                    pg8::EpiGlIn E{(bf16*)SCR, (float*)(SCR + 3 * ACT_BYTES)};
                    pg8::gemm_phase<pg8::EpiGlIn, pg8::StaticOrder, true, true>(F.lds, g, S, E, F.wave);
                }
#endif
            }
            SEAM(); PE(s != 1 ? 2 : 4);
            if (s == 1) {
                PB(5 + l % 3);
                if (RUN()) {
#ifndef NO_SCANS
                    unsigned char* ws = KWS(); bf16* H = (bf16*)(ws + WS_H); unsigned char* SCR = ws + WS_SCR; const int mx = l % 3, mi = l / 3;
                    if (mx == 0) { RgArgs A{(const bf16*)SCR, (const bf16*)(SCR + ACT_BYTES), H, (const bf16*)(ws + WS_RGG + mi * RGG_BYTES), KIN(12) + (size_t)mi * 8 * 256, KIN(13) + (size_t)mi * D, KIN(9) + (size_t)mi * 4 * D, KIN(10) + (size_t)mi * D};
                        rg_scan_phase(F, A); }
                    else if (mx == 1) { GlaArgs A{(const bf16*)SCR, nullptr, (const float*)(SCR + 3 * ACT_BYTES), (const bf16*)(SCR + ACT_BYTES), (const bf16*)(SCR + 2 * ACT_BYTES), nullptr, nullptr, nullptr, KIN(17), H, (float*)(ws + WS_SS)};
                        gla_scan_phase<128, false>(F, A); }
                    else { GlaArgs A{(const bf16*)SCR, (const bf16*)(SCR + ACT_BYTES / 2), nullptr, (const bf16*)(SCR + ACT_BYTES), (const bf16*)(SCR + 2 * ACT_BYTES), (const float*)(SCR + 3 * ACT_BYTES), KIN(20), KIN(21), KIN(22), H, nullptr};
#if defined(DBG_COPY)
                        { int tq_ = F.wave * 64 + lane_id(); asm volatile("" : "+v"(tq_)); const int gw = blockIdx.x * 512 + tq_;
                          for (size_t e = gw; e < (size_t)M * D; e += (size_t)gridDim.x * 512) { const size_t row = e >> 10; const int col = (int)(e & 1023);
                              float v = 0.f;
                              if (DBG_COPY & 1) v += bf2f(A.V[e]);
                              if (DBG_COPY & 2) v += bf2f(A.G[e]);
                              if (DBG_COPY & 4) v += bf2f(A.Q[row * 512 + (col & 511)]);
                              if (DBG_COPY & 8) v += bf2f(A.K[row * 512 + (col & 511)]);
                              if (DBG_COPY & 16) v += A.ALOW[row * 16 + (col & 15)];
                              H[e] = (bf16)f2bf(v); } }
#elif !defined(DBG_SKIP_GLSCAN)
                        gla_scan_phase<256, true>(F, A);
#endif
                    }
#endif
                }
                SEAM(); PE(5 + l % 3);
            }
            PB(s != 1 ? 3 : 8);
            if (RUN()) { unsigned char* ws = KWS(); const int mx = l % 3, mi = l / 3;
                const float* xcur = (l == 0 && s == 0) ? KIN(0) : (const float*)KARG()->out;
                const float* modl = (const float*)(ws + WS_MOD) + (size_t)l * BATCH * (NMOD * D);
                const bf16* Ap; const bf16* Bp; int K; float fac; const float* ssp = nullptr;
                if (s != 1) { Ap = (const bf16*)(ws + WS_SCR); Bp = (const bf16*)(ws + WS_W2 + (l * 2 + (s >> 1)) * W2_BYTES); K = FF; fac = 0.5f; }
                else { Ap = (const bf16*)(ws + WS_H); K = D; fac = 1.0f;
                    if (mx == 0) Bp = (const bf16*)(ws + WS_RGOUT + mi * SQ_BYTES); else if (mx == 1) { Bp = (const bf16*)(ws + WS_HGOUT); ssp = (const float*)(ws + WS_SS); } else Bp = (const bf16*)(ws + WS_GLOUT); }
                pg8::Gemm g{Ap, Bp, M, D, K}; pg8::StaticOrder S; S.init(M, D, F.G, (int)blockIdx.x);
                pg8::EpiResid E{xcur, KARG()->out, modl + (3 * s + 2) * D, NMOD * D, fac, ssp};
                pg8::gemm_phase<pg8::EpiResid, pg8::StaticOrder, true, true>(F.lds, g, S, E, F.wave);
            }
            SEAM(); PE(s != 1 ? 3 : 8);
        }
    }
    PB(9);
#if defined(DBG_NSUB) && DBG_NSUB == 0
    if (RUN()) { float* xo = KARG()->out; final_norm_phase(F, KIN(0), KIN(5), xo); }
#else
    if (RUN()) { float* xo = KARG()->out; final_norm_phase(F, xo, KIN(5), xo); }
#endif
    PE(9);
#ifdef PROBE_KIND
    if (blockIdx.x == 0 && F.wave == 0 && lane_id() == 0) { volatile unsigned long long* tp_ = (volatile unsigned long long*)(KWS() + 512 * 1024); const unsigned long long want = tp_[1] * PROBE_MUL, t0_ = __builtin_amdgcn_s_memrealtime();
        while (__builtin_amdgcn_s_memrealtime() - t0_ < want) __builtin_amdgcn_s_sleep(8); }
#endif
#undef RUN
#undef SEAM
}

extern "C" void kernel_launch(void* const* d_in, const int* in_sizes, int n_in, void* d_out, int out_size, void* d_ws, size_t ws_size, hipStream_t stream) {
    static int grid = 0;
    if (grid == 0) {
        if (n_in != 24 || in_sizes[0] != M * D || out_size != M * D || ws_size < WS_END) { fprintf(stderr, "kernel_launch: unexpected shapes (n_in %d, in0 %d, out %d, ws %zu < %zu); nothing launched\n", n_in, n_in > 0 ? in_sizes[0] : -1, out_size, ws_size, (size_t)WS_END); grid = -1; return; }
        int dev = 0, cus = 0, per_cu = 0;
        if (hipGetDevice(&dev) != hipSuccess || hipDeviceGetAttribute(&cus, hipDeviceAttributeMultiprocessorCount, dev) != hipSuccess) { grid = -1; return; }
        if (hipFuncSetAttribute((const void*)mk_fwd, hipFuncAttributeMaxDynamicSharedMemorySize, LDS_BYTES) != hipSuccess) { fprintf(stderr, "kernel_launch: hipFuncSetAttribute failed\n"); grid = -1; return; }
        if (hipOccupancyMaxActiveBlocksPerMultiprocessor(&per_cu, (const void*)mk_fwd, NWAVES * 64, LDS_BYTES) != hipSuccess || per_cu < 1)
            fprintf(stderr, "kernel_launch: note: occupancy query reports %d workgroups per CU\n", per_cu);
        (void)hipGetLastError();
        grid = cus;
    }
    if (grid < 0) return;
    if (hipMemsetAsync((char*)d_ws + WS_CTL, 0, CTL_ZERO_BYTES, stream) != hipSuccess) return;
    Args a{};
    for (int i = 0; i < 24; ++i) a.in[i] = (const float*)d_in[i];
    a.out = (float*)d_out; a.ws = (unsigned char*)d_ws;
#if MK_N_LAUNCHES == 1
    a.ph_lo = 0; a.ph_hi = NPH;
    hipLaunchKernelGGL(mk_fwd, dim3(grid), dim3(NWAVES * 64), LDS_BYTES, stream, a);
#else
    for (int p = 0; p < NPH; ++p) { a.ph_lo = p; a.ph_hi = p + 1; hipLaunchKernelGGL(mk_fwd, dim3(grid), dim3(NWAVES * 64), LDS_BYTES, stream, a); }
#endif
}
```

```cpp
#include <hip/hip_runtime.h>
#include <cstdio>
#include <cstdint>
#include <cmath>
#ifndef MK_N_LAUNCHES
#define MK_N_LAUNCHES 1
#endif
namespace pg8 {
#define PG8_LAS __attribute__((address_space(3)))
typedef unsigned short bf16_t;
typedef short bf16x8 __attribute__((ext_vector_type(8)));
typedef float f32x4 __attribute__((ext_vector_type(4)));
typedef unsigned u32x4 __attribute__((ext_vector_type(4)));
constexpr int BM = 256, BK = 64, HALF = 128, HTB = HALF * BK * 2  , STAGE_BYTES = 8 * HTB, NXCD = 8, WGM = 8;

__host__ __device__ __forceinline__ int lds_byte(int r, int c) { const int st = (r >> 4) * 2 + (c >> 5), rr = r & 15, cc = c & 31, ob = rr * 64 + cc * 2; return st * 1024 + (ob ^ (((ob >> 9) & 1) << 5)); }
__host__ __device__ __forceinline__ void stage_rc(int b, int& R, int& C) { const int st = b / 1024, sb = b % 1024, swz = sb ^ (((sb >> 9) & 1) << 5); R = (st >> 1) * 16 + swz / 64; C = (st & 1) * 32 + (swz % 64) / 2; }
__host__ __device__ __forceinline__ int perm32(int rho) { const int n = rho >> 4, i = rho & 15; return 8 * (i >> 2) + 4 * n + (i & 3); }

struct Unit { int pm, pn; };
struct Gemm { const bf16_t* A; const bf16_t* Bt; int M, N, K; };

struct StaticOrder {
    int nM, nN, nwg, G, c;
    __host__ __device__ void init(int M, int N, int G_, int c_) { nM = M / BM; nN = N / BM; nwg = nM * nN; G = G_; c = c_; }
    __host__ __device__ bool next(int i, Unit& u) const {
        const long L = (long)i * G + c; if (L >= nwg) return false;
        int wgid = (int)L; { const int q = nwg / NXCD, r = nwg % NXCD, xcd = wgid % NXCD, off = wgid / NXCD; wgid = (xcd < r ? xcd * (q + 1) : r * (q + 1) + (xcd - r) * q) + off; }
        const int nig = WGM * nN, gid = wgid / nig, fm = gid * WGM, gsz = (nM - fm) < WGM ? (nM - fm) : WGM;
        u.pm = fm + ((wgid % nig) % gsz); u.pn = (wgid % nig) / gsz; return true;
    }
    __device__ __forceinline__ void a_ready(const Unit&) const {}
    __device__ __forceinline__ void done(const Unit&) const {}
};

typedef float f32x2_t __attribute__((ext_vector_type(2))); typedef __bf16 bf16x2_t __attribute__((ext_vector_type(2)));
__device__ __forceinline__ unsigned cvt_pk_bf16(float lo, float hi) { const f32x2_t v = {lo, hi}; const bf16x2_t b = __builtin_convertvector(v, bf16x2_t); return __builtin_bit_cast(unsigned, b); }
__device__ __forceinline__ u32x4 pack8(const f32x4 a, const f32x4 b) { u32x4 w; w.x = cvt_pk_bf16(a[0], a[1]); w.y = cvt_pk_bf16(a[2], a[3]); w.z = cvt_pk_bf16(b[0], b[1]); w.w = cvt_pk_bf16(b[2], b[3]); return w; }
__device__ __forceinline__ float fast_sigmoid(float x) { return __builtin_amdgcn_rcpf(1.0f + __builtin_amdgcn_exp2f(-1.4426950408889634f * x)); }
__device__ __forceinline__ f32x4 sigmoid4(const f32x4 v) { f32x4 o; o[0] = fast_sigmoid(v[0]); o[1] = fast_sigmoid(v[1]); o[2] = fast_sigmoid(v[2]); o[3] = fast_sigmoid(v[3]); return o; }
__device__ __forceinline__ f32x4 silu4(const f32x4 v) { return v * sigmoid4(v); }
__device__ __forceinline__ f32x4 gelu_tanh4(const f32x4 v) { const f32x4 z = v * (1.5957691216057308f + 0.07135481627260025f * (v * v)); return v * sigmoid4(z); }

struct EpiSwiglu {
    static constexpr bool PERM = true, AFTER_DRAIN = false;
    bf16_t* O; int ldc;
    __device__ __forceinline__ void operator()(const f32x4 (&acc)[2][2][4][2], const Unit& u, int wr, int wc, int fr, int fq) const {
        const int row0 = u.pm * BM + wr * 64 + fr, col0 = u.pn * HALF + wc * 32 + 8 * fq;
#pragma unroll
        for (int ai = 0; ai < 2; ++ai)
#pragma unroll
            for (int m = 0; m < 4; ++m) { bf16_t* rowp = O + (size_t)(row0 + ai * HALF + m * 16) * ldc + col0;
                const f32x4 v0 = silu4(acc[ai][0][m][0]) * acc[ai][1][m][0], v1 = silu4(acc[ai][0][m][1]) * acc[ai][1][m][1];
                *(u32x4*)rowp = pack8(v0, v1); }
    }
};
struct EpiRgIn {
    static constexpr bool PERM = true, AFTER_DRAIN = false;
    bf16_t* Y;
    __device__ __forceinline__ void operator()(const f32x4 (&acc)[2][2][4][2], const Unit& u, int wr, int wc, int fr, int fq) const {
        const int row0 = u.pm * BM + wr * 64 + fr; const bool isy = u.pn < 4;
        bf16_t* base = Y + (size_t)(isy ? 0 : 1) * ((size_t)65536 * 1024) + (u.pn & 3) * BM + wc * 32 + 8 * fq;
#pragma unroll
        for (int ai = 0; ai < 2; ++ai)
#pragma unroll
            for (int m = 0; m < 4; ++m) { bf16_t* rowp = base + (size_t)(row0 + ai * HALF + m * 16) * 1024;
#pragma unroll
                for (int bj = 0; bj < 2; ++bj) { f32x4 v0 = acc[ai][bj][m][0], v1 = acc[ai][bj][m][1];
                    if (isy) { v0 = gelu_tanh4(v0); v1 = gelu_tanh4(v1); }
                    *(u32x4*)(rowp + bj * HALF) = pack8(v0, v1); } }
    }
};
struct EpiHgIn {
    static constexpr bool PERM = true, AFTER_DRAIN = false;
    bf16_t* Q; float* LOGF; const float* lb;
    __device__ __forceinline__ void operator()(const f32x4 (&acc)[2][2][4][2], const Unit& u, int wr, int wc, int fr, int fq) const {
        const int row0 = u.pm * BM + wr * 64 + fr, sec = u.pn >> 2, colw = (u.pn & 3) * BM + wc * 32 + 8 * fq;
        if (sec == 1) {
#pragma unroll
            for (int bj = 0; bj < 2; ++bj) { const f32x4 l0 = *(const f32x4*)(lb + colw + bj * HALF), l1 = *(const f32x4*)(lb + colw + bj * HALF + 4);
#pragma unroll
                for (int ai = 0; ai < 2; ++ai)
#pragma unroll
                    for (int m = 0; m < 4; ++m) { float* rowp = LOGF + (size_t)(row0 + ai * HALF + m * 16) * 1024 + colw + bj * HALF;
                        const f32x4 s0 = sigmoid4(acc[ai][bj][m][0]), s1 = sigmoid4(acc[ai][bj][m][1]);
                        const f32x4 f0 = l0 + (1.0f - l0) * s0, f1 = l1 + (1.0f - l1) * s1; f32x4 o0, o1;
#pragma unroll
                        for (int e = 0; e < 4; ++e) { o0[e] = __logf(f0[e]); o1[e] = __logf(f1[e]); }
                        *(f32x4*)rowp = o0; *(f32x4*)(rowp + 4) = o1; } }
        } else {
            bf16_t* base = Q + (size_t)(sec - (sec > 0 ? 1 : 0)) * ((size_t)65536 * 1024) + colw;
#pragma unroll
            for (int ai = 0; ai < 2; ++ai)
#pragma unroll
                for (int m = 0; m < 4; ++m) { bf16_t* rowp = base + (size_t)(row0 + ai * HALF + m * 16) * 1024;
#pragma unroll
                    for (int bj = 0; bj < 2; ++bj) { f32x4 v0 = acc[ai][bj][m][0], v1 = acc[ai][bj][m][1];
                        if (sec == 3) { v0 = sigmoid4(v0); v1 = sigmoid4(v1); }
                        *(u32x4*)(rowp + bj * HALF) = pack8(v0, v1); } }
        }
    }
};
struct EpiGlIn {
    static constexpr bool PERM = true, AFTER_DRAIN = false;
    bf16_t* Q; float* ALOW;
    __device__ __forceinline__ void operator()(const f32x4 (&acc)[2][2][4][2], const Unit& u, int wr, int wc, int fr, int fq) const {
        const int row0 = u.pm * BM + wr * 64 + fr, pn = u.pn;
        if (pn == 12) {
            if (wc == 0 && fq < 2) {
#pragma unroll
                for (int ai = 0; ai < 2; ++ai)
#pragma unroll
                    for (int m = 0; m < 4; ++m) { float* rowp = ALOW + (size_t)(row0 + ai * HALF + m * 16) * 16 + 8 * fq;
                        *(f32x4*)rowp = acc[ai][0][m][0]; *(f32x4*)(rowp + 4) = acc[ai][0][m][1]; }
            }
            return;
        }
        const int g2 = pn >= 2 ? 1 : 0, g4 = pn >= 4 ? 1 : 0, g8 = pn >= 8 ? 1 : 0; const int ld = 512 + 512 * g4;
        bf16_t* base = Q + (size_t)(g2 + g4 + 2 * g8) * ((size_t)65536 * 512) + (pn - 2 * g2 - 2 * g4 - 4 * g8) * BM;
        base += wc * 32 + 8 * fq; const bool act = pn >= 8;
#pragma unroll
        for (int ai = 0; ai < 2; ++ai)
#pragma unroll
            for (int m = 0; m < 4; ++m) { bf16_t* rowp = base + (size_t)(row0 + ai * HALF + m * 16) * ld;
#pragma unroll
                for (int bj = 0; bj < 2; ++bj) { f32x4 v0 = acc[ai][bj][m][0], v1 = acc[ai][bj][m][1];
                    if (act) { v0 = silu4(v0); v1 = silu4(v1); }
                    *(u32x4*)(rowp + bj * HALF) = pack8(v0, v1); } }
    }
};
struct EpiResid {
    static constexpr bool PERM = false, AFTER_DRAIN = false;
    const float* base; float* out; const float* coef; int cstride; float fac; const float* ss;
    __device__ __forceinline__ void operator()(const f32x4 (&acc)[2][2][4][2], const Unit& u, int wr, int wc, int fr, int fq) const {
        const int row0 = u.pm * BM + wr * 64 + fr, col0 = u.pn * BM + wc * 32 + 4 * fq;
        const float* cf = coef + (size_t)(u.pm >> 3) * cstride + col0;
        f32x4 cv[2][2];
#pragma unroll
        for (int bj = 0; bj < 2; ++bj)
#pragma unroll
            for (int n = 0; n < 2; ++n) cv[bj][n] = *(const f32x4*)(cf + bj * HALF + n * 16) * fac;
#pragma unroll
        for (int ai = 0; ai < 2; ++ai)
#pragma unroll
            for (int m = 0; m < 4; ++m) { const int row = row0 + ai * HALF + m * 16; const size_t off = (size_t)row * 1024 + col0;
                float rs = 1.0f;
                if (ss) { const f32x4 a = *(const f32x4*)(ss + (size_t)row * 8), b = *(const f32x4*)(ss + (size_t)row * 8 + 4);
                    rs = 1.0f / sqrtf(((a[0] + a[1]) + (a[2] + a[3]) + (b[0] + b[1]) + (b[2] + b[3])) * (1.0f / 1024.0f) + 1e-6f); }
#pragma unroll
                for (int bj = 0; bj < 2; ++bj)
#pragma unroll
                    for (int n = 0; n < 2; ++n) { const f32x4 bs = *(const f32x4*)(base + off + bj * HALF + n * 16);
                        *(f32x4*)(out + off + bj * HALF + n * 16) = bs + (cv[bj][n] * rs) * acc[ai][bj][m][n]; } }
    }
};

template <class Epi, class Sched, bool ALIGN_EPI = false, bool SP2 = false>
__device__ __forceinline__ void gemm_phase(PG8_LAS unsigned char* lds, const Gemm g, const Sched& S, const Epi& E, const int wave_id) {
    int tid_ = wave_id * 64 + (int)__builtin_amdgcn_mbcnt_hi(~0u, __builtin_amdgcn_mbcnt_lo(~0u, 0u)); asm volatile("" : "+v"(tid_));
    const int tid = tid_, wid = wave_id, lane = tid & 63, wr = wid >> 2, wc = wid & 3, fr = lane & 15, fq = lane >> 4;
    const int K = g.K, nt = K / BK;
    unsigned voffA[2], voffB[2];
#pragma unroll
    for (int i = 0; i < 2; ++i) { int R, C; stage_rc(tid * 16 + i * 8192, R, C); const int Rb = Epi::PERM ? ((R & ~31) + perm32(R & 31)) : R;
        voffA[i] = (unsigned)(R * K + C) * 2u; voffB[i] = (unsigned)(Rb * K + C) * 2u; }
    const size_t kstep = (size_t)(BK * 2);
    const size_t hstep = (size_t)HALF * K * 2;
    const size_t tstep = 2 * hstep;
    const unsigned ldsw = (unsigned)wid * 1024u;
    const int aoff = lds_byte(wr * 64 + fr, fq * 8), boff = lds_byte(wc * 32 + fr, fq * 8);
#define PG8_SA(b, h) (((b) * 2 + (h)) * HTB)
#define PG8_SB(b, h) ((4 + (b) * 2 + (h)) * HTB)
#define PG8_STAGE(bufoff, gbase, voff) do { _Pragma("unroll") for (int _i = 0; _i < 2; ++_i) \
        __builtin_amdgcn_global_load_lds((const unsigned*)((const char*)(gbase) + (voff)[_i]), (PG8_LAS unsigned*)(lds + (bufoff) + ldsw + _i * 8192), 16, 0, 0); } while (0)
#define PG8_LDA(dst, b, h) do { _Pragma("unroll") for (int m = 0; m < 4; ++m) _Pragma("unroll") for (int k = 0; k < 2; ++k) dst[m][k] = *(const PG8_LAS bf16x8*)(lds + PG8_SA(b, h) + aoff + m * 2048 + k * 1024); } while (0)
#define PG8_LDB(dst, b, h) do { _Pragma("unroll") for (int n = 0; n < 2; ++n) _Pragma("unroll") for (int k = 0; k < 2; ++k) dst[n][k] = *(const PG8_LAS bf16x8*)(lds + PG8_SB(b, h) + boff + n * 2048 + k * 1024); } while (0)
#define PG8_MMA(ai, bj, At, Bt) do { __builtin_amdgcn_s_setprio(1); _Pragma("unroll") for (int m = 0; m < 4; ++m) _Pragma("unroll") for (int n = 0; n < 2; ++n) _Pragma("unroll") for (int k = 0; k < 2; ++k) \
        acc[ai][bj][m][n] = __builtin_amdgcn_mfma_f32_16x16x32_bf16(Bt[n][k], At[m][k], acc[ai][bj][m][n], 0, 0, 0); __builtin_amdgcn_s_setprio(0); } while (0)
#define PG8_WAIT_V(n) asm volatile("s_waitcnt vmcnt(" #n ")" ::: "memory")
#define PG8_WAIT_L(n) asm volatile("s_waitcnt lgkmcnt(" #n ")" ::: "memory")
#define PG8_BAR __builtin_amdgcn_s_barrier()
#define PG8_SCHED __builtin_amdgcn_sched_barrier(0)
    Unit cur, nxt; int ui = 0;
    if (!S.next(0, cur)) return;
    f32x4 acc[2][2][4][2];
#pragma unroll
    for (int a = 0; a < 2; ++a)
#pragma unroll
        for (int b = 0; b < 2; ++b)
#pragma unroll
            for (int m = 0; m < 4; ++m)
#pragma unroll
                for (int n = 0; n < 2; ++n) acc[a][b][m][n] = (f32x4){0.f, 0.f, 0.f, 0.f};
    bf16x8 At[4][2], B0[2][2], B1[2][2];
    const char* cA = (const char*)g.A + (size_t)cur.pm * tstep; const char* cB = (const char*)g.Bt + (size_t)cur.pn * tstep;
    S.a_ready(cur);
    if constexpr (SP2) {
        PG8_STAGE(PG8_SB(0, 0), cB, voffB); PG8_STAGE(PG8_SB(0, 1), cB + hstep, voffB); PG8_STAGE(PG8_SA(0, 0), cA, voffA); PG8_STAGE(PG8_SA(0, 1), cA + hstep, voffA);
        if (wr == 1) PG8_BAR;
        PG8_WAIT_V(2); PG8_BAR;
        PG8_STAGE(PG8_SB(1, 0), cB + kstep, voffB); PG8_STAGE(PG8_SA(1, 0), cA + kstep, voffA); PG8_STAGE(PG8_SB(1, 1), cB + hstep + kstep, voffB);
        PG8_WAIT_V(6); PG8_BAR;
    } else {
        PG8_STAGE(PG8_SB(0, 0), cB, voffB); PG8_STAGE(PG8_SA(0, 0), cA, voffA); PG8_STAGE(PG8_SB(0, 1), cB + hstep, voffB); PG8_STAGE(PG8_SA(0, 1), cA + hstep, voffA);
        if (wr == 1) PG8_BAR;
        PG8_WAIT_V(4); PG8_BAR;
        PG8_STAGE(PG8_SB(1, 0), cB + kstep, voffB); PG8_STAGE(PG8_SA(1, 0), cA + kstep, voffA); PG8_STAGE(PG8_SB(1, 1), cB + hstep + kstep, voffB);
        PG8_WAIT_V(6); PG8_BAR;
    }
    for (;;) {
        const bool has_next = S.next(ui + 1, nxt);
        const char* nA = has_next ? (const char*)g.A + (size_t)nxt.pm * tstep : cA; const char* nB = has_next ? (const char*)g.Bt + (size_t)nxt.pn * tstep : cB;
        for (int t = 0; t < nt; t += 2) {
            const bool last = (t == nt - 2);
            const char* a1 = cA + (size_t)(t + 1) * kstep;
            const char* a2 = last ? nA : cA + (size_t)(t + 2) * kstep; const char* b2 = last ? nB : cB + (size_t)(t + 2) * kstep;
            const char* a3 = a2 + kstep; const char* b3 = b2 + kstep;
            if (last && has_next) S.a_ready(nxt);
            if constexpr (SP2) {
            PG8_LDB(B0, 0, 0); PG8_LDB(B1, 0, 1); PG8_SCHED; PG8_LDA(At, 0, 0); PG8_STAGE(PG8_SA(1, 1), a1 + hstep, voffA);
            PG8_WAIT_V(8); PG8_WAIT_L(0); PG8_BAR; PG8_MMA(0, 0, At, B0); PG8_MMA(0, 1, At, B1); PG8_BAR; PG8_SCHED;
            PG8_LDA(At, 0, 1); PG8_STAGE(PG8_SB(0, 0), b2, voffB); PG8_STAGE(PG8_SB(0, 1), b2 + hstep, voffB); PG8_STAGE(PG8_SA(0, 0), a2, voffA);
            PG8_WAIT_V(8); PG8_WAIT_L(0); PG8_BAR; PG8_MMA(1, 0, At, B0); PG8_MMA(1, 1, At, B1); PG8_BAR; PG8_SCHED;
            PG8_LDB(B0, 1, 0); PG8_LDB(B1, 1, 1); PG8_SCHED; PG8_LDA(At, 1, 0); PG8_STAGE(PG8_SA(0, 1), a2 + hstep, voffA);
            PG8_WAIT_V(8); PG8_WAIT_L(0); PG8_BAR; PG8_MMA(0, 0, At, B0); PG8_MMA(0, 1, At, B1); PG8_BAR; PG8_SCHED;
            PG8_LDA(At, 1, 1); PG8_STAGE(PG8_SB(1, 0), b3, voffB); PG8_STAGE(PG8_SB(1, 1), b3 + hstep, voffB); PG8_STAGE(PG8_SA(1, 0), a3, voffA);
            PG8_WAIT_V(8); PG8_WAIT_L(0); PG8_BAR; PG8_MMA(1, 0, At, B0); PG8_MMA(1, 1, At, B1); PG8_BAR; PG8_SCHED;
            } else {
            PG8_LDB(B0, 0, 0); PG8_SCHED; PG8_LDA(At, 0, 0); PG8_STAGE(PG8_SA(1, 1), a1 + hstep, voffA);
            PG8_WAIT_L(8); PG8_BAR; PG8_WAIT_L(0); PG8_MMA(0, 0, At, B0); PG8_BAR; PG8_SCHED;
            PG8_LDB(B1, 0, 1); PG8_STAGE(PG8_SB(0, 0), b2, voffB);
            PG8_BAR; PG8_WAIT_L(0); PG8_MMA(0, 1, At, B1); PG8_BAR;
            PG8_LDA(At, 0, 1); PG8_STAGE(PG8_SA(0, 0), a2, voffA);
            PG8_BAR; PG8_WAIT_L(0); PG8_MMA(1, 0, At, B0); PG8_BAR; PG8_SCHED;
            PG8_STAGE(PG8_SB(0, 1), b2 + hstep, voffB);
            PG8_WAIT_V(6); PG8_BAR; PG8_MMA(1, 1, At, B1); PG8_BAR;
            PG8_LDB(B0, 1, 0); PG8_SCHED; PG8_LDA(At, 1, 0); PG8_STAGE(PG8_SA(0, 1), a2 + hstep, voffA);
            PG8_WAIT_L(8); PG8_BAR; PG8_WAIT_L(0); PG8_MMA(0, 0, At, B0); PG8_BAR; PG8_SCHED;
            PG8_LDB(B1, 1, 1); PG8_STAGE(PG8_SB(1, 0), b3, voffB);
            PG8_BAR; PG8_WAIT_L(0); PG8_MMA(0, 1, At, B1); PG8_BAR;
            PG8_LDA(At, 1, 1); PG8_STAGE(PG8_SA(1, 0), a3, voffA);
            PG8_BAR; PG8_WAIT_L(0); PG8_MMA(1, 0, At, B0); PG8_BAR; PG8_SCHED;
            PG8_STAGE(PG8_SB(1, 1), b3 + hstep, voffB);
            PG8_WAIT_V(6); PG8_BAR; PG8_MMA(1, 1, At, B1); PG8_BAR;
            }
        }
        if constexpr (ALIGN_EPI) { if (wr == 0) PG8_BAR; }
        if constexpr (!Epi::AFTER_DRAIN) { E(acc, cur, wr, wc, fr, fq); S.done(cur); }
        if (!has_next) break;
#pragma unroll
        for (int a = 0; a < 2; ++a)
#pragma unroll
            for (int b = 0; b < 2; ++b)
#pragma unroll
                for (int m = 0; m < 4; ++m)
#pragma unroll
                    for (int n = 0; n < 2; ++n) acc[a][b][m][n] = (f32x4){0.f, 0.f, 0.f, 0.f};
        cur = nxt; cA = nA; cB = nB; ++ui;
        if constexpr (ALIGN_EPI) { if (wr == 1) PG8_BAR; }
    }
    PG8_WAIT_V(0);
    if constexpr (!ALIGN_EPI) { if (wr == 0) PG8_BAR; }
    PG8_BAR;
    if constexpr (Epi::AFTER_DRAIN) { E.fused(acc, cur, wr, wc, fr, fq, lds, wid, lane); S.done(cur); }
#undef PG8_SA
#undef PG8_SB
#undef PG8_STAGE
#undef PG8_LDA
#undef PG8_LDB
#undef PG8_MMA
#undef PG8_WAIT_V
#undef PG8_WAIT_L
#undef PG8_BAR
#undef PG8_SCHED
}
}
constexpr int NWAVES = 8;
constexpr int BATCH = 32, SEQ = 2048, D = 1024, M = BATCH * SEQ, FF = 2816, DEPTH = 4, NMOD = 9;
constexpr int GLA_IN = 3088, GLA_INP = 3328;
constexpr float EPS = 1e-6f;
constexpr size_t MiB = 1u << 20;
constexpr size_t WS_CTL = 0, CTL_ZERO_BYTES = 1 * MiB;
constexpr size_t WS_MOD = 2 * MiB;
constexpr size_t WS_LB = 6 * MiB + 512 * 1024;
constexpr size_t WS_SS = 7 * MiB;
constexpr size_t WS_W13 = 10 * MiB, W13_BYTES = (size_t)2 * FF * D * 2;
constexpr size_t WS_W2 = 98 * MiB, W2_BYTES = (size_t)D * FF * 2;
constexpr size_t WS_RGIN = 142 * MiB, RGIN_BYTES = (size_t)2048 * D * 2;
constexpr size_t WS_RGG = 150 * MiB, RGG_BYTES = (size_t)8 * 256 * 128 * 2;
constexpr size_t WS_RGOUT = 151 * MiB, SQ_BYTES = (size_t)D * D * 2;
constexpr size_t WS_HGIN = 155 * MiB;
constexpr size_t WS_HGOUT = 163 * MiB;
constexpr size_t WS_GLIN = 165 * MiB;
constexpr size_t WS_GLOUT = 172 * MiB;
constexpr size_t WS_H = 176 * MiB;
constexpr size_t WS_SCR = 304 * MiB;
constexpr size_t ACT_BYTES = (size_t)M * D * 2;
constexpr size_t WS_END = WS_SCR + 5 * ACT_BYTES;
static_assert(WS_W13 + 8 * W13_BYTES <= WS_W2 && WS_W2 + 8 * W2_BYTES <= WS_RGIN && WS_RGIN + 2 * RGIN_BYTES <= WS_RGG && WS_RGG + 2 * RGG_BYTES <= WS_RGOUT && WS_RGOUT + 2 * SQ_BYTES <= WS_HGIN, "ws map 1");
static_assert(WS_HGIN + 4 * SQ_BYTES <= WS_HGOUT && WS_HGOUT + SQ_BYTES <= WS_GLIN && WS_GLIN + (size_t)GLA_INP * D * 2 <= WS_GLOUT && WS_GLOUT + SQ_BYTES <= WS_H && WS_H + ACT_BYTES <= WS_SCR, "ws map 2");
static_assert((size_t)M * FF * 2 <= 5 * ACT_BYTES, "hid fits");
constexpr int CW_TMO = 0, CW_BAR = 4096;
constexpr int RING_BYTES = 131072, LDSCTL_OFF = RING_BYTES, MISC_OFF = LDSCTL_OFF + 320, LDS_BYTES = 147456;

#define GAS __attribute__((address_space(1)))
#define LAS __attribute__((address_space(3)))
typedef unsigned short bf16;
typedef unsigned v4u __attribute__((ext_vector_type(4)));
typedef unsigned v2u __attribute__((ext_vector_type(2)));
typedef float f32x4 __attribute__((ext_vector_type(4)));
typedef float f32x16 __attribute__((ext_vector_type(16)));
typedef short bf16x8 __attribute__((ext_vector_type(8)));
typedef GAS unsigned gu32;
#define RLX_AGENT __ATOMIC_RELAXED, __HIP_MEMORY_SCOPE_AGENT
#define LDS_WAIT() asm volatile("s_waitcnt lgkmcnt(0)" ::: "memory")
#define VM_WAIT() asm volatile("s_waitcnt vmcnt(0)" ::: "memory")
__device__ __forceinline__ unsigned pk2(float lo, float hi) { return pg8::cvt_pk_bf16(lo, hi); }
__device__ __forceinline__ unsigned f2bf(float f) { return pg8::cvt_pk_bf16(f, 0.f) & 0xffffu; }
__device__ __forceinline__ float bf2f(unsigned h) { return __builtin_bit_cast(float, h << 16); }
__device__ __forceinline__ float sigmoidf_(float x) { return 1.0f / (1.0f + expf(-x)); }

__device__ __forceinline__ int lane_id() { return (int)__builtin_amdgcn_mbcnt_hi(~0u, __builtin_amdgcn_mbcnt_lo(~0u, 0u)); }
#define XB_TMO      128
#define XB_XCNT(j)  (256  + 64 * (j))
#define XB_XSUB(j)  (1280 + 64 * (j))
#define XB_XGEN(j)  (2304 + 64 * (j))
#define XB_TOP      3328
#define XB_TOPGEN   3392
#define XCD_BAR_WORDS 3456
#define XB_SPIN_CAP (1u << 18)

__device__ __forceinline__ unsigned xb_ld(unsigned* p)              { return __hip_atomic_load(p, __ATOMIC_RELAXED, __HIP_MEMORY_SCOPE_AGENT); }
__device__ __forceinline__ unsigned xb_add(unsigned* p, unsigned v) { return __hip_atomic_fetch_add(p, v, __ATOMIC_RELAXED, __HIP_MEMORY_SCOPE_AGENT); }
__device__ __forceinline__ unsigned xb_xcc_id() { return (unsigned)__builtin_amdgcn_s_getreg((3 << 11) | 20) & 0xFu; }
#define XB_SPIN(cond, bar) do { unsigned _sp = 0; while (cond) { __builtin_amdgcn_s_sleep(1); \
    if ((++_sp & 255u) == 0u) { if (xb_ld(&(bar)[XB_TMO])) break; if (_sp > XB_SPIN_CAP) { atomicAdd(&(bar)[XB_TMO], 1u); break; } } } } while (0)

struct XcdBarrier {
    unsigned* bar; unsigned x; int wave;
    volatile LAS unsigned* st;
};

__device__ __forceinline__ XcdBarrier xcd_barrier_post(unsigned* bar, volatile LAS unsigned* st) {
    XcdBarrier b; b.bar = bar; b.x = xb_xcc_id(); b.st = st;
    if (threadIdx.x == 0) (void)xb_add(&bar[XB_XCNT(b.x)], 1u);
    return b;
}
__device__ __forceinline__ void xcd_barrier_complete(unsigned* bar, unsigned x, unsigned& nloc, unsigned& nx) {
    const unsigned G = gridDim.x * gridDim.y * gridDim.z;
    unsigned sum, cnt, mine, sp = 0u;
    for (;;) {
        sum = 0u; cnt = 0u; mine = 0u;
#pragma unroll
        for (unsigned j = 0; j < 16; ++j) { const unsigned c = xb_ld(&bar[XB_XCNT(j)]); sum += c; cnt += (c > 0u) ? 1u : 0u; mine = (j == x) ? c : mine; }
        if (sum == G) break;
        __builtin_amdgcn_s_sleep(1);
        if ((++sp & 255u) == 0u) { if (xb_ld(&bar[XB_TMO])) break; if (sp > XB_SPIN_CAP) { atomicAdd(&bar[XB_TMO], 1u); break; } }
    }
    nloc = mine > 0u ? mine : 1u; nx = cnt > 0u ? cnt : 1u;
}

__device__ __forceinline__ void xcd_barrier(const XcdBarrier& b) {
    asm volatile("s_waitcnt vmcnt(0)" ::: "memory");
    __syncthreads();
    if (b.wave == 0 && (int)__builtin_amdgcn_mbcnt_hi(~0u, __builtin_amdgcn_mbcnt_lo(~0u, 0u)) == 0) {
        unsigned* bar = b.bar; unsigned bx_ = b.x; asm volatile("" : "+s"(bar), "+s"(bx_));
        __builtin_amdgcn_s_waitcnt(0);
        unsigned nloc = b.st[0], nx = b.st[1];
        if (nloc == 0u) { xcd_barrier_complete(bar, bx_, nloc, nx); b.st[0] = nloc; b.st[1] = nx; }
        const unsigned old = xb_add(&bar[XB_XSUB(bx_)], 1u);
        const unsigned gen = old / nloc;
        if (old + 1u == (gen + 1u) * nloc) {
            __builtin_amdgcn_fence(__ATOMIC_RELEASE, "agent");
            asm volatile("s_waitcnt vmcnt(0)" ::: "memory");
            const unsigned og = xb_add(&bar[XB_TOP], 1u);
            const unsigned tg = og / nx;
            if (og + 1u == (tg + 1u) * nx) xb_add(&bar[XB_TOPGEN], 1u);
            else XB_SPIN(xb_ld(&bar[XB_TOPGEN]) == tg, bar);
            __builtin_amdgcn_fence(__ATOMIC_ACQUIRE, "agent");
            xb_add(&bar[XB_XGEN(bx_)], 1u);
            asm volatile("s_waitcnt vmcnt(0)" ::: "memory");
        } else {
            XB_SPIN(xb_ld(&bar[XB_XGEN(bx_)]) == gen, bar);
            __builtin_amdgcn_fence(__ATOMIC_ACQUIRE, "agent");
            asm volatile("s_waitcnt vmcnt(0)" ::: "memory");
        }
    }
    __syncthreads();
}
struct Frame {
    LAS unsigned char* lds;
    volatile LAS unsigned* MISC;
    gu32* ctl;
    int wave, vcu, G;
};
__device__ __forceinline__ float wave_sum(float v) {
#pragma unroll
    for (int o = 1; o < 64; o <<= 1) v += __shfl_xor(v, o);
    return v;
}
__device__ __forceinline__ void conv_item(const float* W, int N, int k0, int n0, int nvalid, bf16* WT, int Kd, int drow0, LAS float* scr, int lane) {
    const bool ok = (lane & 31) < nvalid;
#pragma unroll 8
    for (int i = 0; i < 32; ++i) { const int kk = 2 * i + (lane >> 5); scr[kk * 33 + (lane & 31)] = ok ? W[(size_t)(k0 + kk) * N + n0 + (lane & 31)] : 0.f; }
    LDS_WAIT(); asm volatile("" ::: "memory");
    const int c = lane & 7;
#pragma unroll
    for (int j = 0; j < 4; ++j) { const int n = (lane >> 3) + 8 * j; const LAS float* s = scr + (8 * c) * 33 + n;
        v4u o; o.x = pk2(s[0 * 33], s[1 * 33]); o.y = pk2(s[2 * 33], s[3 * 33]); o.z = pk2(s[4 * 33], s[5 * 33]); o.w = pk2(s[6 * 33], s[7 * 33]);
        *(GAS v4u*)(WT + (size_t)(drow0 + n) * Kd + k0 + 8 * c) = o; }
    LDS_WAIT(); asm volatile("" ::: "memory");
}
struct ProIn { const float *c, *ada_w, *ada_b, *w13, *w2, *rg_w_in, *rg_gate_w, *rg_w_out, *hg_w_in, *hg_lb, *hg_w_out, *gla_w_in, *gla_w_out; };
__device__ __forceinline__ void p0_prologue(Frame& F, const ProIn& P, unsigned char* ws) {
    int lane_ = lane_id(); asm volatile("" : "+v"(lane_)); const int lane = lane_;
    int gw_ = F.wave * F.G + F.vcu; asm volatile("" : "+s"(gw_)); const int gw = gw_, NGW = F.G * NWAVES;
    float* MOD = (float*)(ws + WS_MOD);
    for (int blk = gw; blk < DEPTH * NMOD * D / 32; blk += NGW) {
        const int n0 = blk * 32, l = n0 / (NMOD * D), nn = n0 % (NMOD * D);
        const float* Wp = P.ada_w + (size_t)l * D * (NMOD * D) + nn + (lane & 31) + (size_t)(lane >> 5) * (NMOD * D);
        const float* Cp = P.c + (size_t)(lane & 31) * D + (lane >> 5);
        f32x16 acc = {};
        for (int k0 = 0; k0 < D; k0 += 16) {
            float wv[8], cv[8];
#pragma unroll
            for (int i = 0; i < 8; ++i) { wv[i] = Wp[(size_t)(k0 + 2 * i) * (NMOD * D)]; cv[i] = Cp[k0 + 2 * i]; }
#pragma unroll
            for (int i = 0; i < 8; ++i) { const float ca = cv[i] / (1.0f + expf(-cv[i])); acc = __builtin_amdgcn_mfma_f32_32x32x2f32(ca, wv[i], acc, 0, 0, 0); }
        }
        const float bias = P.ada_b[(size_t)l * (NMOD * D) + nn + (lane & 31)];
#pragma unroll
        for (int r = 0; r < 16; ++r) { const int b = (r & 3) + 8 * (r >> 2) + 4 * (lane >> 5); MOD[((size_t)l * BATCH + b) * (NMOD * D) + nn + (lane & 31)] = acc[r] + bias; }
    }
    if (F.vcu == 0) { float* LB = (float*)(ws + WS_LB);
        for (int ch = F.wave * 64 + lane; ch < D; ch += NWAVES * 64) { const float g0 = P.hg_lb[ch], g1 = P.hg_lb[D + ch], g2 = P.hg_lb[2 * D + ch], g3 = P.hg_lb[3 * D + ch];
            const float mx = fmaxf(fmaxf(g0, g1), fmaxf(g2, g3)); const float e0 = expf(g0 - mx), e1 = expf(g1 - mx), e2 = expf(g2 - mx), e3 = expf(g3 - mx);
            LB[ch] = e1 / (e0 + e1 + e2 + e3); } }
    LAS float* scr = (LAS float*)(F.lds + F.wave * 16384);
    int gw2_ = F.vcu * NWAVES + F.wave; asm volatile("" : "+s"(gw2_)); const int gw2 = gw2_;
    constexpr int I_W13 = 16 * 176, I_W2 = 44 * 32, I_RGIN = 16 * 64, I_RGG = 2 * 8, I_SQ = 16 * 32, I_HGIN = 16 * 128, I_GLIN = 16 * (GLA_INP / 32);
    constexpr int T0 = 8 * I_W13, T1 = T0 + 8 * I_W2, T2 = T1 + 2 * I_RGIN, T3 = T2 + 16 * I_RGG, T4 = T3 + 2 * I_SQ, T5 = T4 + I_HGIN, T6 = T5 + I_SQ, T7 = T6 + I_GLIN, T8 = T7 + I_SQ;
    for (int it = gw2; it < T8; it += NGW) {
        int r = it;
        if (r < T0) { const int mi = r / I_W13, q = r % I_W13, kb = q / 176, nb = q % 176, n0 = nb * 32;
            const int drow = n0 < FF ? (n0 / 128) * 256 + (n0 % 128) : ((n0 - FF) / 128) * 256 + 128 + ((n0 - FF) % 128);
            conv_item(P.w13 + (size_t)mi * D * 2 * FF, 2 * FF, kb * 64, n0, 32, (bf16*)(ws + WS_W13 + mi * W13_BYTES), D, drow, scr, lane); continue; }
        r -= T0;
        if (r < 8 * I_W2) { const int mi = r / I_W2, q = r % I_W2, kb = q / 32, nb = q % 32;
            conv_item(P.w2 + (size_t)mi * FF * D, D, kb * 64, nb * 32, 32, (bf16*)(ws + WS_W2 + mi * W2_BYTES), FF, nb * 32, scr, lane); continue; }
        r -= 8 * I_W2;
        if (r < 2 * I_RGIN) { const int mi = r / I_RGIN, q = r % I_RGIN, kb = q / 64, nb = q % 64;
            conv_item(P.rg_w_in + (size_t)mi * D * 2048, 2048, kb * 64, nb * 32, 32, (bf16*)(ws + WS_RGIN + mi * RGIN_BYTES), D, nb * 32, scr, lane); continue; }
        r -= 2 * I_RGIN;
        if (r < 16 * I_RGG) { const int mi = r / I_RGG, q = r % I_RGG, kb = q / 8, nb = q % 8;
            conv_item(P.rg_gate_w + (size_t)mi * 128 * 256, 256, kb * 64, nb * 32, 32, (bf16*)(ws + WS_RGG) + (size_t)mi * 256 * 128, 128, nb * 32, scr, lane); continue; }
        r -= 16 * I_RGG;
        if (r < 2 * I_SQ) { const int mi = r / I_SQ, q = r % I_SQ, kb = q / 32, nb = q % 32;
            conv_item(P.rg_w_out + (size_t)mi * D * D, D, kb * 64, nb * 32, 32, (bf16*)(ws + WS_RGOUT + mi * SQ_BYTES), D, nb * 32, scr, lane); continue; }
        r -= 2 * I_SQ;
        if (r < I_HGIN) { const int kb = r / 128, nb = r % 128;
            conv_item(P.hg_w_in, 4096, kb * 64, nb * 32, 32, (bf16*)(ws + WS_HGIN), D, nb * 32, scr, lane); continue; }
        r -= I_HGIN;
        if (r < I_SQ) { const int kb = r / 32, nb = r % 32;
            conv_item(P.hg_w_out, D, kb * 64, nb * 32, 32, (bf16*)(ws + WS_HGOUT), D, nb * 32, scr, lane); continue; }
        r -= I_SQ;
        if (r < I_GLIN) { const int kb = r / (GLA_INP / 32), nb = r % (GLA_INP / 32), n0 = nb * 32; const int nv = GLA_IN - n0 < 0 ? 0 : (GLA_IN - n0 > 32 ? 32 : GLA_IN - n0);
            conv_item(P.gla_w_in, GLA_IN, kb * 64, nv > 0 ? n0 : 0, nv, (bf16*)(ws + WS_GLIN), D, n0, scr, lane); continue; }
        r -= I_GLIN;
        { const int kb = r / 32, nb = r % 32;
            conv_item(P.gla_w_out, D, kb * 64, nb * 32, 32, (bf16*)(ws + WS_GLOUT), D, nb * 32, scr, lane); }
    }
}
__device__ __forceinline__ void norm_phase(Frame& F, const float* x, const float* nw, const float* shift, const float* scale, bf16* H) {
    int lane_ = lane_id(); asm volatile("" : "+v"(lane_)); const int lane = lane_;
    int gw_ = F.vcu * NWAVES + F.wave; asm volatile("" : "+s"(gw_)); const int gw = gw_, NGW = F.G * NWAVES;
    for (int strip = gw; strip < M / 32; strip += NGW) {
        const int b = (strip * 32) / SEQ;
        f32x4 gv[4], sv[4];
#pragma unroll
        for (int j = 0; j < 4; ++j) { const int col = 4 * lane + 256 * j;
            gv[j] = *(const f32x4*)(nw + col) * (1.0f + *(const f32x4*)(scale + (size_t)b * (NMOD * D) + col)); sv[j] = *(const f32x4*)(shift + (size_t)b * (NMOD * D) + col); }
        for (int rr = 0; rr < 32; ++rr) { const size_t row = (size_t)strip * 32 + rr;
            const GAS f32x4* xr = (const GAS f32x4*)(x + row * D) + lane;
            f32x4 v[4]; float s = 0.f;
#pragma unroll
            for (int j = 0; j < 4; ++j) { v[j] = xr[64 * j]; s += (v[j].x * v[j].x + v[j].y * v[j].y) + (v[j].z * v[j].z + v[j].w * v[j].w); }
            const float rstd = 1.0f / sqrtf(wave_sum(s) * (1.f / D) + EPS);
            GAS v2u* o8 = (GAS v2u*)(H + row * D) + lane;
#pragma unroll
            for (int j = 0; j < 4; ++j) { const f32x4 o = v[j] * rstd * gv[j] + sv[j]; v2u w; w.x = pk2(o.x, o.y); w.y = pk2(o.z, o.w); o8[64 * j] = w; }
        }
    }
}
__device__ __forceinline__ void final_norm_phase(Frame& F, const float* x, const float* w, float* out) {
    int lane_ = lane_id(); asm volatile("" : "+v"(lane_)); const int lane = lane_;
    int gw_ = F.vcu * NWAVES + F.wave; asm volatile("" : "+s"(gw_)); const int gw = gw_, NGW = F.G * NWAVES;
    f32x4 gv[4];
#pragma unroll
    for (int j = 0; j < 4; ++j) gv[j] = *(const f32x4*)(w + 4 * lane + 256 * j);
    for (int strip = gw; strip < M / 32; strip += NGW) {
        for (int rr = 0; rr < 32; ++rr) { const size_t row = (size_t)strip * 32 + rr;
            const GAS f32x4* xr = (const GAS f32x4*)(x + row * D) + lane;
            f32x4 v[4]; float s = 0.f;
#pragma unroll
            for (int j = 0; j < 4; ++j) { v[j] = xr[64 * j]; s += (v[j].x * v[j].x + v[j].y * v[j].y) + (v[j].z * v[j].z + v[j].w * v[j].w); }
            const float rstd = 1.0f / sqrtf(wave_sum(s) * (1.f / D) + EPS);
            GAS f32x4* o = (GAS f32x4*)(out + row * D) + lane;
#pragma unroll
            for (int j = 0; j < 4; ++j) o[64 * j] = v[j] * rstd * gv[j];
        }
    }
}
#define MFMA16(a, b, c) __builtin_amdgcn_mfma_f32_16x16x32_bf16((a), (b), (c), 0, 0, 0)
__device__ __forceinline__ bf16x8 ld_b128(const LAS unsigned char* p) { return *(const LAS bf16x8*)p; }
__device__ __forceinline__ bf16x8 ld_2xb64(const LAS unsigned char* p0, const LAS unsigned char* p1) { const v2u a = *(const LAS v2u*)p0, b = *(const LAS v2u*)p1; v4u w; w.x = a.x; w.y = a.y; w.z = b.x; w.w = b.y; return __builtin_bit_cast(bf16x8, w); }
__device__ __forceinline__ bf16x8 pack8f(const f32x4 a, const f32x4 b) { return __builtin_bit_cast(bf16x8, pg8::pack8(a, b)); }
#define LOG2E 1.4426950408889634f
#define LN2 0.6931471805599453f
__device__ __forceinline__ float fexp2(float x) { return __builtin_amdgcn_exp2f(x); }
__device__ __forceinline__ float frcp(float x) { return __builtin_amdgcn_rcpf(x); }
__device__ __forceinline__ float fsigm(float x) { return frcp(1.0f + fexp2(-LOG2E * x)); }
#ifndef DBG_R4
#define DBG_R4 4
#endif
typedef __amdgpu_buffer_rsrc_t rsrc_t;
__device__ __forceinline__ rsrc_t mk_rsrc(const void* p) { return __builtin_amdgcn_make_buffer_rsrc((void*)p, 0, 0x7fffffff, 0x00020000); }
__device__ __forceinline__ float bld_bf(rsrc_t r, unsigned voff, unsigned soff) { const unsigned w = __builtin_amdgcn_raw_buffer_load_b32(r, voff & ~3u, soff, 0); return __builtin_bit_cast(float, (voff & 2u) ? (w & 0xffff0000u) : (w << 16)); }
__device__ __forceinline__ unsigned bld_raw(rsrc_t r, unsigned voff, unsigned soff) { return __builtin_amdgcn_raw_buffer_load_b32(r, voff & ~3u, soff, 0); }
__device__ __forceinline__ float half_bf(unsigned w, unsigned voff) { return __builtin_bit_cast(float, (voff & 2u) ? (w & 0xffff0000u) : (w << 16)); }
__device__ __forceinline__ unsigned half_u16(unsigned w, unsigned voff) { return (voff & 2u) ? (w >> 16) : (w & 0xffffu); }
__device__ __forceinline__ unsigned short bld_u16(rsrc_t r, unsigned voff, unsigned soff) { const unsigned w = __builtin_amdgcn_raw_buffer_load_b32(r, voff & ~3u, soff, 0); return (unsigned short)((voff & 2u) ? (w >> 16) : (w & 0xffffu)); }
__device__ __forceinline__ float bld_f32(rsrc_t r, unsigned voff, unsigned soff) { return __builtin_bit_cast(float, __builtin_amdgcn_raw_buffer_load_b32(r, voff, soff, 0)); }
__device__ __forceinline__ v4u bld_b128(rsrc_t r, unsigned voff, unsigned soff) { return __builtin_amdgcn_raw_buffer_load_b128(r, voff, soff, 0); }
struct RgArgs { const bf16* Y; const bf16* XB; bf16* HY; const bf16* WgT; const float *gate_b, *lam, *conv_w, *conv_b; };
#define LDS_BARRIER() do { asm volatile("s_waitcnt lgkmcnt(0)" ::: "memory"); __builtin_amdgcn_s_barrier(); asm volatile("" ::: "memory"); } while (0)
#define WAVE_SYNC() asm volatile("" ::: "memory")
__device__ __forceinline__ void rg_scan_phase(Frame& F, const RgArgs A) {
    LAS unsigned char* L = F.lds;
    int tid_ = F.wave * 64 + lane_id(); asm volatile("" : "+v"(tid_));
    const int tid = tid_, lane = tid & 63, wave = F.wave, q = lane >> 4, l15 = lane & 15;
    const int cch = tid & 127, tg = wave >> 1, chl = 16 * wave + l15;
    typedef float f32x2v __attribute__((ext_vector_type(2)));
    LAS f32x2v* AU = (LAS f32x2v*)(L + 50176 + wave * 4608);
    LAS f32x2v* PH = (LAS f32x2v*)(L + 50176 + wave * 4608 + 4096);
    for (int unit = blockIdx.x; unit < BATCH * 8; unit += gridDim.x) {
        const int b = unit >> 3, hd = unit & 7, colbase = hd * 128; const size_t rowbase = (size_t)b * SEQ;
        const bf16* Wg = A.WgT + (size_t)hd * 256 * 128;
        bf16x8 Bx[4], Ba[4];
#pragma unroll
        for (int s = 0; s < 4; ++s) { Bx[s] = *(const bf16x8*)(Wg + (size_t)chl * 128 + 32 * s + 8 * q); Ba[s] = *(const bf16x8*)(Wg + (size_t)(128 + chl) * 128 + 32 * s + 8 * q); }
        const float bx = A.gate_b[hd * 256 + chl], ba = A.gate_b[hd * 256 + 128 + chl];
        const float lamv = A.lam[colbase + chl]; const float sp8 = 8.0f * (fmaxf(-lamv, 0.f) + log1pf(expf(-fabsf(lamv))));
        const float cw0 = A.conv_w[colbase + cch], cw1 = A.conv_w[D + colbase + cch], cw2 = A.conv_w[2 * D + colbase + cch], cw3 = A.conv_w[3 * D + colbase + cch], cb = A.conv_b[colbase + cch];
        float h = 0.f;
        const rsrc_t rxb = mk_rsrc(A.XB + rowbase * D + colbase), ry = mk_rsrc(A.Y + rowbase * D + colbase), rhy = mk_rsrc(A.HY + rowbase * D + colbase);
        const unsigned vo = (unsigned)(8 * tg * D + cch) * 2u;
        const unsigned voy = (unsigned)(8 * q * D + chl) * 2u;
        unsigned xw[11], yw[8];
#pragma unroll
        for (int i = 0; i < 11; ++i) { const int t = 8 * tg - 3 + i; const unsigned w = bld_raw(rxb, (unsigned)cch * 2u, (unsigned)(t < 0 ? 0 : t) * 2048u); xw[i] = t >= 0 ? w : 0u; }
#pragma unroll
        for (int i = 0; i < 8; ++i) yw[i] = bld_raw(ry, voy, (unsigned)i * 2048u);
        for (int step = 0; step < SEQ / 32; ++step) {
            const int t0 = step * 32;
            LAS float* XC = (LAS float*)(L + (step & 1) * 25088); LAS unsigned char* XCB = L + (step & 1) * 25088 + 16384;
            float xb[11], yv[8];
#pragma unroll
            for (int i = 0; i < 11; ++i) xb[i] = half_bf(xw[i], (unsigned)cch * 2u);
#pragma unroll
            for (int i = 0; i < 8; ++i) yv[i] = half_bf(yw[i], voy);
#pragma unroll
            for (int i = 0; i < 8; ++i) { const float xc = cb + cw0 * xb[i] + cw1 * xb[i + 1] + cw2 * xb[i + 2] + cw3 * xb[i + 3];
                XC[(8 * tg + i) * 128 + cch] = xc; *(LAS unsigned short*)(XCB + (8 * tg + i) * 272 + cch * 2) = (unsigned short)f2bf(xc); }
            if (step + 1 < SEQ / 32) {
#pragma unroll
                for (int i = 0; i < 11; ++i) xw[i] = bld_raw(rxb, vo, (unsigned)(t0 + 32 - 3 + i) * 2048u);
#pragma unroll
                for (int i = 0; i < 8; ++i) yw[i] = bld_raw(ry, voy, (unsigned)(t0 + 32 + i) * 2048u);
            }
            LDS_BARRIER();
            f32x4 ax[2], aa[2];
#pragma unroll
            for (int tb = 0; tb < 2; ++tb) { ax[tb] = (f32x4){0.f, 0.f, 0.f, 0.f}; aa[tb] = (f32x4){0.f, 0.f, 0.f, 0.f};
#pragma unroll
                for (int s = 0; s < 4; ++s) { const bf16x8 a = ld_b128(XCB + (16 * tb + l15) * 272 + 64 * s + 16 * q); ax[tb] = MFMA16(a, Bx[s], ax[tb]); aa[tb] = MFMA16(a, Ba[s], aa[tb]); } }
#pragma unroll
            for (int tb = 0; tb < 2; ++tb)
#pragma unroll
                for (int r = 0; r < 4; ++r) { const int t = 16 * tb + 4 * q + r;
                    const float gx = ax[tb][r] + bx, ga = aa[tb][r] + ba;
                    const float la = -fsigm(ga) * sp8; const float a = fexp2(LOG2E * la);
                    const float x2 = 2.0f * la;
                    const float ser = -x2 * (1.0f + x2 * (0.5f + x2 * (0.16666667f + x2 * (0.041666668f + x2 * 0.008333334f))));
                    float m2 = x2 > -0.25f ? ser : 1.0f - a * a; float mult = __builtin_amdgcn_sqrtf(m2); if (t0 + t == 0) mult = 1.0f;
                    AU[t * 16 + l15] = (f32x2v){a, fsigm(gx) * XC[t * 128 + chl] * mult}; }
            WAVE_SYNC();
            float av[8], uv[8]; float P = 1.0f, Hl = 0.f;
#pragma unroll
            for (int i = 0; i < 8; ++i) { const f32x2v au = AU[(8 * q + i) * 16 + l15]; av[i] = au.x; uv[i] = au.y; Hl = av[i] * Hl + uv[i]; P *= av[i]; }
            PH[q * 16 + l15] = (f32x2v){P, Hl};
            WAVE_SYNC();
            { const f32x2v m0 = PH[l15], m1 = PH[16 + l15], m2_ = PH[32 + l15], m3 = PH[48 + l15];
                const float c1 = m0.x * h + m0.y, c2 = m1.x * c1 + m1.y, c3 = m2_.x * c2 + m2_.y, c4 = m3.x * c3 + m3.y;
                float hh = q == 0 ? h : (q == 1 ? c1 : (q == 2 ? c2 : c3)); h = c4;
#pragma unroll
                for (int i = 0; i < 8; ++i) { hh = av[i] * hh + uv[i]; __builtin_amdgcn_raw_buffer_store_b16((unsigned short)f2bf(hh * yv[i]), rhy, voy, (unsigned)(t0 + i) * 2048u, 0); } }
            WAVE_SYNC();
        }
        __syncthreads();
    }
}
struct GlaArgs { const bf16* Q; const bf16* K; const float* LOGF; const bf16* V; const bf16* G; const float* ALOW; const float *w2, *gb, *nw; bf16* OUT; float* SS; };
template <int DV, bool GLA>
__device__ __forceinline__ void gla_scan_phase(Frame& F, const GlaArgs A) {
    constexpr int NH = GLA ? 4 : 8, NCB = DV / 128, QLD = GLA ? 512 : 1024, NV = DV / 16, VTG = 512 / DV  , VTOK = 32 / VTG;
    LAS unsigned char* L = F.lds;
    LAS unsigned char* QT = L;
    LAS unsigned char* KT = L + 8704;
    LAS unsigned char* KHT = L + 17408;
    LAS unsigned char* VT = L + 27648;
    LAS float* DEC = (LAS float*)(L + 48128);
    LAS float* GT = (LAS float*)(L + 48640);
    LAS float* OB = (LAS float*)(L + 50688);
    LAS float* ALS = (LAS float*)(L + 83456);
    LAS float* NWL = (LAS float*)(L + 87552);
    int tid_ = F.wave * 64 + lane_id(); asm volatile("" : "+v"(tid_));
    const int tid = tid_, lane = tid & 63, wave = F.wave, q = lane >> 4, l15 = lane & 15;
    const int kc = tid & 127, tg = wave >> 1, vdv = tid & (DV - 1), vtg = wave / (DV / 64), ot = tid >> 4, oc = tid & 15;
    for (int unit = blockIdx.x; unit < BATCH * NH; unit += gridDim.x) {
        const int b = unit / NH, hd = unit % NH; const size_t rowbase = (size_t)b * SEQ;
        f32x4 S[NCB][8];
#pragma unroll
        for (int cb = 0; cb < NCB; ++cb)
#pragma unroll
            for (int kt = 0; kt < 8; ++kt) S[cb][kt] = (f32x4){0.f, 0.f, 0.f, 0.f};
        const rsrc_t rq = mk_rsrc(A.Q + rowbase * QLD + hd * 128), rk = mk_rsrc(GLA ? (const void*)(A.K + rowbase * QLD + hd * 128) : (const void*)(A.LOGF + rowbase * D + hd * 128));
        const rsrc_t rv = mk_rsrc(A.V + rowbase * D + hd * DV), rg = mk_rsrc(A.G + rowbase * D + hd * DV), ro = mk_rsrc(A.OUT + rowbase * D + hd * DV), ral = mk_rsrc(GLA ? A.ALOW + rowbase * 16 : nullptr);
        const unsigned voq = (unsigned)(8 * tg * QLD + kc) * 2u, vok = GLA ? voq : (unsigned)(8 * tg * D + kc) * 4u, vov = (unsigned)(VTOK * vtg * D + vdv) * 2u, vog = (unsigned)(ot * D + oc * NV) * 2u;
        constexpr unsigned QST = QLD * 2u, KST = GLA ? QLD * 2u : D * 4u, VST = D * 2u;
        float w2r[16]; float gbv = 0.f;
        if (GLA) {
#pragma unroll
            for (int r = 0; r < 16; ++r) w2r[r] = A.w2[r * 512 + hd * 128 + kc];
            gbv = A.gb[hd * 128 + kc]; }
        if (tid < DV) NWL[tid] = A.nw[(GLA ? 0 : hd * 128) + tid];
        unsigned qw[8], kw[8], vw[VTOK]; float alv = 0.f; v4u gg[NV / 8], ggn[NV / 8];
#pragma unroll
        for (int i = 0; i < 8; ++i) { qw[i] = bld_raw(rq, voq, (unsigned)i * QST); kw[i] = bld_raw(rk, vok, (unsigned)i * KST); }
#pragma unroll
        for (int i = 0; i < VTOK; ++i) vw[i] = bld_raw(rv, vov, (unsigned)i * VST);
#pragma unroll
        for (int e = 0; e < NV / 8; ++e) gg[e] = bld_b128(rg, vog + 16u * e, 0u);
        if (GLA) { ALS[tid] = bld_f32(ral, (unsigned)tid * 4u, 0u); alv = bld_f32(ral, (unsigned)tid * 4u, 32u * 64u); }
        __syncthreads();
        for (int n = 0; n < SEQ / 32; ++n) {
            const unsigned r0 = (unsigned)n * 32u;
            float qv[8], kv[8]; unsigned vv[VTOK];
#pragma unroll
            for (int i = 0; i < 8; ++i) { qv[i] = half_bf(qw[i], voq); kv[i] = GLA ? half_bf(kw[i], vok) : __builtin_bit_cast(float, kw[i]); }
#pragma unroll
            for (int i = 0; i < VTOK; ++i) vv[i] = half_u16(vw[i], vov);
            float bl[8], kt_[8];
            { float c = 0.f;
#pragma unroll
                for (int i = 0; i < 8; ++i) { float g2;
                    if (GLA) { const LAS float* al = ALS + (n & 1) * 512 + (8 * tg + i) * 16; float z = gbv;
#pragma unroll
                        for (int r4 = 0; r4 < 4; ++r4) { const f32x4 a4 = *(const LAS f32x4*)(al + 4 * r4); z += a4[0] * w2r[4 * r4] + a4[1] * w2r[4 * r4 + 1] + a4[2] * w2r[4 * r4 + 2] + a4[3] * w2r[4 * r4 + 3]; }
                        g2 = (fminf(z, 0.f) * LOG2E - __builtin_amdgcn_logf(1.0f + fexp2(-LOG2E * fabsf(z)))) * (1.0f / 16.0f); kt_[i] = kv[i]; }
                    else { g2 = kv[i] * LOG2E; kt_[i] = 1.0f - fexp2(g2); }
                    c += g2; bl[i] = c; }
                GT[tg * 128 + kc] = c; }
            LDS_BARRIER();
            { const float g0 = GT[kc], g1 = GT[128 + kc], g2 = GT[256 + kc], g3 = GT[384 + kc];
                const float off = (tg > 0 ? g0 : 0.f) + (tg > 1 ? g1 : 0.f) + (tg > 2 ? g2 : 0.f), tot = (g0 + g1) + (g2 + g3);
                const float qs = GLA ? 0.08838834764831845f : 1.0f, etot = fexp2(tot);
                float kh[8];
#pragma unroll
                for (int i = 0; i < 8; ++i) { const float bb = bl[i] + off; const int t = 8 * tg + i; const float e1 = fexp2(bb), e2 = frcp(e1);
                    *(LAS unsigned short*)(QT + t * 272 + kc * 2) = (unsigned short)f2bf(qv[i] * qs * e1);
                    const float k2 = kt_[i] * e2;
                    *(LAS unsigned short*)(KT + t * 272 + kc * 2) = (unsigned short)f2bf(k2);
                    kh[i] = k2 * etot; }
                v4u w; w.x = pk2(kh[0], kh[1]); w.y = pk2(kh[2], kh[3]); w.z = pk2(kh[4], kh[5]); w.w = pk2(kh[6], kh[7]);
                *(LAS v4u*)(KHT + kc * 80 + 16 * tg) = w;
                if (tg == 0) DEC[kc] = etot; }
#pragma unroll
            for (int i8 = 0; i8 < VTOK / 8; ++i8) { v4u w; w.x = vv[8 * i8] | (vv[8 * i8 + 1] << 16); w.y = vv[8 * i8 + 2] | (vv[8 * i8 + 3] << 16); w.z = vv[8 * i8 + 4] | (vv[8 * i8 + 5] << 16); w.w = vv[8 * i8 + 6] | (vv[8 * i8 + 7] << 16);
                *(LAS v4u*)(VT + vdv * 80 + (VTOK * vtg + 8 * i8) * 2) = w; }
            if (n + 1 < SEQ / 32) { const unsigned rn = r0 + 32u;
#pragma unroll
                for (int i = 0; i < 8; ++i) { qw[i] = bld_raw(rq, voq, (rn + i) * QST); kw[i] = bld_raw(rk, vok, (rn + i) * KST); }
#pragma unroll
                for (int i = 0; i < VTOK; ++i) vw[i] = bld_raw(rv, vov, (rn + i) * VST);
#pragma unroll
                for (int e = 0; e < NV / 8; ++e) ggn[e] = bld_b128(rg, vog + 16u * e, rn * VST); }
            LDS_BARRIER();
            if (GLA) { ALS[((n + 1) & 1) * 512 + tid] = alv; if (n + 2 < SEQ / 32) alv = bld_f32(ral, (unsigned)tid * 4u, (r0 + 64u) * 64u); }
            f32x4 P00 = {0.f, 0.f, 0.f, 0.f}, P01 = P00, P11 = P00;
#pragma unroll
            for (int s = 0; s < 4; ++s) { const bf16x8 KA0 = ld_b128(KT + l15 * 272 + 64 * s + 16 * q), KA1 = ld_b128(KT + (16 + l15) * 272 + 64 * s + 16 * q);
                const bf16x8 QB0 = ld_b128(QT + l15 * 272 + 64 * s + 16 * q), QB1 = ld_b128(QT + (16 + l15) * 272 + 64 * s + 16 * q);
                P00 = MFMA16(KA0, QB0, P00); P01 = MFMA16(KA0, QB1, P01); P11 = MFMA16(KA1, QB1, P11); }
#pragma unroll
            for (int r = 0; r < 4; ++r) if (l15 < 4 * q + r) { P00[r] = 0.f; P11[r] = 0.f; }
            const bf16x8 PA0 = pack8f(P00, (f32x4){0.f, 0.f, 0.f, 0.f}), PA1 = pack8f(P01, P11);
            bf16x8 VB[NCB];
#pragma unroll
            for (int cb = 0; cb < NCB; ++cb) { const LAS unsigned char* vr = VT + (16 * (wave * NCB + cb) + l15) * 80 + 8 * q; VB[cb] = ld_2xb64(vr, vr + 32); }
            f32x4 O[NCB][2];
#pragma unroll
            for (int cb = 0; cb < NCB; ++cb)
#pragma unroll
                for (int tb = 0; tb < 2; ++tb) O[cb][tb] = (f32x4){0.f, 0.f, 0.f, 0.f};
#pragma unroll
            for (int s = 0; s < 4; ++s) {
                bf16x8 QA[2];
#pragma unroll
                for (int tb = 0; tb < 2; ++tb) { const LAS unsigned char* qr = QT + (16 * tb + l15) * 272 + 64 * s + 8 * q; QA[tb] = ld_2xb64(qr, qr + 32); }
#pragma unroll
                for (int cb = 0; cb < NCB; ++cb) { const bf16x8 SB = pack8f(S[cb][2 * s], S[cb][2 * s + 1]);
                    O[cb][0] = MFMA16(QA[0], SB, O[cb][0]); O[cb][1] = MFMA16(QA[1], SB, O[cb][1]); } }
#pragma unroll
            for (int cb = 0; cb < NCB; ++cb) { O[cb][0] = MFMA16(PA0, VB[cb], O[cb][0]); O[cb][1] = MFMA16(PA1, VB[cb], O[cb][1]); }
#pragma unroll
            for (int kt = 0; kt < 8; ++kt) { const f32x4 dec = *(const LAS f32x4*)(DEC + 16 * kt + 4 * q);
                const LAS unsigned char* kr = KHT + (16 * kt + l15) * 80 + 8 * q; const bf16x8 KH = ld_2xb64(kr, kr + 32);
#pragma unroll
                for (int cb = 0; cb < NCB; ++cb) S[cb][kt] = MFMA16(KH, VB[cb], S[cb][kt] * dec); }
#pragma unroll
            for (int cb = 0; cb < NCB; ++cb)
#pragma unroll
                for (int tb = 0; tb < 2; ++tb)
#pragma unroll
                    for (int r = 0; r < 4; ++r) OB[(16 * tb + 4 * q + r) * DV + 16 * (wave * NCB + cb) + l15] = O[cb][tb][r];
#ifdef DBG_TRIVIAL
#pragma unroll
            for (int cb = 0; cb < NCB; ++cb)
#pragma unroll
                for (int tb = 0; tb < 2; ++tb)
#pragma unroll
                    for (int r = 0; r < 4; ++r) { const int t = 16 * tb + 4 * q + r, dv = 16 * (wave * NCB + cb) + l15;
                        float vsum = 0.f; if (DBG_TRIVIAL & 1) vsum += bf2f(*(const LAS unsigned short*)(VT + dv * 80 + t * 2)); if (DBG_TRIVIAL & 2) vsum += bf2f(*(const LAS unsigned short*)(QT + t * 272 + (dv & 127) * 2)); if (DBG_TRIVIAL & 4) vsum += bf2f(*(const LAS unsigned short*)(KHT + (dv & 127) * 80 + t * 2)); if (DBG_TRIVIAL & 8) vsum += 1.0f + 0.001f * (float)(t + dv);
                        OB[t * DV + dv] = vsum; }
#endif
            LDS_BARRIER();
            { float o[NV]; float ss = 0.f;
#pragma unroll
                for (int e4 = 0; e4 < NV / 4; ++e4) { const f32x4 v = *(const LAS f32x4*)(OB + ot * DV + oc * NV + 4 * e4); o[4 * e4] = v[0]; o[4 * e4 + 1] = v[1]; o[4 * e4 + 2] = v[2]; o[4 * e4 + 3] = v[3]; ss += (v[0] * v[0] + v[1] * v[1]) + (v[2] * v[2] + v[3] * v[3]); }
                ss += __shfl_xor(ss, 1); ss += __shfl_xor(ss, 2); ss += __shfl_xor(ss, 4); ss += __shfl_xor(ss, 8);
                float rs = 1.0f;
                if (GLA) rs = 1.0f / sqrtf(ss * (1.0f / DV) + EPS); else if (oc == 0) A.SS[(rowbase + r0 + ot) * 8 + hd] = ss;
#pragma unroll
                for (int e8 = 0; e8 < NV / 8; ++e8) { const v4u gw_ = gg[e8]; float gf[8]; float nwr[NV];
                    { const f32x4 n0 = *(const LAS f32x4*)(NWL + oc * NV + 8 * e8), n1 = *(const LAS f32x4*)(NWL + oc * NV + 8 * e8 + 4); nwr[8 * e8] = n0[0]; nwr[8 * e8 + 1] = n0[1]; nwr[8 * e8 + 2] = n0[2]; nwr[8 * e8 + 3] = n0[3]; nwr[8 * e8 + 4] = n1[0]; nwr[8 * e8 + 5] = n1[1]; nwr[8 * e8 + 6] = n1[2]; nwr[8 * e8 + 7] = n1[3]; }
                    gf[0] = bf2f(gw_.x & 0xffffu); gf[1] = bf2f(gw_.x >> 16); gf[2] = bf2f(gw_.y & 0xffffu); gf[3] = bf2f(gw_.y >> 16); gf[4] = bf2f(gw_.z & 0xffffu); gf[5] = bf2f(gw_.z >> 16); gf[6] = bf2f(gw_.w & 0xffffu); gf[7] = bf2f(gw_.w >> 16);
                    v4u w; w.x = pk2(o[8 * e8] * rs * nwr[8 * e8] * gf[0], o[8 * e8 + 1] * rs * nwr[8 * e8 + 1] * gf[1]); w.y = pk2(o[8 * e8 + 2] * rs * nwr[8 * e8 + 2] * gf[2], o[8 * e8 + 3] * rs * nwr[8 * e8 + 3] * gf[3]);
                    w.z = pk2(o[8 * e8 + 4] * rs * nwr[8 * e8 + 4] * gf[4], o[8 * e8 + 5] * rs * nwr[8 * e8 + 5] * gf[5]); w.w = pk2(o[8 * e8 + 6] * rs * nwr[8 * e8 + 6] * gf[6], o[8 * e8 + 7] * rs * nwr[8 * e8 + 7] * gf[7]);
                    __builtin_amdgcn_raw_buffer_store_b128(w, ro, vog + 16u * e8, r0 * VST, 0); gg[e8] = ggn[e8]; } }
        }
        __syncthreads();
    }
}
constexpr int NPH = 1 + DEPTH * 10 + 1;
struct Args { const float* in[24]; float* out; unsigned char* ws; int ph_lo, ph_hi; };
#define AS4 __attribute__((address_space(4)))
#define KARG() ({ const AS4 Args* _p = (const AS4 Args*)__builtin_amdgcn_kernarg_segment_ptr(); asm volatile("" : "+s"(_p)); _p; })
#define KIN(i) ((const float*)KARG()->in[i])
#define KWS() ((unsigned char*)KARG()->ws)
__global__ void __launch_bounds__(NWAVES * 64, 2) mk_fwd(Args args_unused) {
    extern __shared__ __attribute__((aligned(16))) unsigned char lds[];
    Frame F;
    F.lds = (LAS unsigned char*)lds;
    F.MISC = (volatile LAS unsigned*)(F.lds + MISC_OFF);
    F.wave = __builtin_amdgcn_readfirstlane((int)threadIdx.x >> 6);
    F.G = gridDim.x; { const int bx = blockIdx.x; F.vcu = (F.G % 8 == 0) ? (bx % 8) * (F.G / 8) + bx / 8 : bx; }
    F.ctl = (gu32*)(KWS() + WS_CTL);
    for (int u = threadIdx.x; u < (LDS_BYTES - LDSCTL_OFF) / 4; u += NWAVES * 64) ((LAS unsigned*)(F.lds + LDSCTL_OFF))[u] = 0u;
    __syncthreads();
    XcdBarrier bar = xcd_barrier_post((unsigned*)(F.ctl + CW_BAR), F.MISC + 8); bar.wave = F.wave;
#ifdef PROBE_KIND
#define PB(kind) do { if (((1 << (kind)) & PROBE_KIND) && blockIdx.x == 0 && F.wave == 0 && lane_id() == 0) { volatile unsigned long long* tp_ = (volatile unsigned long long*)(KWS() + 512 * 1024); tp_[0] = __builtin_amdgcn_s_memrealtime(); } } while (0)
#define PE(kind) do { if (((1 << (kind)) & PROBE_KIND) && blockIdx.x == 0 && F.wave == 0 && lane_id() == 0) { volatile unsigned long long* tp_ = (volatile unsigned long long*)(KWS() + 512 * 1024); tp_[1] = tp_[1] + (__builtin_amdgcn_s_memrealtime() - tp_[0]); } } while (0)
#else
#define PB(kind) do {} while (0)
#define PE(kind) do {} while (0)
#endif
#if MK_N_LAUNCHES == 1
#define RUN() true
#define SEAM() xcd_barrier(bar)
#else
    int pi = 0;
#define RUN() (KARG()->ph_lo == pi)
#define SEAM() (++pi)
#endif
    PB(0);
    if (RUN()) { const AS4 Args* a = KARG(); ProIn P{a->in[1], a->in[2], a->in[3], a->in[6], a->in[7], a->in[8], a->in[11], a->in[14], a->in[15], a->in[16], a->in[18], a->in[19], a->in[23]};
        p0_prologue(F, P, KWS()); }
    SEAM(); PE(0);
    for (int l = 0; l < DEPTH; ++l) {
        for (int s = 0; s < 3; ++s) {
#ifdef DBG_NSUB
            if (l * 3 + s >= DBG_NSUB) continue;
#endif
            PB(1);
            if (RUN()) { unsigned char* ws = KWS(); const float* modl = (const float*)(ws + WS_MOD) + (size_t)l * BATCH * (NMOD * D);
                const float* xcur = (l == 0 && s == 0) ? KIN(0) : (const float*)KARG()->out;
                norm_phase(F, xcur, KIN(4) + ((size_t)l * 3 + s) * D, modl + (3 * s) * D, modl + (3 * s + 1) * D, (bf16*)(ws + WS_H)); }
            SEAM(); PE(1);
            PB(s != 1 ? 2 : 4);
            if (RUN()) { unsigned char* ws = KWS(); const bf16* H = (const bf16*)(ws + WS_H); unsigned char* SCR = ws + WS_SCR; const int mx = l % 3, mi = l / 3;
                if (s != 1) { const int fi = l * 2 + (s >> 1);
                    pg8::Gemm g{H, (const bf16*)(ws + WS_W13 + fi * W13_BYTES), M, 2 * FF, D}; pg8::StaticOrder S; S.init(M, 2 * FF, F.G, (int)blockIdx.x);
                    pg8::EpiSwiglu E{(bf16*)SCR, FF};
                    pg8::gemm_phase<pg8::EpiSwiglu, pg8::StaticOrder, true, true>(F.lds, g, S, E, F.wave);
                }
#ifndef NO_MIXIN
                else if (mx == 0) {
                    pg8::Gemm g{H, (const bf16*)(ws + WS_RGIN + mi * RGIN_BYTES), M, 2048, D}; pg8::StaticOrder S; S.init(M, 2048, F.G, (int)blockIdx.x);
                    pg8::EpiRgIn E{(bf16*)SCR};
                    pg8::gemm_phase<pg8::EpiRgIn, pg8::StaticOrder, true, true>(F.lds, g, S, E, F.wave);
                } else if (mx == 1) {
                    pg8::Gemm g{H, (const bf16*)(ws + WS_HGIN), M, 4096, D}; pg8::StaticOrder S; S.init(M, 4096, F.G, (int)blockIdx.x);
                    pg8::EpiHgIn E{(bf16*)SCR, (float*)(SCR + 3 * ACT_BYTES), (const float*)(ws + WS_LB)};
                    pg8::gemm_phase<pg8::EpiHgIn, pg8::StaticOrder, true, true>(F.lds, g, S, E, F.wave);
                } else {
                    pg8::Gemm g{H, (const bf16*)(ws + WS_GLIN), M, GLA_INP, D}; pg8::StaticOrder S; S.init(M, GLA_INP, F.G, (int)blockIdx.x);
                    pg8::EpiGlIn E{(bf16*)SCR, (float*)(SCR + 3 * ACT_BYTES)};
                    pg8::gemm_phase<pg8::EpiGlIn, pg8::StaticOrder, true, true>(F.lds, g, S, E, F.wave);
                }
#endif
            }
            SEAM(); PE(s != 1 ? 2 : 4);
            if (s == 1) {
                PB(5 + l % 3);
                if (RUN()) {
#ifndef NO_SCANS
                    unsigned char* ws = KWS(); bf16* H = (bf16*)(ws + WS_H); unsigned char* SCR = ws + WS_SCR; const int mx = l % 3, mi = l / 3;
                    if (mx == 0) { RgArgs A{(const bf16*)SCR, (const bf16*)(SCR + ACT_BYTES), H, (const bf16*)(ws + WS_RGG + mi * RGG_BYTES), KIN(12) + (size_t)mi * 8 * 256, KIN(13) + (size_t)mi * D, KIN(9) + (size_t)mi * 4 * D, KIN(10) + (size_t)mi * D};
                        rg_scan_phase(F, A); }
                    else if (mx == 1) { GlaArgs A{(const bf16*)SCR, nullptr, (const float*)(SCR + 3 * ACT_BYTES), (const bf16*)(SCR + ACT_BYTES), (const bf16*)(SCR + 2 * ACT_BYTES), nullptr, nullptr, nullptr, KIN(17), H, (float*)(ws + WS_SS)};
                        gla_scan_phase<128, false>(F, A); }
                    else { GlaArgs A{(const bf16*)SCR, (const bf16*)(SCR + ACT_BYTES / 2), nullptr, (const bf16*)(SCR + ACT_BYTES), (const bf16*)(SCR + 2 * ACT_BYTES), (const float*)(SCR + 3 * ACT_BYTES), KIN(20), KIN(21), KIN(22), H, nullptr};
#if defined(DBG_COPY)
                        { int tq_ = F.wave * 64 + lane_id(); asm volatile("" : "+v"(tq_)); const int gw = blockIdx.x * 512 + tq_;
                          for (size_t e = gw; e < (size_t)M * D; e += (size_t)gridDim.x * 512) { const size_t row = e >> 10; const int col = (int)(e & 1023);
                              float v = 0.f;
                              if (DBG_COPY & 1) v += bf2f(A.V[e]);
                              if (DBG_COPY & 2) v += bf2f(A.G[e]);
                              if (DBG_COPY & 4) v += bf2f(A.Q[row * 512 + (col & 511)]);
                              if (DBG_COPY & 8) v += bf2f(A.K[row * 512 + (col & 511)]);
                              if (DBG_COPY & 16) v += A.ALOW[row * 16 + (col & 15)];
                              H[e] = (bf16)f2bf(v); } }
#elif !defined(DBG_SKIP_GLSCAN)
                        gla_scan_phase<256, true>(F, A);
#endif
                    }
#endif
                }
                SEAM(); PE(5 + l % 3);
            }
            PB(s != 1 ? 3 : 8);
            if (RUN()) { unsigned char* ws = KWS(); const int mx = l % 3, mi = l / 3;
                const float* xcur = (l == 0 && s == 0) ? KIN(0) : (const float*)KARG()->out;
                const float* modl = (const float*)(ws + WS_MOD) + (size_t)l * BATCH * (NMOD * D);
                const bf16* Ap; const bf16* Bp; int K; float fac; const float* ssp = nullptr;
                if (s != 1) { Ap = (const bf16*)(ws + WS_SCR); Bp = (const bf16*)(ws + WS_W2 + (l * 2 + (s >> 1)) * W2_BYTES); K = FF; fac = 0.5f; }
                else { Ap = (const bf16*)(ws + WS_H); K = D; fac = 1.0f;
                    if (mx == 0) Bp = (const bf16*)(ws + WS_RGOUT + mi * SQ_BYTES); else if (mx == 1) { Bp = (const bf16*)(ws + WS_HGOUT); ssp = (const float*)(ws + WS_SS); } else Bp = (const bf16*)(ws + WS_GLOUT); }
                pg8::Gemm g{Ap, Bp, M, D, K}; pg8::StaticOrder S; S.init(M, D, F.G, (int)blockIdx.x);
                pg8::EpiResid E{xcur, KARG()->out, modl + (3 * s + 2) * D, NMOD * D, fac, ssp};
                pg8::gemm_phase<pg8::EpiResid, pg8::StaticOrder, true, true>(F.lds, g, S, E, F.wave);
            }
            SEAM(); PE(s != 1 ? 3 : 8);
        }
    }
    PB(9);
#if defined(DBG_NSUB) && DBG_NSUB == 0
    if (RUN()) { float* xo = KARG()->out; final_norm_phase(F, KIN(0), KIN(5), xo); }
#else
    if (RUN()) { float* xo = KARG()->out; final_norm_phase(F, xo, KIN(5), xo); }
#endif
    PE(9);
#ifdef PROBE_KIND
    if (blockIdx.x == 0 && F.wave == 0 && lane_id() == 0) { volatile unsigned long long* tp_ = (volatile unsigned long long*)(KWS() + 512 * 1024); const unsigned long long want = tp_[1] * PROBE_MUL, t0_ = __builtin_amdgcn_s_memrealtime();
        while (__builtin_amdgcn_s_memrealtime() - t0_ < want) __builtin_amdgcn_s_sleep(8); }
#endif
#undef RUN
#undef SEAM
}

extern "C" void kernel_launch(void* const* d_in, const int* in_sizes, int n_in, void* d_out, int out_size, void* d_ws, size_t ws_size, hipStream_t stream) {
    static int grid = 0;
    if (grid == 0) {
        if (n_in != 24 || in_sizes[0] != M * D || out_size != M * D || ws_size < WS_END) { fprintf(stderr, "kernel_launch: unexpected shapes (n_in %d, in0 %d, out %d, ws %zu < %zu); nothing launched\n", n_in, n_in > 0 ? in_sizes[0] : -1, out_size, ws_size, (size_t)WS_END); grid = -1; return; }
        int dev = 0, cus = 0, per_cu = 0;
        if (hipGetDevice(&dev) != hipSuccess || hipDeviceGetAttribute(&cus, hipDeviceAttributeMultiprocessorCount, dev) != hipSuccess) { grid = -1; return; }
        if (hipFuncSetAttribute((const void*)mk_fwd, hipFuncAttributeMaxDynamicSharedMemorySize, LDS_BYTES) != hipSuccess) { fprintf(stderr, "kernel_launch: hipFuncSetAttribute failed\n"); grid = -1; return; }
        if (hipOccupancyMaxActiveBlocksPerMultiprocessor(&per_cu, (const void*)mk_fwd, NWAVES * 64, LDS_BYTES) != hipSuccess || per_cu < 1)
            fprintf(stderr, "kernel_launch: note: occupancy query reports %d workgroups per CU\n", per_cu);
        (void)hipGetLastError();
        grid = cus;
    }
    if (grid < 0) return;
    if (hipMemsetAsync((char*)d_ws + WS_CTL, 0, CTL_ZERO_BYTES, stream) != hipSuccess) return;
    Args a{};
    for (int i = 0; i < 24; ++i) a.in[i] = (const float*)d_in[i];
    a.out = (float*)d_out; a.ws = (unsigned char*)d_ws;
#if MK_N_LAUNCHES == 1
    a.ph_lo = 0; a.ph_hi = NPH;
    hipLaunchKernelGGL(mk_fwd, dim3(grid), dim3(NWAVES * 64), LDS_BYTES, stream, a);
#else
    for (int p = 0; p < NPH; ++p) { a.ph_lo = p; a.ph_hi = p + 1; hipLaunchKernelGGL(mk_fwd, dim3(grid), dim3(NWAVES * 64), LDS_BYTES, stream, a); }
#endif
}
```

```cpp
#include <hip/hip_runtime.h>
#include <cstdio>
#include <cstdint>
#include <cmath>
#ifndef MK_N_LAUNCHES
#define MK_N_LAUNCHES 1
#endif
namespace pg8 {
#define PG8_LAS __attribute__((address_space(3)))
typedef unsigned short bf16_t;
typedef short bf16x8 __attribute__((ext_vector_type(8)));
typedef float f32x4 __attribute__((ext_vector_type(4)));
typedef unsigned u32x4 __attribute__((ext_vector_type(4)));
constexpr int BM = 256, BK = 64, HALF = 128, HTB = HALF * BK * 2  , STAGE_BYTES = 8 * HTB, NXCD = 8, WGM = 8;

__host__ __device__ __forceinline__ int lds_byte(int r, int c) { const int st = (r >> 4) * 2 + (c >> 5), rr = r & 15, cc = c & 31, ob = rr * 64 + cc * 2; return st * 1024 + (ob ^ (((ob >> 9) & 1) << 5)); }
__host__ __device__ __forceinline__ void stage_rc(int b, int& R, int& C) { const int st = b / 1024, sb = b % 1024, swz = sb ^ (((sb >> 9) & 1) << 5); R = (st >> 1) * 16 + swz / 64; C = (st & 1) * 32 + (swz % 64) / 2; }
__host__ __device__ __forceinline__ int perm32(int rho) { const int n = rho >> 4, i = rho & 15; return 8 * (i >> 2) + 4 * n + (i & 3); }

struct Unit { int pm, pn; };
struct Gemm { const bf16_t* A; const bf16_t* Bt; int M, N, K; };

struct StaticOrder {
    int nM, nN, nwg, G, c;
    __host__ __device__ void init(int M, int N, int G_, int c_) { nM = M / BM; nN = N / BM; nwg = nM * nN; G = G_; c = c_; }
    __host__ __device__ bool next(int i, Unit& u) const {
        const int L = i * G + c; if (L >= nwg) return false;
        int wgid = L; { const int q = nwg / NXCD, r = nwg % NXCD, xcd = wgid % NXCD, off = wgid / NXCD; wgid = (xcd < r ? xcd * (q + 1) : r * (q + 1) + (xcd - r) * q) + off; }
        const int nig = WGM * nN, gid = wgid / nig, fm = gid * WGM, gsz = (nM - fm) < WGM ? (nM - fm) : WGM;
        u.pm = fm + ((wgid % nig) % gsz); u.pn = (wgid % nig) / gsz; return true;
    }
    __device__ __forceinline__ void a_ready(const Unit&) const {}
    __device__ __forceinline__ void done(const Unit&) const {}
};

typedef float f32x2_t __attribute__((ext_vector_type(2))); typedef __bf16 bf16x2_t __attribute__((ext_vector_type(2)));
__device__ __forceinline__ unsigned cvt_pk_bf16(float lo, float hi) { const f32x2_t v = {lo, hi}; const bf16x2_t b = __builtin_convertvector(v, bf16x2_t); return __builtin_bit_cast(unsigned, b); }
__device__ __forceinline__ u32x4 pack8(const f32x4 a, const f32x4 b) { u32x4 w; w.x = cvt_pk_bf16(a[0], a[1]); w.y = cvt_pk_bf16(a[2], a[3]); w.z = cvt_pk_bf16(b[0], b[1]); w.w = cvt_pk_bf16(b[2], b[3]); return w; }
__device__ __forceinline__ float fast_sigmoid(float x) { return __builtin_amdgcn_rcpf(1.0f + __builtin_amdgcn_exp2f(-1.4426950408889634f * x)); }
__device__ __forceinline__ f32x4 sigmoid4(const f32x4 v) { f32x4 o; o[0] = fast_sigmoid(v[0]); o[1] = fast_sigmoid(v[1]); o[2] = fast_sigmoid(v[2]); o[3] = fast_sigmoid(v[3]); return o; }
__device__ __forceinline__ f32x4 silu4(const f32x4 v) { return v * sigmoid4(v); }
__device__ __forceinline__ f32x4 gelu_tanh4(const f32x4 v) { const f32x4 z = v * (1.5957691216057308f + 0.07135481627260025f * (v * v)); return v * sigmoid4(z); }

struct PrefIn { f32x4 p0, p1, b; };
struct RowScale {
    const float* PS; PG8_LAS float* tab;
    __device__ __forceinline__ void fetch(PrefIn& pf, const Unit& u, int tid, const float* bsrc0, const float* bsrc1) const {
        asm volatile("" : "+v"(tid));
        const float* pp = PS + (size_t)(u.pm * BM + (tid >> 1)) * 16 + 8 * (tid & 1);
        pf.p0 = *(const f32x4*)pp; pf.p1 = *(const f32x4*)(pp + 4);
        if (tid < 64) pf.b = *(const f32x4*)((tid < 32 ? bsrc0 : bsrc1) + 4 * (tid & 31));
    }
    __device__ __forceinline__ void finish(float (&rs)[2][4], f32x4 (&bv)[2][2], const PrefIn& pf, int tid, int wr, int wc, int fr, int fq) const {
        float s = ((pf.p0[0] + pf.p0[1]) + (pf.p0[2] + pf.p0[3])) + ((pf.p1[0] + pf.p1[1]) + (pf.p1[2] + pf.p1[3])); s += __shfl_xor(s, 1);
        if ((tid & 1) == 0) tab[tid >> 1] = 1.0f / sqrtf(s * (1.0f / 1024.0f) + 1e-6f);
        if (tid < 64) *(PG8_LAS f32x4*)(tab + 256 + 4 * tid) = pf.b;
        asm volatile("s_waitcnt lgkmcnt(0)" ::: "memory"); __builtin_amdgcn_s_barrier(); asm volatile("" ::: "memory");
#pragma unroll
        for (int ai = 0; ai < 2; ++ai)
#pragma unroll
            for (int m = 0; m < 4; ++m) rs[ai][m] = tab[ai * HALF + wr * 64 + m * 16 + fr];
#pragma unroll
        for (int bj = 0; bj < 2; ++bj)
#pragma unroll
            for (int n = 0; n < 2; ++n) bv[bj][n] = *(const PG8_LAS f32x4*)(tab + 256 + bj * HALF + wc * 32 + 8 * fq + 4 * n);
    }
};
struct EpiSwiglu {
    static constexpr bool PERM = true, AFTER_DRAIN = false;
    bf16_t* O; int ldc; RowScale R; const float* b2;
    typedef PrefIn Pref;
    __device__ __forceinline__ void prefetch(Pref& pf, const Unit& u, int tid) const { const float* bp = b2 + (size_t)(u.pm >> 3) * 5632 + u.pn * HALF; R.fetch(pf, u, tid, bp, bp + 2816); }
    __device__ __forceinline__ void operator()(const f32x4 (&acc)[2][2][4][2], const Unit& u, int wr, int wc, int fr, int fq, const Pref& pf, int tid) const {
        const int row0 = u.pm * BM + wr * 64 + fr, col0 = u.pn * HALF + wc * 32 + 8 * fq;
        float rs[2][4]; f32x4 bv[2][2]; R.finish(rs, bv, pf, tid, wr, wc, fr, fq);
        const f32x4 bg0 = bv[0][0], bg1 = bv[0][1], bu0 = bv[1][0], bu1 = bv[1][1];
#pragma unroll
        for (int ai = 0; ai < 2; ++ai)
#pragma unroll
            for (int m = 0; m < 4; ++m) { bf16_t* rowp = O + (size_t)(row0 + ai * HALF + m * 16) * ldc + col0; const float r = rs[ai][m];
                const f32x4 v0 = silu4(acc[ai][0][m][0] * r + bg0) * (acc[ai][1][m][0] * r + bu0), v1 = silu4(acc[ai][0][m][1] * r + bg1) * (acc[ai][1][m][1] * r + bu1);
                *(u32x4*)rowp = pack8(v0, v1); }
    }
};
struct EpiRgIn {
    static constexpr bool PERM = true, AFTER_DRAIN = false;
    bf16_t* Y; RowScale R; const float* b2;
    typedef PrefIn Pref;
    __device__ __forceinline__ void prefetch(Pref& pf, const Unit& u, int tid) const { const float* bp = b2 + (size_t)(u.pm >> 3) * 2048 + u.pn * BM; R.fetch(pf, u, tid, bp, bp + HALF); }
    __device__ __forceinline__ void operator()(const f32x4 (&acc)[2][2][4][2], const Unit& u, int wr, int wc, int fr, int fq, const Pref& pf, int tid) const {
        const int row0 = u.pm * BM + wr * 64 + fr; const bool isy = u.pn < 4;
        float rs[2][4]; f32x4 bv[2][2]; R.finish(rs, bv, pf, tid, wr, wc, fr, fq);
        bf16_t* base = Y + (size_t)(isy ? 0 : 1) * ((size_t)65536 * 1024) + (u.pn & 3) * BM + wc * 32 + 8 * fq;
#pragma unroll
        for (int ai = 0; ai < 2; ++ai)
#pragma unroll
            for (int m = 0; m < 4; ++m) { bf16_t* rowp = base + (size_t)(row0 + ai * HALF + m * 16) * 1024; const float r = rs[ai][m];
#pragma unroll
                for (int bj = 0; bj < 2; ++bj) { f32x4 v0 = acc[ai][bj][m][0] * r + bv[bj][0], v1 = acc[ai][bj][m][1] * r + bv[bj][1];
                    if (isy) { v0 = gelu_tanh4(v0); v1 = gelu_tanh4(v1); }
                    *(u32x4*)(rowp + bj * HALF) = pack8(v0, v1); } }
    }
};
struct EpiHgIn {
    static constexpr bool PERM = true, AFTER_DRAIN = false;
    bf16_t* Q; float* LOGF; const float* lb; RowScale R; const float* b2;
    typedef PrefIn Pref;
    __device__ __forceinline__ void prefetch(Pref& pf, const Unit& u, int tid) const { const float* bp = b2 + (size_t)(u.pm >> 3) * 4096 + u.pn * BM; R.fetch(pf, u, tid, bp, bp + HALF); }
    __device__ __forceinline__ void operator()(const f32x4 (&acc)[2][2][4][2], const Unit& u, int wr, int wc, int fr, int fq, const Pref& pf, int tid) const {
        const int row0 = u.pm * BM + wr * 64 + fr, sec = u.pn >> 2, colw = (u.pn & 3) * BM + wc * 32 + 8 * fq;
        float rs[2][4]; f32x4 bv[2][2]; R.finish(rs, bv, pf, tid, wr, wc, fr, fq);
        if (sec == 1) {
#pragma unroll
            for (int bj = 0; bj < 2; ++bj) { const f32x4 l0 = *(const f32x4*)(lb + colw + bj * HALF), l1 = *(const f32x4*)(lb + colw + bj * HALF + 4);
#pragma unroll
                for (int ai = 0; ai < 2; ++ai)
#pragma unroll
                    for (int m = 0; m < 4; ++m) { float* rowp = LOGF + (size_t)(row0 + ai * HALF + m * 16) * 1024 + colw + bj * HALF; const float r = rs[ai][m];
                        const f32x4 s0 = sigmoid4(acc[ai][bj][m][0] * r + bv[bj][0]), s1 = sigmoid4(acc[ai][bj][m][1] * r + bv[bj][1]);
                        const f32x4 f0 = l0 + (1.0f - l0) * s0, f1 = l1 + (1.0f - l1) * s1; f32x4 o0, o1;
#pragma unroll
                        for (int e = 0; e < 4; ++e) { o0[e] = __logf(f0[e]); o1[e] = __logf(f1[e]); }
                        *(f32x4*)rowp = o0; *(f32x4*)(rowp + 4) = o1; } }
        } else {
            bf16_t* base = Q + (size_t)(sec - (sec > 0 ? 1 : 0)) * ((size_t)65536 * 1024) + colw;
#pragma unroll
            for (int ai = 0; ai < 2; ++ai)
#pragma unroll
                for (int m = 0; m < 4; ++m) { bf16_t* rowp = base + (size_t)(row0 + ai * HALF + m * 16) * 1024; const float r = rs[ai][m];
#pragma unroll
                    for (int bj = 0; bj < 2; ++bj) { f32x4 v0 = acc[ai][bj][m][0] * r + bv[bj][0], v1 = acc[ai][bj][m][1] * r + bv[bj][1];
                        if (sec == 3) { v0 = sigmoid4(v0); v1 = sigmoid4(v1); }
                        *(u32x4*)(rowp + bj * HALF) = pack8(v0, v1); } }
        }
    }
};
struct EpiGlIn {
    static constexpr bool PERM = true, AFTER_DRAIN = false;
    bf16_t* Q; float* ALOW; RowScale R; const float* b2;
    typedef PrefIn Pref;
    __device__ __forceinline__ void prefetch(Pref& pf, const Unit& u, int tid) const { const float* bp = b2 + (size_t)(u.pm >> 3) * 3328 + u.pn * BM; R.fetch(pf, u, tid, bp, u.pn == 12 ? bp : bp + HALF); }
    __device__ __forceinline__ void operator()(const f32x4 (&acc)[2][2][4][2], const Unit& u, int wr, int wc, int fr, int fq, const Pref& pf, int tid) const {
        const int row0 = u.pm * BM + wr * 64 + fr, pn = u.pn;
        float rs[2][4]; f32x4 bv[2][2]; R.finish(rs, bv, pf, tid, wr, wc, fr, fq);
        if (pn == 12) {
            if (wc == 0 && fq < 2) { const f32x4 b0 = bv[0][0], b1 = bv[0][1];
#pragma unroll
                for (int ai = 0; ai < 2; ++ai)
#pragma unroll
                    for (int m = 0; m < 4; ++m) { float* rowp = ALOW + (size_t)(row0 + ai * HALF + m * 16) * 16 + 8 * fq; const float r = rs[ai][m];
                        *(f32x4*)rowp = acc[ai][0][m][0] * r + b0; *(f32x4*)(rowp + 4) = acc[ai][0][m][1] * r + b1; }
            }
            return;
        }
        const int g2 = pn >= 2 ? 1 : 0, g4 = pn >= 4 ? 1 : 0, g8 = pn >= 8 ? 1 : 0; const int ld = 512 + 512 * g4;
        bf16_t* base = Q + (size_t)(g2 + g4 + 2 * g8) * ((size_t)65536 * 512) + (pn - 2 * g2 - 2 * g4 - 4 * g8) * BM;
        base += wc * 32 + 8 * fq; const bool act = pn >= 8;
#pragma unroll
        for (int ai = 0; ai < 2; ++ai)
#pragma unroll
            for (int m = 0; m < 4; ++m) { bf16_t* rowp = base + (size_t)(row0 + ai * HALF + m * 16) * ld; const float r = rs[ai][m];
#pragma unroll
                for (int bj = 0; bj < 2; ++bj) { f32x4 v0 = acc[ai][bj][m][0] * r + bv[bj][0], v1 = acc[ai][bj][m][1] * r + bv[bj][1];
                    if (act) { v0 = silu4(v0); v1 = silu4(v1); }
                    *(u32x4*)(rowp + bj * HALF) = pack8(v0, v1); } }
    }
};
struct EpiResidParams { const float* base; float* out; const float* coef; const float* ss; bf16_t* An; const float* nwn; const float* scn; float* PS; int cstride; float fac; };
struct EpiResid {
    static constexpr bool PERM = true, AFTER_DRAIN = false;
    const PG8_LAS unsigned* pb;
    struct Pref {};
    __device__ __forceinline__ void prefetch(Pref&, const Unit&, int) const {}
    __device__ __forceinline__ unsigned long long ld64(int i) const { const unsigned lo = __builtin_amdgcn_readfirstlane(pb[2 * i]), hi = __builtin_amdgcn_readfirstlane(pb[2 * i + 1]); return ((unsigned long long)hi << 32) | lo; }
    __device__ __forceinline__ void operator()(const f32x4 (&acc)[2][2][4][2], const Unit& u, int wr, int wc, int fr, int fq, const Pref&, int) const {
        const float* base = (const float*)ld64(0); float* out = (float*)ld64(1); const float* coef = (const float*)ld64(2); const float* ss = (const float*)ld64(3);
        bf16_t* An = (bf16_t*)ld64(4); const float* nwn = (const float*)ld64(5); const float* scn = (const float*)ld64(6); float* PS = (float*)ld64(7);
        const int cstride = (int)__builtin_amdgcn_readfirstlane(pb[16]); const float fac = __builtin_bit_cast(float, __builtin_amdgcn_readfirstlane(pb[17]));
        const int row0 = u.pm * BM + wr * 64 + fr, col0 = u.pn * BM + wc * 32 + 8 * fq;
        const float* cf = coef + (size_t)(u.pm >> 3) * cstride + col0;
        f32x4 cv[2][2], gv[2][2];
#pragma unroll
        for (int bj = 0; bj < 2; ++bj)
#pragma unroll
            for (int n = 0; n < 2; ++n) { cv[bj][n] = *(const f32x4*)(cf + bj * HALF + n * 4) * fac;
                gv[bj][n] = An ? *(const f32x4*)(nwn + col0 + bj * HALF + n * 4) * (1.0f + *(const f32x4*)(scn + (size_t)(u.pm >> 3) * cstride + col0 + bj * HALF + n * 4)) : (f32x4){0.f, 0.f, 0.f, 0.f}; }
#pragma unroll
        for (int g = 0; g < 4; ++g) { const int ai = g >> 1, m0 = (g & 1) * 2;
            f32x4 pre[2][2][2]; float rs[2];
#pragma unroll
            for (int mm = 0; mm < 2; ++mm) { const int row = row0 + ai * HALF + (m0 + mm) * 16; const size_t off = (size_t)row * 1024 + col0;
#pragma unroll
                for (int bj = 0; bj < 2; ++bj)
#pragma unroll
                    for (int n = 0; n < 2; ++n) pre[mm][bj][n] = *(const f32x4*)(base + off + bj * HALF + n * 4);
                rs[mm] = 1.0f;
                if (ss) { const f32x4 a = *(const f32x4*)(ss + (size_t)row * 8), b = *(const f32x4*)(ss + (size_t)row * 8 + 4);
                    rs[mm] = 1.0f / sqrtf(((a[0] + a[1]) + (a[2] + a[3]) + (b[0] + b[1]) + (b[2] + b[3])) * (1.0f / 1024.0f) + 1e-6f); } }
            asm volatile("" ::: "memory");
#pragma unroll
            for (int mm = 0; mm < 2; ++mm) { const int row = row0 + ai * HALF + (m0 + mm) * 16; const size_t off = (size_t)row * 1024 + col0; float sq = 0.f;
#pragma unroll
                for (int bj = 0; bj < 2; ++bj) { f32x4 xn[2];
#pragma unroll
                    for (int n = 0; n < 2; ++n) { xn[n] = pre[mm][bj][n] + (cv[bj][n] * rs[mm]) * acc[ai][bj][m0 + mm][n]; *(f32x4*)(out + off + bj * HALF + n * 4) = xn[n];
                        sq += (xn[n][0] * xn[n][0] + xn[n][1] * xn[n][1]) + (xn[n][2] * xn[n][2] + xn[n][3] * xn[n][3]); }
                    if (An) *(u32x4*)(An + off + bj * HALF) = pack8(xn[0] * gv[bj][0], xn[1] * gv[bj][1]); }
                if (An) { sq += __shfl_xor(sq, 16); sq += __shfl_xor(sq, 32); if (fq == 0) PS[(size_t)row * 16 + u.pn * 4 + wc] = sq; } }
            asm volatile("" ::: "memory");
        }
    }
};

template <class Epi, class Sched, bool ALIGN_EPI = false, bool SP2 = false>
__device__ __forceinline__ void gemm_phase(PG8_LAS unsigned char* lds, const Gemm g, const Sched& S, const Epi& E, const int wave_id) {
    int lid_; asm volatile("v_mbcnt_lo_u32_b32 %0, -1, 0\n\tv_mbcnt_hi_u32_b32 %0, -1, %0" : "=v"(lid_)); const int tid_ = wave_id * 64 + lid_;
    const int tid = tid_, wid = wave_id, lane = tid & 63, wr = wid >> 2, wc = wid & 3, fr = lane & 15, fq = lane >> 4;
    const int K = g.K, nt = K / BK;
    unsigned voffA[2], voffB[2];
#pragma unroll
    for (int i = 0; i < 2; ++i) { int R, C; stage_rc(tid * 16 + i * 8192, R, C); const int Rb = Epi::PERM ? ((R & ~31) + perm32(R & 31)) : R;
        voffA[i] = (unsigned)(R * K + C) * 2u; voffB[i] = (unsigned)(Rb * K + C) * 2u; }
    const size_t kstep = (size_t)(BK * 2);
    const size_t hstep = (size_t)HALF * K * 2;
    const size_t tstep = 2 * hstep;
    const unsigned ldsw = (unsigned)wid * 1024u;
    const int aoff = lds_byte(wr * 64 + fr, fq * 8), boff = lds_byte(wc * 32 + fr, fq * 8);
#define PG8_SA(b, h) (((b) * 2 + (h)) * HTB)
#define PG8_SB(b, h) ((4 + (b) * 2 + (h)) * HTB)
#define PG8_STAGE(bufoff, gbase, voff) do { _Pragma("unroll") for (int _i = 0; _i < 2; ++_i) \
        __builtin_amdgcn_global_load_lds((const unsigned*)((const char*)(gbase) + (voff)[_i]), (PG8_LAS unsigned*)(lds + (bufoff) + ldsw + _i * 8192), 16, 0, 0); } while (0)
#define PG8_LDA(dst, b, h) do { _Pragma("unroll") for (int m = 0; m < 4; ++m) _Pragma("unroll") for (int k = 0; k < 2; ++k) dst[m][k] = *(const PG8_LAS bf16x8*)(lds + PG8_SA(b, h) + aoff + m * 2048 + k * 1024); } while (0)
#define PG8_LDB(dst, b, h) do { _Pragma("unroll") for (int n = 0; n < 2; ++n) _Pragma("unroll") for (int k = 0; k < 2; ++k) dst[n][k] = *(const PG8_LAS bf16x8*)(lds + PG8_SB(b, h) + boff + n * 2048 + k * 1024); } while (0)
#define PG8_MMA(ai, bj, At, Bt) do { __builtin_amdgcn_s_setprio(1); _Pragma("unroll") for (int m = 0; m < 4; ++m) _Pragma("unroll") for (int n = 0; n < 2; ++n) _Pragma("unroll") for (int k = 0; k < 2; ++k) \
        acc[ai][bj][m][n] = __builtin_amdgcn_mfma_f32_16x16x32_bf16(Bt[n][k], At[m][k], acc[ai][bj][m][n], 0, 0, 0); __builtin_amdgcn_s_setprio(0); } while (0)
#define PG8_WAIT_V(n) asm volatile("s_waitcnt vmcnt(" #n ")" ::: "memory")
#define PG8_WAIT_L(n) asm volatile("s_waitcnt lgkmcnt(" #n ")" ::: "memory")
#define PG8_BAR __builtin_amdgcn_s_barrier()
#define PG8_SCHED __builtin_amdgcn_sched_barrier(0)
    Unit cur, nxt; int ui = 0;
    typename Epi::Pref pf;
    if (!S.next(0, cur)) return;
    f32x4 acc[2][2][4][2];
#pragma unroll
    for (int a = 0; a < 2; ++a)
#pragma unroll
        for (int b = 0; b < 2; ++b)
#pragma unroll
            for (int m = 0; m < 4; ++m)
#pragma unroll
                for (int n = 0; n < 2; ++n) acc[a][b][m][n] = (f32x4){0.f, 0.f, 0.f, 0.f};
    bf16x8 At[4][2], B0[2][2], B1[2][2];
    const char* cA = (const char*)g.A + (size_t)cur.pm * tstep; const char* cB = (const char*)g.Bt + (size_t)cur.pn * tstep;
    S.a_ready(cur);
    if constexpr (SP2) {
        PG8_STAGE(PG8_SB(0, 0), cB, voffB); PG8_STAGE(PG8_SB(0, 1), cB + hstep, voffB); PG8_STAGE(PG8_SA(0, 0), cA, voffA); PG8_STAGE(PG8_SA(0, 1), cA + hstep, voffA);
        if (wr == 1) PG8_BAR;
        PG8_WAIT_V(2); PG8_BAR;
        PG8_STAGE(PG8_SB(1, 0), cB + kstep, voffB); PG8_STAGE(PG8_SA(1, 0), cA + kstep, voffA); PG8_STAGE(PG8_SB(1, 1), cB + hstep + kstep, voffB);
        PG8_WAIT_V(6); PG8_BAR;
    } else {
        PG8_STAGE(PG8_SB(0, 0), cB, voffB); PG8_STAGE(PG8_SA(0, 0), cA, voffA); PG8_STAGE(PG8_SB(0, 1), cB + hstep, voffB); PG8_STAGE(PG8_SA(0, 1), cA + hstep, voffA);
        if (wr == 1) PG8_BAR;
        PG8_WAIT_V(4); PG8_BAR;
        PG8_STAGE(PG8_SB(1, 0), cB + kstep, voffB); PG8_STAGE(PG8_SA(1, 0), cA + kstep, voffA); PG8_STAGE(PG8_SB(1, 1), cB + hstep + kstep, voffB);
        PG8_WAIT_V(6); PG8_BAR;
    }
    for (;;) {
        const bool has_next = S.next(ui + 1, nxt);
        const char* nA = has_next ? (const char*)g.A + (size_t)nxt.pm * tstep : cA; const char* nB = has_next ? (const char*)g.Bt + (size_t)nxt.pn * tstep : cB;
        for (int t = 0; t < nt; t += 2) {
            const bool last = (t == nt - 2);
            const char* a1 = cA + (size_t)(t + 1) * kstep;
            const char* a2 = last ? nA : cA + (size_t)(t + 2) * kstep; const char* b2 = last ? nB : cB + (size_t)(t + 2) * kstep;
            const char* a3 = a2 + kstep; const char* b3 = b2 + kstep;
            if (last && has_next) S.a_ready(nxt);
            if (last) E.prefetch(pf, cur, tid);
            if constexpr (SP2) {
            PG8_LDB(B0, 0, 0); PG8_LDB(B1, 0, 1); PG8_SCHED; PG8_LDA(At, 0, 0); PG8_STAGE(PG8_SA(1, 1), a1 + hstep, voffA);
            PG8_WAIT_V(8); PG8_WAIT_L(0); PG8_BAR; PG8_MMA(0, 0, At, B0); PG8_MMA(0, 1, At, B1); PG8_BAR; PG8_SCHED;
            PG8_LDA(At, 0, 1); PG8_STAGE(PG8_SB(0, 0), b2, voffB); PG8_STAGE(PG8_SB(0, 1), b2 + hstep, voffB); PG8_STAGE(PG8_SA(0, 0), a2, voffA);
            PG8_WAIT_V(8); PG8_WAIT_L(0); PG8_BAR; PG8_MMA(1, 0, At, B0); PG8_MMA(1, 1, At, B1); PG8_BAR; PG8_SCHED;
            PG8_LDB(B0, 1, 0); PG8_LDB(B1, 1, 1); PG8_SCHED; PG8_LDA(At, 1, 0); PG8_STAGE(PG8_SA(0, 1), a2 + hstep, voffA);
            PG8_WAIT_V(8); PG8_WAIT_L(0); PG8_BAR; PG8_MMA(0, 0, At, B0); PG8_MMA(0, 1, At, B1); PG8_BAR; PG8_SCHED;
            PG8_LDA(At, 1, 1); PG8_STAGE(PG8_SB(1, 0), b3, voffB); PG8_STAGE(PG8_SB(1, 1), b3 + hstep, voffB); PG8_STAGE(PG8_SA(1, 0), a3, voffA);
            PG8_WAIT_V(8); PG8_WAIT_L(0); PG8_BAR; PG8_MMA(1, 0, At, B0); PG8_MMA(1, 1, At, B1); PG8_BAR; PG8_SCHED;
            } else {
            PG8_LDB(B0, 0, 0); PG8_SCHED; PG8_LDA(At, 0, 0); PG8_STAGE(PG8_SA(1, 1), a1 + hstep, voffA);
            PG8_WAIT_L(8); PG8_BAR; PG8_WAIT_L(0); PG8_MMA(0, 0, At, B0); PG8_BAR; PG8_SCHED;
            PG8_LDB(B1, 0, 1); PG8_STAGE(PG8_SB(0, 0), b2, voffB);
            PG8_BAR; PG8_WAIT_L(0); PG8_MMA(0, 1, At, B1); PG8_BAR;
            PG8_LDA(At, 0, 1); PG8_STAGE(PG8_SA(0, 0), a2, voffA);
            PG8_BAR; PG8_WAIT_L(0); PG8_MMA(1, 0, At, B0); PG8_BAR; PG8_SCHED;
            PG8_STAGE(PG8_SB(0, 1), b2 + hstep, voffB);
            PG8_WAIT_V(6); PG8_BAR; PG8_MMA(1, 1, At, B1); PG8_BAR;
            PG8_LDB(B0, 1, 0); PG8_SCHED; PG8_LDA(At, 1, 0); PG8_STAGE(PG8_SA(0, 1), a2 + hstep, voffA);
            PG8_WAIT_L(8); PG8_BAR; PG8_WAIT_L(0); PG8_MMA(0, 0, At, B0); PG8_BAR; PG8_SCHED;
            PG8_LDB(B1, 1, 1); PG8_STAGE(PG8_SB(1, 0), b3, voffB);
            PG8_BAR; PG8_WAIT_L(0); PG8_MMA(0, 1, At, B1); PG8_BAR;
            PG8_LDA(At, 1, 1); PG8_STAGE(PG8_SA(1, 0), a3, voffA);
            PG8_BAR; PG8_WAIT_L(0); PG8_MMA(1, 0, At, B0); PG8_BAR; PG8_SCHED;
            PG8_STAGE(PG8_SB(1, 1), b3 + hstep, voffB);
            PG8_WAIT_V(6); PG8_BAR; PG8_MMA(1, 1, At, B1); PG8_BAR;
            }
        }
        if constexpr (ALIGN_EPI) { if (wr == 0) PG8_BAR; }
        if constexpr (!Epi::AFTER_DRAIN) { E(acc, cur, wr, wc, fr, fq, pf, tid); S.done(cur); }
        if (!has_next) break;
#pragma unroll
        for (int a = 0; a < 2; ++a)
#pragma unroll
            for (int b = 0; b < 2; ++b)
#pragma unroll
                for (int m = 0; m < 4; ++m)
#pragma unroll
                    for (int n = 0; n < 2; ++n) acc[a][b][m][n] = (f32x4){0.f, 0.f, 0.f, 0.f};
        cur = nxt; cA = nA; cB = nB; ++ui;
        if constexpr (ALIGN_EPI) { if (wr == 1) PG8_BAR; }
    }
    PG8_WAIT_V(0);
    if constexpr (!ALIGN_EPI) { if (wr == 0) PG8_BAR; }
    PG8_BAR;
    if constexpr (Epi::AFTER_DRAIN) { E.fused(acc, cur, wr, wc, fr, fq, lds, wid, lane); S.done(cur); }
#undef PG8_SA
#undef PG8_SB
#undef PG8_STAGE
#undef PG8_LDA
#undef PG8_LDB
#undef PG8_MMA
#undef PG8_WAIT_V
#undef PG8_WAIT_L
#undef PG8_BAR
#undef PG8_SCHED
}
}
constexpr int NWAVES = 8;
constexpr int BATCH = 32, SEQ = 2048, D = 1024, M = BATCH * SEQ, FF = 2816, DEPTH = 4, NMOD = 9;
constexpr int GLA_IN = 3088, GLA_INP = 3328;
constexpr float EPS = 1e-6f;
constexpr size_t MiB = 1u << 20;
constexpr size_t WS_CTL = 0, CTL_ZERO_BYTES = 1 * MiB;
constexpr size_t WS_MOD = 2 * MiB;
constexpr size_t WS_LB = 6 * MiB + 512 * 1024;
constexpr size_t WS_SS = 7 * MiB;
constexpr size_t WS_W13 = 10 * MiB, W13_BYTES = (size_t)2 * FF * D * 2;
constexpr size_t WS_W2 = 98 * MiB, W2_BYTES = (size_t)D * FF * 2;
constexpr size_t WS_RGIN = 142 * MiB, RGIN_BYTES = (size_t)2048 * D * 2;
constexpr size_t WS_RGG = 150 * MiB, RGG_BYTES = (size_t)8 * 256 * 128 * 2;
constexpr size_t WS_RGOUT = 151 * MiB, SQ_BYTES = (size_t)D * D * 2;
constexpr size_t WS_HGIN = 155 * MiB;
constexpr size_t WS_HGOUT = 163 * MiB;
constexpr size_t WS_GLIN = 165 * MiB;
constexpr size_t WS_GLOUT = 172 * MiB;
constexpr size_t WS_H = 176 * MiB;
constexpr size_t WS_SCR = 304 * MiB;
constexpr size_t ACT_BYTES = (size_t)M * D * 2;
constexpr size_t WS_B2 = WS_SCR + 5 * ACT_BYTES;
constexpr size_t B2_BYTES = (size_t)32 * 5632 * 4;
constexpr size_t WS_PS = WS_B2 + 9 * MiB;
constexpr size_t WS_MODT = WS_PS + 4 * MiB;
constexpr size_t WS_END = WS_MODT + 5 * MiB;
static_assert(12 * B2_BYTES <= 9 * MiB, "bias2 fits");
static_assert(WS_W13 + 8 * W13_BYTES <= WS_W2 && WS_W2 + 8 * W2_BYTES <= WS_RGIN && WS_RGIN + 2 * RGIN_BYTES <= WS_RGG && WS_RGG + 2 * RGG_BYTES <= WS_RGOUT && WS_RGOUT + 2 * SQ_BYTES <= WS_HGIN, "ws map 1");
static_assert(WS_HGIN + 4 * SQ_BYTES <= WS_HGOUT && WS_HGOUT + SQ_BYTES <= WS_GLIN && WS_GLIN + (size_t)GLA_INP * D * 2 <= WS_GLOUT && WS_GLOUT + SQ_BYTES <= WS_H && WS_H + ACT_BYTES <= WS_SCR, "ws map 2");
static_assert((size_t)M * FF * 2 <= 5 * ACT_BYTES, "hid fits");
constexpr int CW_TMO = 0, CW_BAR = 4096;
constexpr int RING_BYTES = 131072, LDSCTL_OFF = RING_BYTES, MISC_OFF = LDSCTL_OFF + 320, LDS_BYTES = 147456;

#define GAS __attribute__((address_space(1)))
#define LAS __attribute__((address_space(3)))
typedef unsigned short bf16;
typedef unsigned v4u __attribute__((ext_vector_type(4)));
typedef unsigned v2u __attribute__((ext_vector_type(2)));
typedef float f32x4 __attribute__((ext_vector_type(4)));
typedef float f32x16 __attribute__((ext_vector_type(16)));
typedef short bf16x8 __attribute__((ext_vector_type(8)));
typedef GAS unsigned gu32;
#define RLX_AGENT __ATOMIC_RELAXED, __HIP_MEMORY_SCOPE_AGENT
#define LDS_WAIT() asm volatile("s_waitcnt lgkmcnt(0)" ::: "memory")
#define VM_WAIT() asm volatile("s_waitcnt vmcnt(0)" ::: "memory")
__device__ __forceinline__ unsigned pk2(float lo, float hi) { return pg8::cvt_pk_bf16(lo, hi); }
__device__ __forceinline__ unsigned f2bf(float f) { return pg8::cvt_pk_bf16(f, 0.f) & 0xffffu; }
__device__ __forceinline__ float bf2f(unsigned h) { return __builtin_bit_cast(float, h << 16); }
__device__ __forceinline__ float sigmoidf_(float x) { return 1.0f / (1.0f + expf(-x)); }

__device__ __forceinline__ int lane_id() { int l; asm volatile("v_mbcnt_lo_u32_b32 %0, -1, 0\n\tv_mbcnt_hi_u32_b32 %0, -1, %0" : "=v"(l)); return l; }
#define XB_TMO      128
#define XB_XCNT(j)  (256  + 64 * (j))
#define XB_XSUB(j)  (1280 + 64 * (j))
#define XB_XGEN(j)  (2304 + 64 * (j))
#define XB_TOP      3328
#define XB_TOPGEN   3392
#define XCD_BAR_WORDS 3456
#define XB_SPIN_CAP (1u << 18)

__device__ __forceinline__ unsigned xb_ld(unsigned* p)              { return __hip_atomic_load(p, __ATOMIC_RELAXED, __HIP_MEMORY_SCOPE_AGENT); }
__device__ __forceinline__ unsigned xb_add(unsigned* p, unsigned v) { return __hip_atomic_fetch_add(p, v, __ATOMIC_RELAXED, __HIP_MEMORY_SCOPE_AGENT); }
__device__ __forceinline__ unsigned xb_xcc_id() { return (unsigned)__builtin_amdgcn_s_getreg((3 << 11) | 20) & 0xFu; }
#define XB_SPIN(cond, bar) do { unsigned _sp = 0; while (cond) { __builtin_amdgcn_s_sleep(1); \
    if ((++_sp & 255u) == 0u) { if (xb_ld(&(bar)[XB_TMO])) break; if (_sp > XB_SPIN_CAP) { atomicAdd(&(bar)[XB_TMO], 1u); break; } } } } while (0)

struct XcdBarrier {
    unsigned* bar; unsigned x; int wave;
    volatile LAS unsigned* st;
};

__device__ __forceinline__ XcdBarrier xcd_barrier_post(unsigned* bar, volatile LAS unsigned* st) {
    XcdBarrier b; b.bar = bar; b.x = xb_xcc_id(); b.st = st;
    if (threadIdx.x == 0) (void)xb_add(&bar[XB_XCNT(b.x)], 1u);
    return b;
}
__device__ __forceinline__ void xcd_barrier_complete(unsigned* bar, unsigned x, unsigned& nloc, unsigned& nx) {
    const unsigned G = gridDim.x * gridDim.y * gridDim.z;
    unsigned sum, cnt, mine, sp = 0u;
    for (;;) {
        sum = 0u; cnt = 0u; mine = 0u;
#pragma unroll
        for (unsigned j = 0; j < 16; ++j) { const unsigned c = xb_ld(&bar[XB_XCNT(j)]); sum += c; cnt += (c > 0u) ? 1u : 0u; mine = (j == x) ? c : mine; }
        if (sum == G) break;
        __builtin_amdgcn_s_sleep(1);
        if ((++sp & 255u) == 0u) { if (xb_ld(&bar[XB_TMO])) break; if (sp > XB_SPIN_CAP) { atomicAdd(&bar[XB_TMO], 1u); break; } }
    }
    nloc = mine > 0u ? mine : 1u; nx = cnt > 0u ? cnt : 1u;
}

__device__ __forceinline__ void xcd_barrier(const XcdBarrier& b) {
    asm volatile("s_waitcnt vmcnt(0)" ::: "memory");
    __syncthreads();
    int xl_; asm volatile("v_mbcnt_lo_u32_b32 %0, -1, 0\n\tv_mbcnt_hi_u32_b32 %0, -1, %0" : "=v"(xl_));
    if (b.wave == 0 && xl_ == 0) {
        unsigned* bar = b.bar; unsigned bx_ = b.x; asm volatile("" : "+s"(bar), "+s"(bx_));
        __builtin_amdgcn_s_waitcnt(0);
        unsigned nloc = b.st[0], nx = b.st[1];
        if (nloc == 0u) { xcd_barrier_complete(bar, bx_, nloc, nx); b.st[0] = nloc; b.st[1] = nx; }
        const unsigned old = xb_add(&bar[XB_XSUB(bx_)], 1u);
        const unsigned gen = old / nloc;
        if (old + 1u == (gen + 1u) * nloc) {
            __builtin_amdgcn_fence(__ATOMIC_RELEASE, "agent");
            asm volatile("s_waitcnt vmcnt(0)" ::: "memory");
            const unsigned og = xb_add(&bar[XB_TOP], 1u);
            const unsigned tg = og / nx;
            if (og + 1u == (tg + 1u) * nx) xb_add(&bar[XB_TOPGEN], 1u);
            else XB_SPIN(xb_ld(&bar[XB_TOPGEN]) == tg, bar);
            __builtin_amdgcn_fence(__ATOMIC_ACQUIRE, "agent");
            xb_add(&bar[XB_XGEN(bx_)], 1u);
            asm volatile("s_waitcnt vmcnt(0)" ::: "memory");
        } else {
            XB_SPIN(xb_ld(&bar[XB_XGEN(bx_)]) == gen, bar);
            __builtin_amdgcn_fence(__ATOMIC_ACQUIRE, "agent");
            asm volatile("s_waitcnt vmcnt(0)" ::: "memory");
        }
    }
    __syncthreads();
}
struct Frame {
    LAS unsigned char* lds;
    volatile LAS unsigned* MISC;
    gu32* ctl;
    int wave, vcu, G;
};
__device__ __forceinline__ float wave_sum(float v) {
#pragma unroll
    for (int o = 1; o < 64; o <<= 1) v += __shfl_xor(v, o);
    return v;
}
__device__ __forceinline__ void conv_item(const float* W, int N, int k0, int n0, int nvalid, bf16* WT, int Kd, int drow0, LAS float* scr, int lane) {
    const bool ok = (lane & 31) < nvalid;
#pragma unroll 8
    for (int i = 0; i < 32; ++i) { const int kk = 2 * i + (lane >> 5); scr[kk * 33 + (lane & 31)] = ok ? W[(size_t)(k0 + kk) * N + n0 + (lane & 31)] : 0.f; }
    LDS_WAIT(); asm volatile("" ::: "memory");
    const int c = lane & 7;
#pragma unroll
    for (int j = 0; j < 4; ++j) { const int n = (lane >> 3) + 8 * j; const LAS float* s = scr + (8 * c) * 33 + n;
        v4u o; o.x = pk2(s[0 * 33], s[1 * 33]); o.y = pk2(s[2 * 33], s[3 * 33]); o.z = pk2(s[4 * 33], s[5 * 33]); o.w = pk2(s[6 * 33], s[7 * 33]);
        *(GAS v4u*)(WT + (size_t)(drow0 + n) * Kd + k0 + 8 * c) = o; }
    LDS_WAIT(); asm volatile("" ::: "memory");
}
struct ProIn { const float *c, *ada_w, *ada_b, *w13, *w2, *rg_w_in, *rg_gate_w, *rg_w_out, *hg_w_in, *hg_lb, *hg_w_out, *gla_w_in, *gla_w_out; };
__device__ __forceinline__ void p0_prologue(Frame& F, const ProIn& P, unsigned char* ws) {
    int lane_ = lane_id(); asm volatile("" : "+v"(lane_)); const int lane = lane_;
    int gw_ = F.wave * F.G + F.vcu; asm volatile("" : "+s"(gw_)); const int gw = gw_, NGW = F.G * NWAVES;
    float* MOD = (float*)(ws + WS_MOD); float* MODT = (float*)(ws + WS_MODT);
    { LAS float* CT = (LAS float*)F.lds;
        for (int idx = F.wave * 64 + lane; idx < BATCH * D; idx += NWAVES * 64) { const int b = idx >> 10, k = idx & 1023; const float cv = P.c[idx]; CT[k * 32 + (b ^ (k & 31))] = cv / (1.0f + expf(-cv)); }
        __syncthreads();
        for (int blk = gw; blk < DEPTH * NMOD * D / 32; blk += NGW) {
            const int n0 = blk * 32, l = n0 / (NMOD * D), nn = n0 % (NMOD * D);
            const float* Wp = P.ada_w + (size_t)l * D * (NMOD * D) + nn + (lane & 31) + (size_t)(lane >> 5) * (NMOD * D);
            f32x16 acc = {};
            for (int k0 = 0; k0 < D; k0 += 32) {
                float wv[16];
#pragma unroll
                for (int i = 0; i < 16; ++i) wv[i] = Wp[(size_t)(k0 + 2 * i) * (NMOD * D)];
#pragma unroll
                for (int i = 0; i < 16; ++i) { const int k = k0 + 2 * i + (lane >> 5); acc = __builtin_amdgcn_mfma_f32_32x32x2f32(CT[k * 32 + ((lane & 31) ^ (k & 31))], wv[i], acc, 0, 0, 0); }
            }
            const float bias = P.ada_b[(size_t)l * (NMOD * D) + nn + (lane & 31)];
#pragma unroll
            for (int r = 0; r < 16; ++r) { const int b = (r & 3) + 8 * (r >> 2) + 4 * (lane >> 5); MOD[((size_t)l * BATCH + b) * (NMOD * D) + nn + (lane & 31)] = acc[r] + bias; }
#pragma unroll
            for (int g4 = 0; g4 < 4; ++g4) *(f32x4*)(MODT + ((size_t)l * (NMOD * D) + nn + (lane & 31)) * 32 + 8 * g4 + 4 * (lane >> 5)) = (f32x4){acc[4 * g4] + bias, acc[4 * g4 + 1] + bias, acc[4 * g4 + 2] + bias, acc[4 * g4 + 3] + bias};
        }
        __syncthreads();
    }
    if (F.vcu == 0) { float* LB = (float*)(ws + WS_LB);
        for (int ch = F.wave * 64 + lane; ch < D; ch += NWAVES * 64) { const float g0 = P.hg_lb[ch], g1 = P.hg_lb[D + ch], g2 = P.hg_lb[2 * D + ch], g3 = P.hg_lb[3 * D + ch];
            const float mx = fmaxf(fmaxf(g0, g1), fmaxf(g2, g3)); const float e0 = expf(g0 - mx), e1 = expf(g1 - mx), e2 = expf(g2 - mx), e3 = expf(g3 - mx);
            LB[ch] = e1 / (e0 + e1 + e2 + e3); } }
    LAS float* scr = (LAS float*)(F.lds + F.wave * 16384);
    int gw2_ = F.vcu * NWAVES + F.wave; asm volatile("" : "+s"(gw2_)); const int gw2 = gw2_;
    constexpr int I_W13 = 16 * 176, I_W2 = 44 * 32, I_RGIN = 16 * 64, I_RGG = 2 * 8, I_SQ = 16 * 32, I_HGIN = 16 * 128, I_GLIN = 16 * (GLA_INP / 32);
    constexpr int T0 = 8 * I_W13, T1 = T0 + 8 * I_W2, T2 = T1 + 2 * I_RGIN, T3 = T2 + 16 * I_RGG, T4 = T3 + 2 * I_SQ, T5 = T4 + I_HGIN, T6 = T5 + I_SQ, T7 = T6 + I_GLIN, T8 = T7 + I_SQ;
    for (int it = gw2; it < T8; it += NGW) {
        int r = it;
        if (r < T0) { const int mi = r / I_W13, q = r % I_W13, kb = q / 176, nb = q % 176, n0 = nb * 32;
            const int drow = n0 < FF ? (n0 / 128) * 256 + (n0 % 128) : ((n0 - FF) / 128) * 256 + 128 + ((n0 - FF) % 128);
            conv_item(P.w13 + (size_t)mi * D * 2 * FF, 2 * FF, kb * 64, n0, 32, (bf16*)(ws + WS_W13 + mi * W13_BYTES), D, drow, scr, lane); continue; }
        r -= T0;
        if (r < 8 * I_W2) { const int mi = r / I_W2, q = r % I_W2, kb = q / 32, nb = q % 32;
            conv_item(P.w2 + (size_t)mi * FF * D, D, kb * 64, nb * 32, 32, (bf16*)(ws + WS_W2 + mi * W2_BYTES), FF, nb * 32, scr, lane); continue; }
        r -= 8 * I_W2;
        if (r < 2 * I_RGIN) { const int mi = r / I_RGIN, q = r % I_RGIN, kb = q / 64, nb = q % 64;
            conv_item(P.rg_w_in + (size_t)mi * D * 2048, 2048, kb * 64, nb * 32, 32, (bf16*)(ws + WS_RGIN + mi * RGIN_BYTES), D, nb * 32, scr, lane); continue; }
        r -= 2 * I_RGIN;
        if (r < 16 * I_RGG) { const int mi = r / I_RGG, q = r % I_RGG, kb = q / 8, nb = q % 8;
            conv_item(P.rg_gate_w + (size_t)mi * 128 * 256, 256, kb * 64, nb * 32, 32, (bf16*)(ws + WS_RGG) + (size_t)mi * 256 * 128, 128, nb * 32, scr, lane); continue; }
        r -= 16 * I_RGG;
        if (r < 2 * I_SQ) { const int mi = r / I_SQ, q = r % I_SQ, kb = q / 32, nb = q % 32;
            conv_item(P.rg_w_out + (size_t)mi * D * D, D, kb * 64, nb * 32, 32, (bf16*)(ws + WS_RGOUT + mi * SQ_BYTES), D, nb * 32, scr, lane); continue; }
        r -= 2 * I_SQ;
        if (r < I_HGIN) { const int kb = r / 128, nb = r % 128;
            conv_item(P.hg_w_in, 4096, kb * 64, nb * 32, 32, (bf16*)(ws + WS_HGIN), D, nb * 32, scr, lane); continue; }
        r -= I_HGIN;
        if (r < I_SQ) { const int kb = r / 32, nb = r % 32;
            conv_item(P.hg_w_out, D, kb * 64, nb * 32, 32, (bf16*)(ws + WS_HGOUT), D, nb * 32, scr, lane); continue; }
        r -= I_SQ;
        if (r < I_GLIN) { const int kb = r / (GLA_INP / 32), nb = r % (GLA_INP / 32), n0 = nb * 32; const int nv = GLA_IN - n0 < 0 ? 0 : (GLA_IN - n0 > 32 ? 32 : GLA_IN - n0);
            conv_item(P.gla_w_in, GLA_IN, kb * 64, nv > 0 ? n0 : 0, nv, (bf16*)(ws + WS_GLIN), D, n0, scr, lane); continue; }
        r -= I_GLIN;
        { const int kb = r / 32, nb = r % 32;
            conv_item(P.gla_w_out, D, kb * 64, nb * 32, 32, (bf16*)(ws + WS_GLOUT), D, nb * 32, scr, lane); }
    }
}
__device__ __forceinline__ void norm_phase(Frame& F, const float* x, const float* nw, const float* shift, const float* scale, bf16* H) {
    int lane_ = lane_id(); asm volatile("" : "+v"(lane_)); const int lane = lane_;
    int gw_ = F.vcu * NWAVES + F.wave; asm volatile("" : "+s"(gw_)); const int gw = gw_, NGW = F.G * NWAVES;
    for (int strip = gw; strip < M / 32; strip += NGW) {
        const int b = (strip * 32) / SEQ;
        f32x4 gv[4], sv[4];
#pragma unroll
        for (int j = 0; j < 4; ++j) { const int col = 4 * lane + 256 * j;
            gv[j] = *(const f32x4*)(nw + col) * (1.0f + *(const f32x4*)(scale + (size_t)b * (NMOD * D) + col)); sv[j] = *(const f32x4*)(shift + (size_t)b * (NMOD * D) + col); }
        for (int rr = 0; rr < 32; ++rr) { const size_t row = (size_t)strip * 32 + rr;
            const GAS f32x4* xr = (const GAS f32x4*)(x + row * D) + lane;
            f32x4 v[4]; float s = 0.f;
#pragma unroll
            for (int j = 0; j < 4; ++j) { v[j] = xr[64 * j]; s += (v[j].x * v[j].x + v[j].y * v[j].y) + (v[j].z * v[j].z + v[j].w * v[j].w); }
            const float rstd = 1.0f / sqrtf(wave_sum(s) * (1.f / D) + EPS);
            GAS v2u* o8 = (GAS v2u*)(H + row * D) + lane;
#pragma unroll
            for (int j = 0; j < 4; ++j) { const f32x4 o = v[j] * rstd * gv[j] + sv[j]; v2u w; w.x = pk2(o.x, o.y); w.y = pk2(o.z, o.w); o8[64 * j] = w; }
        }
    }
}

struct Pro2In { const float *x, *norm_w; };
__device__ __forceinline__ void p1_prologue(Frame& F, const Pro2In& P, unsigned char* ws) {
    int lane_ = lane_id(); asm volatile("" : "+v"(lane_)); const int lane = lane_;
    int gw_ = F.wave * F.G + F.vcu; asm volatile("" : "+s"(gw_)); const int gw = gw_, NGW = F.G * NWAVES;
    const float* MOD = (const float*)(ws + WS_MOD);
    constexpr int NB_FF = 176, NB_RG = 64, NB_HG = 128, NB_GL = GLA_INP / 32, NBT = 8 * NB_FF + 2 * NB_RG + NB_HG + NB_GL;
    for (int blk = gw; blk < NBT; blk += NGW) {
        int j, rb, pitch; const bf16* Bt; bool ffn = false;
        if (blk < 8 * NB_FF) { const int fi = blk / NB_FF; rb = blk % NB_FF; j = (fi >> 1) * 3 + (fi & 1) * 2; pitch = 5632; Bt = (const bf16*)(ws + WS_W13 + fi * W13_BYTES); ffn = true; }
        else if (blk < 8 * NB_FF + 2 * NB_RG) { const int r = blk - 8 * NB_FF, mi = r / NB_RG; rb = r % NB_RG; j = (mi * 3) * 3 + 1; pitch = 2048; Bt = (const bf16*)(ws + WS_RGIN + mi * RGIN_BYTES); }
        else if (blk < 8 * NB_FF + 2 * NB_RG + NB_HG) { rb = blk - 8 * NB_FF - 2 * NB_RG; j = 1 * 3 + 1; pitch = 4096; Bt = (const bf16*)(ws + WS_HGIN); }
        else { rb = blk - 8 * NB_FF - 2 * NB_RG - NB_HG; j = 2 * 3 + 1; pitch = GLA_INP; Bt = (const bf16*)(ws + WS_GLIN); }
        const int l = j / 3, s = j % 3, r = rb * 32 + (lane & 31);
        const bf16* Bp = Bt + (size_t)r * D + 8 * (lane >> 5);
        const float* Sp = MOD + ((size_t)l * BATCH + (lane & 31)) * (NMOD * D) + (3 * s) * D + 8 * (lane >> 5);
        f32x16 acc = {};
        for (int k0 = 0; k0 < D; k0 += 128) {
            bf16x8 bf[8]; f32x4 s0[8], s1[8];
#pragma unroll
            for (int i = 0; i < 8; ++i) { bf[i] = *(const bf16x8*)(Bp + k0 + 16 * i); s0[i] = *(const f32x4*)(Sp + k0 + 16 * i); s1[i] = *(const f32x4*)(Sp + k0 + 16 * i + 4); }
#pragma unroll
            for (int i = 0; i < 8; ++i) acc = __builtin_amdgcn_mfma_f32_32x32x16_bf16(__builtin_bit_cast(bf16x8, pg8::pack8(s0[i], s1[i])), bf[i], acc, 0, 0, 0);
        }
        const int w = r & 255, n = ffn ? ((w < 128) ? (r >> 8) * 128 + w : FF + (r >> 8) * 128 + (w - 128)) : r;
        float* B2 = (float*)(ws + WS_B2 + (size_t)j * B2_BYTES);
#pragma unroll
        for (int rr = 0; rr < 16; ++rr) { const int b = (rr & 3) + 8 * (rr >> 2) + 4 * (lane >> 5); B2[(size_t)b * pitch + n] = acc[rr]; }
    }
    const int gw2 = F.vcu * NWAVES + F.wave;
    bf16* H = (bf16*)(ws + WS_H); float* PS = (float*)(ws + WS_PS);
    for (int strip = gw2; strip < M / 32; strip += NGW) {
        const int b = (strip * 32) / SEQ;
        f32x4 gv[4];
#pragma unroll
        for (int jj = 0; jj < 4; ++jj) { const int col = 4 * lane + 256 * jj; gv[jj] = *(const f32x4*)(P.norm_w + col) * (1.0f + *(const f32x4*)(MOD + (size_t)b * (NMOD * D) + D + col)); }
        for (int rr = 0; rr < 32; ++rr) { const size_t row = (size_t)strip * 32 + rr;
            const GAS f32x4* xr = (const GAS f32x4*)(P.x + row * D) + lane;
            f32x4 v[4]; float sq = 0.f;
#pragma unroll
            for (int jj = 0; jj < 4; ++jj) { v[jj] = xr[64 * jj]; sq += (v[jj].x * v[jj].x + v[jj].y * v[jj].y) + (v[jj].z * v[jj].z + v[jj].w * v[jj].w); }
            sq = wave_sum(sq);
            GAS v2u* o8 = (GAS v2u*)(H + row * D) + lane;
#pragma unroll
            for (int jj = 0; jj < 4; ++jj) { const f32x4 o = v[jj] * gv[jj]; v2u w; w.x = pk2(o.x, o.y); w.y = pk2(o.z, o.w); o8[64 * jj] = w; }
            if (lane < 16) PS[row * 16 + lane] = lane == 0 ? sq : 0.f;
        }
    }
}
__device__ __forceinline__ void final_norm_phase(Frame& F, const float* x, const float* w, float* out) {
    int lane_ = lane_id(); asm volatile("" : "+v"(lane_)); const int lane = lane_;
    int gw_ = F.vcu * NWAVES + F.wave; asm volatile("" : "+s"(gw_)); const int gw = gw_, NGW = F.G * NWAVES;
    f32x4 gv[4];
#pragma unroll
    for (int j = 0; j < 4; ++j) gv[j] = *(const f32x4*)(w + 4 * lane + 256 * j);
    for (int strip = gw; strip < M / 32; strip += NGW) {
        for (int rr = 0; rr < 32; ++rr) { const size_t row = (size_t)strip * 32 + rr;
            const GAS f32x4* xr = (const GAS f32x4*)(x + row * D) + lane;
            f32x4 v[4]; float s = 0.f;
#pragma unroll
            for (int j = 0; j < 4; ++j) { v[j] = xr[64 * j]; s += (v[j].x * v[j].x + v[j].y * v[j].y) + (v[j].z * v[j].z + v[j].w * v[j].w); }
            const float rstd = 1.0f / sqrtf(wave_sum(s) * (1.f / D) + EPS);
            GAS f32x4* o = (GAS f32x4*)(out + row * D) + lane;
#pragma unroll
            for (int j = 0; j < 4; ++j) o[64 * j] = v[j] * rstd * gv[j];
        }
    }
}
#define MFMA16(a, b, c) __builtin_amdgcn_mfma_f32_16x16x32_bf16((a), (b), (c), 0, 0, 0)
__device__ __forceinline__ bf16x8 ld_b128(const LAS unsigned char* p) { return *(const LAS bf16x8*)p; }
__device__ __forceinline__ bf16x8 ld_2xb64(const LAS unsigned char* p0, const LAS unsigned char* p1) { const v2u a = *(const LAS v2u*)p0, b = *(const LAS v2u*)p1; v4u w; w.x = a.x; w.y = a.y; w.z = b.x; w.w = b.y; return __builtin_bit_cast(bf16x8, w); }
__device__ __forceinline__ bf16x8 pack8f(const f32x4 a, const f32x4 b) { return __builtin_bit_cast(bf16x8, pg8::pack8(a, b)); }
#define LOG2E 1.4426950408889634f
#define LN2 0.6931471805599453f
__device__ __forceinline__ float fexp2(float x) { return __builtin_amdgcn_exp2f(x); }
__device__ __forceinline__ float frcp(float x) { return __builtin_amdgcn_rcpf(x); }
__device__ __forceinline__ float fsigm(float x) { return frcp(1.0f + fexp2(-LOG2E * x)); }
#ifndef DBG_R4
#define DBG_R4 4
#endif
typedef __amdgpu_buffer_rsrc_t rsrc_t;
__device__ __forceinline__ rsrc_t mk_rsrc(const void* p) { return __builtin_amdgcn_make_buffer_rsrc((void*)p, 0, 0x7fffffff, 0x00020000); }
__device__ __forceinline__ float bld_bf(rsrc_t r, unsigned voff, unsigned soff) { const unsigned w = __builtin_amdgcn_raw_buffer_load_b32(r, voff & ~3u, soff, 0); return __builtin_bit_cast(float, (voff & 2u) ? (w & 0xffff0000u) : (w << 16)); }
__device__ __forceinline__ unsigned bld_raw(rsrc_t r, unsigned voff, unsigned soff) { return __builtin_amdgcn_raw_buffer_load_b32(r, voff & ~3u, soff, 0); }
__device__ __forceinline__ float half_bf(unsigned w, unsigned voff) { return __builtin_bit_cast(float, (voff & 2u) ? (w & 0xffff0000u) : (w << 16)); }
__device__ __forceinline__ unsigned half_u16(unsigned w, unsigned voff) { return (voff & 2u) ? (w >> 16) : (w & 0xffffu); }
__device__ __forceinline__ unsigned short bld_u16(rsrc_t r, unsigned voff, unsigned soff) { const unsigned w = __builtin_amdgcn_raw_buffer_load_b32(r, voff & ~3u, soff, 0); return (unsigned short)((voff & 2u) ? (w >> 16) : (w & 0xffffu)); }
__device__ __forceinline__ float bld_f32(rsrc_t r, unsigned voff, unsigned soff) { return __builtin_bit_cast(float, __builtin_amdgcn_raw_buffer_load_b32(r, voff, soff, 0)); }
__device__ __forceinline__ v4u bld_b128(rsrc_t r, unsigned voff, unsigned soff) { return __builtin_amdgcn_raw_buffer_load_b128(r, voff, soff, 0); }
struct RgArgs { const bf16* Y; const bf16* XB; bf16* HY; const bf16* WgT; const float *gate_b, *lam, *conv_w, *conv_b; };
#define LDS_BARRIER() do { asm volatile("s_waitcnt lgkmcnt(0)" ::: "memory"); __builtin_amdgcn_s_barrier(); asm volatile("" ::: "memory"); } while (0)
#define WAVE_SYNC() asm volatile("" ::: "memory")
__device__ __forceinline__ void rg_scan_phase(Frame& F, const RgArgs A) {
    LAS unsigned char* L = F.lds;
    int tid_ = F.wave * 64 + lane_id(); asm volatile("" : "+v"(tid_));
    const int tid = tid_, lane = tid & 63, wave = F.wave, q = lane >> 4, l15 = lane & 15;
    const int cch = tid & 127, tg = wave >> 1, chl = 16 * wave + l15;
    typedef float f32x2v __attribute__((ext_vector_type(2)));
    LAS f32x2v* AU = (LAS f32x2v*)(L + 50176 + wave * 4608);
    LAS f32x2v* PH = (LAS f32x2v*)(L + 50176 + wave * 4608 + 4096);
    for (int unit = blockIdx.x; unit < BATCH * 8; unit += gridDim.x) {
        const int b = unit >> 3, hd = unit & 7, colbase = hd * 128; const size_t rowbase = (size_t)b * SEQ;
        const bf16* Wg = A.WgT + (size_t)hd * 256 * 128;
        bf16x8 Bx[4], Ba[4];
#pragma unroll
        for (int s = 0; s < 4; ++s) { Bx[s] = *(const bf16x8*)(Wg + (size_t)chl * 128 + 32 * s + 8 * q); Ba[s] = *(const bf16x8*)(Wg + (size_t)(128 + chl) * 128 + 32 * s + 8 * q); }
        const float bx = A.gate_b[hd * 256 + chl], ba = A.gate_b[hd * 256 + 128 + chl];
        const float lamv = A.lam[colbase + chl]; const float sp8 = 8.0f * (fmaxf(-lamv, 0.f) + log1pf(expf(-fabsf(lamv))));
        const float cw0 = A.conv_w[colbase + cch], cw1 = A.conv_w[D + colbase + cch], cw2 = A.conv_w[2 * D + colbase + cch], cw3 = A.conv_w[3 * D + colbase + cch], cb = A.conv_b[colbase + cch];
        float h = 0.f;
        const rsrc_t rxb = mk_rsrc(A.XB + rowbase * D + colbase), ry = mk_rsrc(A.Y + rowbase * D + colbase), rhy = mk_rsrc(A.HY + rowbase * D + colbase);
        const unsigned vo = (unsigned)(8 * tg * D + cch) * 2u;
        const unsigned voy = (unsigned)(8 * q * D + chl) * 2u;
        unsigned xw[11], yw[8];
#pragma unroll
        for (int i = 0; i < 11; ++i) { const int t = 8 * tg - 3 + i; const unsigned w = bld_raw(rxb, (unsigned)cch * 2u, (unsigned)(t < 0 ? 0 : t) * 2048u); xw[i] = t >= 0 ? w : 0u; }
#pragma unroll
        for (int i = 0; i < 8; ++i) yw[i] = bld_raw(ry, voy, (unsigned)i * 2048u);
        for (int step = 0; step < SEQ / 32; ++step) {
            const int t0 = step * 32;
            LAS float* XC = (LAS float*)(L + (step & 1) * 25088); LAS unsigned char* XCB = L + (step & 1) * 25088 + 16384;
            float xb[11], yv[8];
#pragma unroll
            for (int i = 0; i < 11; ++i) xb[i] = half_bf(xw[i], (unsigned)cch * 2u);
#pragma unroll
            for (int i = 0; i < 8; ++i) yv[i] = half_bf(yw[i], voy);
#pragma unroll
            for (int i = 0; i < 8; ++i) { const float xc = cb + cw0 * xb[i] + cw1 * xb[i + 1] + cw2 * xb[i + 2] + cw3 * xb[i + 3];
                XC[(8 * tg + i) * 128 + cch] = xc; *(LAS unsigned short*)(XCB + (8 * tg + i) * 272 + cch * 2) = (unsigned short)f2bf(xc); }
            if (step + 1 < SEQ / 32) {
#pragma unroll
                for (int i = 0; i < 11; ++i) xw[i] = bld_raw(rxb, vo, (unsigned)(t0 + 32 - 3 + i) * 2048u);
#pragma unroll
                for (int i = 0; i < 8; ++i) yw[i] = bld_raw(ry, voy, (unsigned)(t0 + 32 + i) * 2048u);
            }
            LDS_BARRIER();
            f32x4 ax[2], aa[2];
#pragma unroll
            for (int tb = 0; tb < 2; ++tb) { ax[tb] = (f32x4){0.f, 0.f, 0.f, 0.f}; aa[tb] = (f32x4){0.f, 0.f, 0.f, 0.f};
#pragma unroll
                for (int s = 0; s < 4; ++s) { const bf16x8 a = ld_b128(XCB + (16 * tb + l15) * 272 + 64 * s + 16 * q); ax[tb] = MFMA16(a, Bx[s], ax[tb]); aa[tb] = MFMA16(a, Ba[s], aa[tb]); } }
#pragma unroll
            for (int tb = 0; tb < 2; ++tb)
#pragma unroll
                for (int r = 0; r < 4; ++r) { const int t = 16 * tb + 4 * q + r;
                    const float gx = ax[tb][r] + bx, ga = aa[tb][r] + ba;
                    const float la = -fsigm(ga) * sp8; const float a = fexp2(LOG2E * la);
                    const float x2 = 2.0f * la;
                    const float ser = -x2 * (1.0f + x2 * (0.5f + x2 * (0.16666667f + x2 * (0.041666668f + x2 * 0.008333334f))));
                    float m2 = x2 > -0.25f ? ser : 1.0f - a * a; float mult = __builtin_amdgcn_sqrtf(m2); if (t0 + t == 0) mult = 1.0f;
                    AU[t * 16 + l15] = (f32x2v){a, fsigm(gx) * XC[t * 128 + chl] * mult}; }
            WAVE_SYNC();
            float av[8], uv[8]; float P = 1.0f, Hl = 0.f;
#pragma unroll
            for (int i = 0; i < 8; ++i) { const f32x2v au = AU[(8 * q + i) * 16 + l15]; av[i] = au.x; uv[i] = au.y; Hl = av[i] * Hl + uv[i]; P *= av[i]; }
            PH[q * 16 + l15] = (f32x2v){P, Hl};
            WAVE_SYNC();
            { const f32x2v m0 = PH[l15], m1 = PH[16 + l15], m2_ = PH[32 + l15], m3 = PH[48 + l15];
                const float c1 = m0.x * h + m0.y, c2 = m1.x * c1 + m1.y, c3 = m2_.x * c2 + m2_.y, c4 = m3.x * c3 + m3.y;
                float hh = q == 0 ? h : (q == 1 ? c1 : (q == 2 ? c2 : c3)); h = c4;
#pragma unroll
                for (int i = 0; i < 8; ++i) { hh = av[i] * hh + uv[i]; __builtin_amdgcn_raw_buffer_store_b16((unsigned short)f2bf(hh * yv[i]), rhy, voy, (unsigned)(t0 + i) * 2048u, 0); } }
            WAVE_SYNC();
        }
        __syncthreads();
    }
}
struct GlaArgs { const bf16* Q; const bf16* K; const float* LOGF; const bf16* V; const bf16* G; const float* ALOW; const float *w2, *gb, *nw; bf16* OUT; float* SS; };
template <int DV, bool GLA>
__device__ __forceinline__ void gla_scan_phase(Frame& F, const GlaArgs A) {
    constexpr int NH = GLA ? 4 : 8, NCB = DV / 128, QLD = GLA ? 512 : 1024, NV = DV / 16, VTG = 512 / DV  , VTOK = 32 / VTG;
    LAS unsigned char* L = F.lds;
    LAS unsigned char* QT = L;
    LAS unsigned char* KT = L + 8704;
    LAS unsigned char* KHT = L + 17408;
    LAS unsigned char* VT = L + 27648;
    LAS float* DEC = (LAS float*)(L + 48128);
    LAS float* GT = (LAS float*)(L + 48640);
    LAS float* OB = (LAS float*)(L + 50688);
    LAS float* ALS = (LAS float*)(L + 83456);
    LAS float* NWL = (LAS float*)(L + 87552);
    int tid_ = F.wave * 64 + lane_id(); asm volatile("" : "+v"(tid_));
    const int tid = tid_, lane = tid & 63, wave = F.wave, q = lane >> 4, l15 = lane & 15;
    const int kc = tid & 127, tg = wave >> 1, vdv = tid & (DV - 1), vtg = wave / (DV / 64), ot = tid >> 4, oc = tid & 15;
    for (int unit = blockIdx.x; unit < BATCH * NH; unit += gridDim.x) {
        const int b = unit / NH, hd = unit % NH; const size_t rowbase = (size_t)b * SEQ;
        f32x4 S[NCB][8];
#pragma unroll
        for (int cb = 0; cb < NCB; ++cb)
#pragma unroll
            for (int kt = 0; kt < 8; ++kt) S[cb][kt] = (f32x4){0.f, 0.f, 0.f, 0.f};
        const rsrc_t rq = mk_rsrc(A.Q + rowbase * QLD + hd * 128), rk = mk_rsrc(GLA ? (const void*)(A.K + rowbase * QLD + hd * 128) : (const void*)(A.LOGF + rowbase * D + hd * 128));
        const rsrc_t rv = mk_rsrc(A.V + rowbase * D + hd * DV), rg = mk_rsrc(A.G + rowbase * D + hd * DV), ro = mk_rsrc(A.OUT + rowbase * D + hd * DV), ral = mk_rsrc(GLA ? A.ALOW + rowbase * 16 : nullptr);
        const unsigned voq = (unsigned)(8 * tg * QLD + kc) * 2u, vok = GLA ? voq : (unsigned)(8 * tg * D + kc) * 4u, vov = (unsigned)(VTOK * vtg * D + vdv) * 2u, vog = (unsigned)(ot * D + oc * NV) * 2u;
        constexpr unsigned QST = QLD * 2u, KST = GLA ? QLD * 2u : D * 4u, VST = D * 2u;
        float w2r[16]; float gbv = 0.f;
        if (GLA) {
#pragma unroll
            for (int r = 0; r < 16; ++r) w2r[r] = A.w2[r * 512 + hd * 128 + kc];
            gbv = A.gb[hd * 128 + kc]; }
        if (tid < DV) NWL[tid] = A.nw[(GLA ? 0 : hd * 128) + tid];
        unsigned qw[8], kw[8], vw[VTOK]; float alv = 0.f; v4u gg[NV / 8], ggn[NV / 8];
#pragma unroll
        for (int i = 0; i < 8; ++i) { qw[i] = bld_raw(rq, voq, (unsigned)i * QST); kw[i] = bld_raw(rk, vok, (unsigned)i * KST); }
#pragma unroll
        for (int i = 0; i < VTOK; ++i) vw[i] = bld_raw(rv, vov, (unsigned)i * VST);
#pragma unroll
        for (int e = 0; e < NV / 8; ++e) gg[e] = bld_b128(rg, vog + 16u * e, 0u);
        if (GLA) { ALS[tid] = bld_f32(ral, (unsigned)tid * 4u, 0u); alv = bld_f32(ral, (unsigned)tid * 4u, 32u * 64u); }
        __syncthreads();
        for (int n = 0; n < SEQ / 32; ++n) {
            const unsigned r0 = (unsigned)n * 32u;
            float qv[8], kv[8]; unsigned vv[VTOK];
#pragma unroll
            for (int i = 0; i < 8; ++i) { qv[i] = half_bf(qw[i], voq); kv[i] = GLA ? half_bf(kw[i], vok) : __builtin_bit_cast(float, kw[i]); }
#pragma unroll
            for (int i = 0; i < VTOK; ++i) vv[i] = half_u16(vw[i], vov);
            if (n + 1 < SEQ / 32) { const unsigned rn = r0 + 32u;
#pragma unroll
                for (int i = 0; i < 8; ++i) { qw[i] = bld_raw(rq, voq, (rn + i) * QST); kw[i] = bld_raw(rk, vok, (rn + i) * KST); }
#pragma unroll
                for (int i = 0; i < VTOK; ++i) vw[i] = bld_raw(rv, vov, (rn + i) * VST);
#pragma unroll
                for (int e = 0; e < NV / 8; ++e) ggn[e] = bld_b128(rg, vog + 16u * e, rn * VST); }
            float bl[8], kt_[8];
            { float c = 0.f;
#pragma unroll
                for (int i = 0; i < 8; ++i) { float g2;
                    if (GLA) { const LAS float* al = ALS + (n & 1) * 512 + (8 * tg + i) * 16; float z = gbv;
#pragma unroll
                        for (int r4 = 0; r4 < 4; ++r4) { const f32x4 a4 = *(const LAS f32x4*)(al + 4 * r4); z += a4[0] * w2r[4 * r4] + a4[1] * w2r[4 * r4 + 1] + a4[2] * w2r[4 * r4 + 2] + a4[3] * w2r[4 * r4 + 3]; }
                        g2 = (fminf(z, 0.f) * LOG2E - __builtin_amdgcn_logf(1.0f + fexp2(-LOG2E * fabsf(z)))) * (1.0f / 16.0f); kt_[i] = kv[i]; }
                    else { g2 = kv[i] * LOG2E; kt_[i] = 1.0f - fexp2(g2); }
                    c += g2; bl[i] = c; }
                GT[tg * 128 + kc] = c; }
            LDS_BARRIER();
            { const float g0 = GT[kc], g1 = GT[128 + kc], g2 = GT[256 + kc], g3 = GT[384 + kc];
                const float off = (tg > 0 ? g0 : 0.f) + (tg > 1 ? g1 : 0.f) + (tg > 2 ? g2 : 0.f), tot = (g0 + g1) + (g2 + g3);
                const float qs = GLA ? 0.08838834764831845f : 1.0f, etot = fexp2(tot);
                float kh[8];
#pragma unroll
                for (int i = 0; i < 8; ++i) { const float bb = bl[i] + off; const int t = 8 * tg + i; const float e1 = fexp2(bb), e2 = frcp(e1);
                    *(LAS unsigned short*)(QT + t * 272 + kc * 2) = (unsigned short)f2bf(qv[i] * qs * e1);
                    const float k2 = kt_[i] * e2;
                    *(LAS unsigned short*)(KT + t * 272 + kc * 2) = (unsigned short)f2bf(k2);
                    kh[i] = k2 * etot; }
                v4u w; w.x = pk2(kh[0], kh[1]); w.y = pk2(kh[2], kh[3]); w.z = pk2(kh[4], kh[5]); w.w = pk2(kh[6], kh[7]);
                *(LAS v4u*)(KHT + kc * 80 + 16 * tg) = w;
                if (tg == 0) DEC[kc] = etot; }
#pragma unroll
            for (int i8 = 0; i8 < VTOK / 8; ++i8) { v4u w; w.x = vv[8 * i8] | (vv[8 * i8 + 1] << 16); w.y = vv[8 * i8 + 2] | (vv[8 * i8 + 3] << 16); w.z = vv[8 * i8 + 4] | (vv[8 * i8 + 5] << 16); w.w = vv[8 * i8 + 6] | (vv[8 * i8 + 7] << 16);
                *(LAS v4u*)(VT + vdv * 80 + (VTOK * vtg + 8 * i8) * 2) = w; }
            LDS_BARRIER();
            if (GLA) { ALS[((n + 1) & 1) * 512 + tid] = alv; if (n + 2 < SEQ / 32) alv = bld_f32(ral, (unsigned)tid * 4u, (r0 + 64u) * 64u); }
            f32x4 P00 = {0.f, 0.f, 0.f, 0.f}, P01 = P00, P11 = P00;
#pragma unroll
            for (int s = 0; s < 4; ++s) { const bf16x8 KA0 = ld_b128(KT + l15 * 272 + 64 * s + 16 * q), KA1 = ld_b128(KT + (16 + l15) * 272 + 64 * s + 16 * q);
                const bf16x8 QB0 = ld_b128(QT + l15 * 272 + 64 * s + 16 * q), QB1 = ld_b128(QT + (16 + l15) * 272 + 64 * s + 16 * q);
                P00 = MFMA16(KA0, QB0, P00); P01 = MFMA16(KA0, QB1, P01); P11 = MFMA16(KA1, QB1, P11); }
#pragma unroll
            for (int r = 0; r < 4; ++r) if (l15 < 4 * q + r) { P00[r] = 0.f; P11[r] = 0.f; }
            const bf16x8 PA0 = pack8f(P00, (f32x4){0.f, 0.f, 0.f, 0.f}), PA1 = pack8f(P01, P11);
            bf16x8 VB[NCB];
#pragma unroll
            for (int cb = 0; cb < NCB; ++cb) { const LAS unsigned char* vr = VT + (16 * (wave * NCB + cb) + l15) * 80 + 8 * q; VB[cb] = ld_2xb64(vr, vr + 32); }
            f32x4 O[NCB][2];
#pragma unroll
            for (int cb = 0; cb < NCB; ++cb)
#pragma unroll
                for (int tb = 0; tb < 2; ++tb) O[cb][tb] = (f32x4){0.f, 0.f, 0.f, 0.f};
#pragma unroll
            for (int s = 0; s < 4; ++s) {
                bf16x8 QA[2];
#pragma unroll
                for (int tb = 0; tb < 2; ++tb) { const LAS unsigned char* qr = QT + (16 * tb + l15) * 272 + 64 * s + 8 * q; QA[tb] = ld_2xb64(qr, qr + 32); }
#pragma unroll
                for (int cb = 0; cb < NCB; ++cb) { const bf16x8 SB = pack8f(S[cb][2 * s], S[cb][2 * s + 1]);
                    O[cb][0] = MFMA16(QA[0], SB, O[cb][0]); O[cb][1] = MFMA16(QA[1], SB, O[cb][1]); } }
#pragma unroll
            for (int cb = 0; cb < NCB; ++cb) { O[cb][0] = MFMA16(PA0, VB[cb], O[cb][0]); O[cb][1] = MFMA16(PA1, VB[cb], O[cb][1]); }
#pragma unroll
            for (int kt = 0; kt < 8; ++kt) { const f32x4 dec = *(const LAS f32x4*)(DEC + 16 * kt + 4 * q);
                const LAS unsigned char* kr = KHT + (16 * kt + l15) * 80 + 8 * q; const bf16x8 KH = ld_2xb64(kr, kr + 32);
#pragma unroll
                for (int cb = 0; cb < NCB; ++cb) S[cb][kt] = MFMA16(KH, VB[cb], S[cb][kt] * dec); }
#pragma unroll
            for (int cb = 0; cb < NCB; ++cb)
#pragma unroll
                for (int tb = 0; tb < 2; ++tb)
#pragma unroll
                    for (int r = 0; r < 4; ++r) OB[(16 * tb + 4 * q + r) * DV + 16 * (wave * NCB + cb) + l15] = O[cb][tb][r];
#ifdef DBG_TRIVIAL
#pragma unroll
            for (int cb = 0; cb < NCB; ++cb)
#pragma unroll
                for (int tb = 0; tb < 2; ++tb)
#pragma unroll
                    for (int r = 0; r < 4; ++r) { const int t = 16 * tb + 4 * q + r, dv = 16 * (wave * NCB + cb) + l15;
                        float vsum = 0.f; if (DBG_TRIVIAL & 1) vsum += bf2f(*(const LAS unsigned short*)(VT + dv * 80 + t * 2)); if (DBG_TRIVIAL & 2) vsum += bf2f(*(const LAS unsigned short*)(QT + t * 272 + (dv & 127) * 2)); if (DBG_TRIVIAL & 4) vsum += bf2f(*(const LAS unsigned short*)(KHT + (dv & 127) * 80 + t * 2)); if (DBG_TRIVIAL & 8) vsum += 1.0f + 0.001f * (float)(t + dv);
                        OB[t * DV + dv] = vsum; }
#endif
            LDS_BARRIER();
            { float o[NV]; float ss = 0.f;
#pragma unroll
                for (int e4 = 0; e4 < NV / 4; ++e4) { const f32x4 v = *(const LAS f32x4*)(OB + ot * DV + oc * NV + 4 * e4); o[4 * e4] = v[0]; o[4 * e4 + 1] = v[1]; o[4 * e4 + 2] = v[2]; o[4 * e4 + 3] = v[3]; ss += (v[0] * v[0] + v[1] * v[1]) + (v[2] * v[2] + v[3] * v[3]); }
                ss += __shfl_xor(ss, 1); ss += __shfl_xor(ss, 2); ss += __shfl_xor(ss, 4); ss += __shfl_xor(ss, 8);
                float rs = 1.0f;
                if (GLA) rs = 1.0f / sqrtf(ss * (1.0f / DV) + EPS); else if (oc == 0) A.SS[(rowbase + r0 + ot) * 8 + hd] = ss;
#pragma unroll
                for (int e8 = 0; e8 < NV / 8; ++e8) { const v4u gw_ = gg[e8]; float gf[8]; float nwr[NV];
                    { const f32x4 n0 = *(const LAS f32x4*)(NWL + oc * NV + 8 * e8), n1 = *(const LAS f32x4*)(NWL + oc * NV + 8 * e8 + 4); nwr[8 * e8] = n0[0]; nwr[8 * e8 + 1] = n0[1]; nwr[8 * e8 + 2] = n0[2]; nwr[8 * e8 + 3] = n0[3]; nwr[8 * e8 + 4] = n1[0]; nwr[8 * e8 + 5] = n1[1]; nwr[8 * e8 + 6] = n1[2]; nwr[8 * e8 + 7] = n1[3]; }
                    gf[0] = bf2f(gw_.x & 0xffffu); gf[1] = bf2f(gw_.x >> 16); gf[2] = bf2f(gw_.y & 0xffffu); gf[3] = bf2f(gw_.y >> 16); gf[4] = bf2f(gw_.z & 0xffffu); gf[5] = bf2f(gw_.z >> 16); gf[6] = bf2f(gw_.w & 0xffffu); gf[7] = bf2f(gw_.w >> 16);
                    v4u w; w.x = pk2(o[8 * e8] * rs * nwr[8 * e8] * gf[0], o[8 * e8 + 1] * rs * nwr[8 * e8 + 1] * gf[1]); w.y = pk2(o[8 * e8 + 2] * rs * nwr[8 * e8 + 2] * gf[2], o[8 * e8 + 3] * rs * nwr[8 * e8 + 3] * gf[3]);
                    w.z = pk2(o[8 * e8 + 4] * rs * nwr[8 * e8 + 4] * gf[4], o[8 * e8 + 5] * rs * nwr[8 * e8 + 5] * gf[5]); w.w = pk2(o[8 * e8 + 6] * rs * nwr[8 * e8 + 6] * gf[6], o[8 * e8 + 7] * rs * nwr[8 * e8 + 7] * gf[7]);
                    __builtin_amdgcn_raw_buffer_store_b128(w, ro, vog + 16u * e8, r0 * VST, 0); gg[e8] = ggn[e8]; } }
        }
        __syncthreads();
    }
}
constexpr int NPH = 2 + DEPTH * 7 + 1;
struct Args { const float* in[24]; float* out; unsigned char* ws; int ph_lo, ph_hi; };
#define AS4 __attribute__((address_space(4)))
#define KARG() ({ const AS4 Args* _p = (const AS4 Args*)__builtin_amdgcn_kernarg_segment_ptr(); asm volatile("" : "+s"(_p)); _p; })
#define KIN(i) ((const float*)KARG()->in[i])
#define KWS() ((unsigned char*)KARG()->ws)
__global__ void __launch_bounds__(NWAVES * 64, 2) mk_fwd(Args args_unused) {
    extern __shared__ __attribute__((aligned(16))) unsigned char lds[];
    Frame F;
    F.lds = (LAS unsigned char*)lds;
    F.MISC = (volatile LAS unsigned*)(F.lds + MISC_OFF);
    F.wave = __builtin_amdgcn_readfirstlane((int)threadIdx.x >> 6);
    F.G = gridDim.x; { const int bx = blockIdx.x; F.vcu = (F.G % 8 == 0) ? (bx % 8) * (F.G / 8) + bx / 8 : bx; }
    F.ctl = (gu32*)(KWS() + WS_CTL);
    for (int u = threadIdx.x; u < (LDS_BYTES - LDSCTL_OFF) / 4; u += NWAVES * 64) ((LAS unsigned*)(F.lds + LDSCTL_OFF))[u] = 0u;
    __syncthreads();
    XcdBarrier bar = xcd_barrier_post((unsigned*)(F.ctl + CW_BAR), F.MISC + 8); bar.wave = F.wave;
#ifdef PROBE_KIND
#define PB(kind) do { if (((1 << (kind)) & PROBE_KIND) && blockIdx.x == 0 && F.wave == 0 && lane_id() == 0) { volatile unsigned long long* tp_ = (volatile unsigned long long*)(KWS() + 512 * 1024); tp_[0] = __builtin_amdgcn_s_memrealtime(); } } while (0)
#define PE(kind) do { if (((1 << (kind)) & PROBE_KIND) && blockIdx.x == 0 && F.wave == 0 && lane_id() == 0) { volatile unsigned long long* tp_ = (volatile unsigned long long*)(KWS() + 512 * 1024); tp_[1] = tp_[1] + (__builtin_amdgcn_s_memrealtime() - tp_[0]); } } while (0)
#else
#define PB(kind) do {} while (0)
#define PE(kind) do {} while (0)
#endif
#if MK_N_LAUNCHES == 1
#define RUN() true
#define SEAM() xcd_barrier(bar)
#else
    int pi = 0;
#define RUN() (KARG()->ph_lo == pi)
#define SEAM() (++pi)
#endif
    PB(0);
    if (RUN()) { const AS4 Args* a = KARG(); ProIn P{a->in[1], a->in[2], a->in[3], a->in[6], a->in[7], a->in[8], a->in[11], a->in[14], a->in[15], a->in[16], a->in[18], a->in[19], a->in[23]};
        p0_prologue(F, P, KWS()); }
    SEAM(); PE(0); PB(10);
    if (RUN()) { const AS4 Args* a = KARG(); Pro2In P{a->in[0], a->in[4]};
        p1_prologue(F, P, KWS()); }
    SEAM(); PE(10);
    for (int l = 0; l < DEPTH; ++l) {
        for (int s = 0; s < 3; ++s) {
            PB(s != 1 ? 2 : 4);
            if (RUN()) { unsigned char* ws = KWS(); unsigned char* SCR = ws + WS_SCR; const int mx = l % 3, mi = l / 3;
                const size_t ainoff = s == 2 ? WS_SCR : WS_H; const bf16* Ain = (const bf16*)(ws + ainoff);
                const pg8::RowScale R{(const float*)(ws + WS_PS), (LAS float*)(F.lds + LDSCTL_OFF + 2048)}; const float* b2 = (const float*)(ws + WS_B2 + (size_t)(l * 3 + s) * B2_BYTES);
                if (s != 1) { const int fi = l * 2 + (s >> 1);
                    pg8::Gemm g{Ain, (const bf16*)(ws + WS_W13 + fi * W13_BYTES), M, 2 * FF, D}; pg8::StaticOrder S; S.init(M, 2 * FF, F.G, (int)blockIdx.x);
                    pg8::EpiSwiglu E{(bf16*)(SCR + ACT_BYTES), FF, R, b2};
                    pg8::gemm_phase<pg8::EpiSwiglu, pg8::StaticOrder, true, true>(F.lds, g, S, E, F.wave);
                }
                else if (mx == 0) {
                    pg8::Gemm g{Ain, (const bf16*)(ws + WS_RGIN + mi * RGIN_BYTES), M, 2048, D}; pg8::StaticOrder S; S.init(M, 2048, F.G, (int)blockIdx.x);
                    pg8::EpiRgIn E{(bf16*)SCR, R, b2};
                    pg8::gemm_phase<pg8::EpiRgIn, pg8::StaticOrder, true, true>(F.lds, g, S, E, F.wave);
                } else if (mx == 1) {
                    pg8::Gemm g{Ain, (const bf16*)(ws + WS_HGIN), M, 4096, D}; pg8::StaticOrder S; S.init(M, 4096, F.G, (int)blockIdx.x);
                    pg8::EpiHgIn E{(bf16*)SCR, (float*)(SCR + 3 * ACT_BYTES), (const float*)(ws + WS_LB), R, b2};
                    pg8::gemm_phase<pg8::EpiHgIn, pg8::StaticOrder, true, true>(F.lds, g, S, E, F.wave);
                } else {
                    pg8::Gemm g{Ain, (const bf16*)(ws + WS_GLIN), M, GLA_INP, D}; pg8::StaticOrder S; S.init(M, GLA_INP, F.G, (int)blockIdx.x);
                    pg8::EpiGlIn E{(bf16*)SCR, (float*)(SCR + 3 * ACT_BYTES), R, b2};
                    pg8::gemm_phase<pg8::EpiGlIn, pg8::StaticOrder, true, true>(F.lds, g, S, E, F.wave);
                }
            }
            SEAM(); PE(s != 1 ? 2 : 4);
            if (s == 1) {
                PB(5 + l % 3);
                if (RUN()) {
                    unsigned char* ws = KWS(); bf16* H = (bf16*)(ws + WS_H); unsigned char* SCR = ws + WS_SCR; const int mx = l % 3, mi = l / 3;
                    if (mx == 0) { RgArgs A{(const bf16*)SCR, (const bf16*)(SCR + ACT_BYTES), H, (const bf16*)(ws + WS_RGG + mi * RGG_BYTES), KIN(12) + (size_t)mi * 8 * 256, KIN(13) + (size_t)mi * D, KIN(9) + (size_t)mi * 4 * D, KIN(10) + (size_t)mi * D};
                        rg_scan_phase(F, A); }
                    else if (mx == 1) { GlaArgs A{(const bf16*)SCR, nullptr, (const float*)(SCR + 3 * ACT_BYTES), (const bf16*)(SCR + ACT_BYTES), (const bf16*)(SCR + 2 * ACT_BYTES), nullptr, nullptr, nullptr, KIN(17), H, (float*)(ws + WS_SS)};
                        gla_scan_phase<128, false>(F, A); }
                    else { GlaArgs A{(const bf16*)SCR, (const bf16*)(SCR + ACT_BYTES / 2), nullptr, (const bf16*)(SCR + ACT_BYTES), (const bf16*)(SCR + 2 * ACT_BYTES), (const float*)(SCR + 3 * ACT_BYTES), KIN(20), KIN(21), KIN(22), H, nullptr};
                        gla_scan_phase<256, true>(F, A); }
                }
                SEAM(); PE(5 + l % 3);
            }
            PB(s != 1 ? 3 : 8);
            if (RUN()) { unsigned char* ws = KWS(); const int mx = l % 3, mi = l / 3;
                const float* xcur = (l == 0 && s == 0) ? KIN(0) : (const float*)KARG()->out;
                const float* modl = (const float*)(ws + WS_MOD) + (size_t)l * BATCH * (NMOD * D);
                const bf16* Ap; const bf16* Bp; int K; float fac; const float* ssp = nullptr;
                if (s != 1) { Ap = (const bf16*)(ws + WS_SCR + ACT_BYTES); Bp = (const bf16*)(ws + WS_W2 + (l * 2 + (s >> 1)) * W2_BYTES); K = FF; fac = 0.5f; }
                else { Ap = (const bf16*)(ws + WS_H); K = D; fac = 1.0f;
                    if (mx == 0) Bp = (const bf16*)(ws + WS_RGOUT + mi * SQ_BYTES); else if (mx == 1) { Bp = (const bf16*)(ws + WS_HGOUT); ssp = (const float*)(ws + WS_SS); } else Bp = (const bf16*)(ws + WS_GLOUT); }
                const bool last = (l == DEPTH - 1 && s == 2); const int ln = s == 2 ? l + 1 : l, sn = s == 2 ? 0 : s + 1;
                const size_t anoff = s == 1 ? WS_SCR : WS_H; bf16* An = (bf16*)(ws + anoff); if (last) An = nullptr;
                const float* nwn = KIN(4) + ((size_t)(last ? 0 : ln) * 3 + sn) * D;
                const float* scn = (const float*)(ws + WS_MOD) + (size_t)(last ? 0 : ln) * BATCH * (NMOD * D) + (3 * sn + 1) * D;
                pg8::Gemm g{Ap, Bp, M, D, K}; pg8::StaticOrder S; S.init(M, D, F.G, (int)blockIdx.x);
                { LAS pg8::EpiResidParams* pp = (LAS pg8::EpiResidParams*)(F.lds + LDSCTL_OFF + 1024);
                  int cs_ = NMOD * D; asm volatile("" : "+s"(ssp), "+s"(An), "+s"(nwn), "+s"(scn), "+s"(xcur), "+s"(cs_), "+s"(fac));
                  if (F.wave == 0 && lane_id() == 0) { pp->base = xcur; pp->out = KARG()->out; pp->coef = modl + (3 * s + 2) * D; pp->ss = ssp; pp->An = An; pp->nwn = nwn; pp->scn = scn; pp->PS = (float*)(ws + WS_PS); pp->cstride = cs_; pp->fac = fac; }
                  __syncthreads(); }
                pg8::EpiResid E{(const LAS unsigned*)(F.lds + LDSCTL_OFF + 1024)};
                pg8::gemm_phase<pg8::EpiResid, pg8::StaticOrder, true, true>(F.lds, g, S, E, F.wave);
            }
            SEAM(); PE(s != 1 ? 3 : 8);
        }
    }
    PB(9);
    if (RUN()) { float* xo = KARG()->out; final_norm_phase(F, xo, KIN(5), xo); }
    PE(9);
#ifdef PROBE_KIND
    if (blockIdx.x == 0 && F.wave == 0 && lane_id() == 0) { volatile unsigned long long* tp_ = (volatile unsigned long long*)(KWS() + 512 * 1024); const unsigned long long want = tp_[1] * PROBE_MUL, t0_ = __builtin_amdgcn_s_memrealtime();
        while (__builtin_amdgcn_s_memrealtime() - t0_ < want) __builtin_amdgcn_s_sleep(8); }
#endif
#undef RUN
#undef SEAM
}

extern "C" void kernel_launch(void* const* d_in, const int* in_sizes, int n_in, void* d_out, int out_size, void* d_ws, size_t ws_size, hipStream_t stream) {
    static int grid = 0;
    if (grid == 0) {
        if (n_in != 24 || in_sizes[0] != M * D || out_size != M * D || ws_size < WS_END) { fprintf(stderr, "kernel_launch: unexpected shapes (n_in %d, in0 %d, out %d, ws %zu < %zu); nothing launched\n", n_in, n_in > 0 ? in_sizes[0] : -1, out_size, ws_size, (size_t)WS_END); grid = -1; return; }
        int dev = 0, cus = 0, per_cu = 0;
        if (hipGetDevice(&dev) != hipSuccess || hipDeviceGetAttribute(&cus, hipDeviceAttributeMultiprocessorCount, dev) != hipSuccess) { grid = -1; return; }
        if (hipFuncSetAttribute((const void*)mk_fwd, hipFuncAttributeMaxDynamicSharedMemorySize, LDS_BYTES) != hipSuccess) { fprintf(stderr, "kernel_launch: hipFuncSetAttribute failed\n"); grid = -1; return; }
        if (hipOccupancyMaxActiveBlocksPerMultiprocessor(&per_cu, (const void*)mk_fwd, NWAVES * 64, LDS_BYTES) != hipSuccess || per_cu < 1)
            fprintf(stderr, "kernel_launch: note: occupancy query reports %d workgroups per CU\n", per_cu);
        (void)hipGetLastError();
        grid = cus;
    }
    if (grid < 0) return;
    if (hipMemsetAsync((char*)d_ws + WS_CTL, 0, CTL_ZERO_BYTES, stream) != hipSuccess) return;
    Args a{};
    for (int i = 0; i < 24; ++i) a.in[i] = (const float*)d_in[i];
    a.out = (float*)d_out; a.ws = (unsigned char*)d_ws;
#if MK_N_LAUNCHES == 1
    a.ph_lo = 0; a.ph_hi = NPH;
    hipLaunchKernelGGL(mk_fwd, dim3(grid), dim3(NWAVES * 64), LDS_BYTES, stream, a);
#else
    for (int p = 0; p < NPH; ++p) { a.ph_lo = p; a.ph_hi = p + 1; hipLaunchKernelGGL(mk_fwd, dim3(grid), dim3(NWAVES * 64), LDS_BYTES, stream, a); }
#endif
}
```

```cpp
#include <hip/hip_runtime.h>
#include <cstdio>
#include <cstdint>
#include <cmath>
#ifndef MK_N_LAUNCHES
#define MK_N_LAUNCHES 1
#endif
namespace pg8 {
#define PG8_LAS __attribute__((address_space(3)))
typedef unsigned short bf16_t;
typedef short bf16x8 __attribute__((ext_vector_type(8)));
typedef float f32x4 __attribute__((ext_vector_type(4)));
typedef unsigned u32x4 __attribute__((ext_vector_type(4)));
constexpr int BM = 256, BK = 64, HALF = 128, HTB = HALF * BK * 2  , STAGE_BYTES = 8 * HTB, NXCD = 8, WGM = 8;

__host__ __device__ __forceinline__ int lds_byte(int r, int c) { const int st = (r >> 4) * 2 + (c >> 5), rr = r & 15, cc = c & 31, ob = rr * 64 + cc * 2; return st * 1024 + (ob ^ (((ob >> 9) & 1) << 5)); }
__host__ __device__ __forceinline__ void stage_rc(int b, int& R, int& C) { const int st = b / 1024, sb = b % 1024, swz = sb ^ (((sb >> 9) & 1) << 5); R = (st >> 1) * 16 + swz / 64; C = (st & 1) * 32 + (swz % 64) / 2; }
__host__ __device__ __forceinline__ int perm32(int rho) { const int n = rho >> 4, i = rho & 15; return 8 * (i >> 2) + 4 * n + (i & 3); }

struct Unit { int pm, pn; };
struct Gemm { const bf16_t* A; const bf16_t* Bt; int M, N, K; };

struct StaticOrder {
    int nM, nN, nwg, G, c;
    __host__ __device__ void init(int M, int N, int G_, int c_) { nM = M / BM; nN = N / BM; nwg = nM * nN; G = G_; c = c_; }
    __host__ __device__ bool next(int i, Unit& u) const {
        const int L = i * G + c; if (L >= nwg) return false;
        int wgid = L; { const int q = nwg / NXCD, r = nwg % NXCD, xcd = wgid % NXCD, off = wgid / NXCD; wgid = (xcd < r ? xcd * (q + 1) : r * (q + 1) + (xcd - r) * q) + off; }
        const int nig = WGM * nN, gid = wgid / nig, fm = gid * WGM, gsz = (nM - fm) < WGM ? (nM - fm) : WGM;
        u.pm = fm + ((wgid % nig) % gsz); u.pn = (wgid % nig) / gsz; return true;
    }
    __device__ __forceinline__ void a_ready(const Unit&) const {}
    __device__ __forceinline__ void done(const Unit&) const {}
};

typedef float f32x2_t __attribute__((ext_vector_type(2))); typedef __bf16 bf16x2_t __attribute__((ext_vector_type(2)));
__device__ __forceinline__ unsigned cvt_pk_bf16(float lo, float hi) { const f32x2_t v = {lo, hi}; const bf16x2_t b = __builtin_convertvector(v, bf16x2_t); return __builtin_bit_cast(unsigned, b); }
__device__ __forceinline__ u32x4 pack8(const f32x4 a, const f32x4 b) { u32x4 w; w.x = cvt_pk_bf16(a[0], a[1]); w.y = cvt_pk_bf16(a[2], a[3]); w.z = cvt_pk_bf16(b[0], b[1]); w.w = cvt_pk_bf16(b[2], b[3]); return w; }
__device__ __forceinline__ float fast_sigmoid(float x) { return __builtin_amdgcn_rcpf(1.0f + __builtin_amdgcn_exp2f(-1.4426950408889634f * x)); }
__device__ __forceinline__ f32x4 sigmoid4(const f32x4 v) { f32x4 o; o[0] = fast_sigmoid(v[0]); o[1] = fast_sigmoid(v[1]); o[2] = fast_sigmoid(v[2]); o[3] = fast_sigmoid(v[3]); return o; }
__device__ __forceinline__ f32x4 silu4(const f32x4 v) { return v * sigmoid4(v); }
__device__ __forceinline__ f32x4 gelu_tanh4(const f32x4 v) { const f32x4 z = v * (1.5957691216057308f + 0.07135481627260025f * (v * v)); return v * sigmoid4(z); }

struct PrefIn { f32x4 p0, p1, b; };
struct RowScale {
    const float* PS; PG8_LAS float* tab;
    __device__ __forceinline__ void fetch(PrefIn& pf, const Unit& u, int tid, const float* bsrc0, const float* bsrc1) const {
        asm volatile("" : "+v"(tid));
        const float* pp = PS + (size_t)(u.pm * BM + (tid >> 1)) * 16 + 8 * (tid & 1);
        pf.p0 = *(const f32x4*)pp; pf.p1 = *(const f32x4*)(pp + 4);
        if (tid < 64) pf.b = *(const f32x4*)((tid < 32 ? bsrc0 : bsrc1) + 4 * (tid & 31));
    }
    __device__ __forceinline__ void finish(float (&rs)[2][4], f32x4 (&bv)[2][2], const PrefIn& pf, int tid, int wr, int wc, int fr, int fq) const {
        float s = ((pf.p0[0] + pf.p0[1]) + (pf.p0[2] + pf.p0[3])) + ((pf.p1[0] + pf.p1[1]) + (pf.p1[2] + pf.p1[3])); s += __shfl_xor(s, 1);
        if ((tid & 1) == 0) tab[tid >> 1] = 1.0f / sqrtf(s * (1.0f / 1024.0f) + 1e-6f);
        if (tid < 64) *(PG8_LAS f32x4*)(tab + 256 + 4 * tid) = pf.b;
        asm volatile("s_waitcnt lgkmcnt(0)" ::: "memory"); __builtin_amdgcn_s_barrier(); asm volatile("" ::: "memory");
#pragma unroll
        for (int ai = 0; ai < 2; ++ai)
#pragma unroll
            for (int m = 0; m < 4; ++m) rs[ai][m] = tab[ai * HALF + wr * 64 + m * 16 + fr];
#pragma unroll
        for (int bj = 0; bj < 2; ++bj)
#pragma unroll
            for (int n = 0; n < 2; ++n) bv[bj][n] = *(const PG8_LAS f32x4*)(tab + 256 + bj * HALF + wc * 32 + 8 * fq + 4 * n);
    }
};
struct EpiSwiglu {
    static constexpr bool PERM = true, AFTER_DRAIN = false; static constexpr int PROBE_ID = 1; unsigned char* wsp; __device__ __forceinline__ void* probe_ptr() const { return wsp + 512 * 1024; }
    bf16_t* O; int ldc; RowScale R; const float* b2;
    typedef PrefIn Pref;
    __device__ __forceinline__ void prefetch(Pref& pf, const Unit& u, int tid) const { const float* bp = b2 + (size_t)(u.pm >> 3) * 5632 + u.pn * HALF; R.fetch(pf, u, tid, bp, bp + 2816); }
    __device__ __forceinline__ void operator()(const f32x4 (&acc)[2][2][4][2], const Unit& u, int wr, int wc, int fr, int fq, const Pref& pf, int tid) const {
        const int row0 = u.pm * BM + wr * 64 + fr, col0 = u.pn * HALF + wc * 32 + 8 * fq;
        float rs[2][4]; f32x4 bv[2][2]; R.finish(rs, bv, pf, tid, wr, wc, fr, fq);
        const f32x4 bg0 = bv[0][0], bg1 = bv[0][1], bu0 = bv[1][0], bu1 = bv[1][1];
#pragma unroll
        for (int ai = 0; ai < 2; ++ai)
#pragma unroll
            for (int m = 0; m < 4; ++m) { bf16_t* rowp = O + (size_t)(row0 + ai * HALF + m * 16) * ldc + col0; const float r = rs[ai][m];
                const f32x4 v0 = silu4(acc[ai][0][m][0] * r + bg0) * (acc[ai][1][m][0] * r + bu0), v1 = silu4(acc[ai][0][m][1] * r + bg1) * (acc[ai][1][m][1] * r + bu1);
                *(u32x4*)rowp = pack8(v0, v1); }
    }
};
struct EpiRgIn {
    static constexpr bool PERM = true, AFTER_DRAIN = false; static constexpr int PROBE_ID = 2; unsigned char* wsp; __device__ __forceinline__ void* probe_ptr() const { return wsp + 512 * 1024; }
    bf16_t* Y; RowScale R; const float* b2;
    typedef PrefIn Pref;
    __device__ __forceinline__ void prefetch(Pref& pf, const Unit& u, int tid) const { const float* bp = b2 + (size_t)(u.pm >> 3) * 2048 + u.pn * BM; R.fetch(pf, u, tid, bp, bp + HALF); }
    __device__ __forceinline__ void operator()(const f32x4 (&acc)[2][2][4][2], const Unit& u, int wr, int wc, int fr, int fq, const Pref& pf, int tid) const {
        const int row0 = u.pm * BM + wr * 64 + fr; const bool isy = u.pn < 4;
        float rs[2][4]; f32x4 bv[2][2]; R.finish(rs, bv, pf, tid, wr, wc, fr, fq);
        bf16_t* base = Y + (size_t)(isy ? 0 : 1) * ((size_t)65536 * 1024) + (u.pn & 3) * BM + wc * 32 + 8 * fq;
#pragma unroll
        for (int ai = 0; ai < 2; ++ai)
#pragma unroll
            for (int m = 0; m < 4; ++m) { bf16_t* rowp = base + (size_t)(row0 + ai * HALF + m * 16) * 1024; const float r = rs[ai][m];
#pragma unroll
                for (int bj = 0; bj < 2; ++bj) { f32x4 v0 = acc[ai][bj][m][0] * r + bv[bj][0], v1 = acc[ai][bj][m][1] * r + bv[bj][1];
                    if (isy) { v0 = gelu_tanh4(v0); v1 = gelu_tanh4(v1); }
                    *(u32x4*)(rowp + bj * HALF) = pack8(v0, v1); } }
    }
};
struct EpiHgIn {
    static constexpr bool PERM = true, AFTER_DRAIN = false; static constexpr int PROBE_ID = 3; unsigned char* wsp; __device__ __forceinline__ void* probe_ptr() const { return wsp + 512 * 1024; }
    bf16_t* Q; float* LOGF; const float* lb; RowScale R; const float* b2;
    typedef PrefIn Pref;
    __device__ __forceinline__ void prefetch(Pref& pf, const Unit& u, int tid) const { const float* bp = b2 + (size_t)(u.pm >> 3) * 4096 + u.pn * BM; R.fetch(pf, u, tid, bp, bp + HALF); }
    __device__ __forceinline__ void operator()(const f32x4 (&acc)[2][2][4][2], const Unit& u, int wr, int wc, int fr, int fq, const Pref& pf, int tid) const {
        const int row0 = u.pm * BM + wr * 64 + fr, sec = u.pn >> 2, colw = (u.pn & 3) * BM + wc * 32 + 8 * fq;
        float rs[2][4]; f32x4 bv[2][2]; R.finish(rs, bv, pf, tid, wr, wc, fr, fq);
        if (sec == 1) {
#pragma unroll
            for (int bj = 0; bj < 2; ++bj) { const f32x4 l0 = *(const f32x4*)(lb + colw + bj * HALF), l1 = *(const f32x4*)(lb + colw + bj * HALF + 4);
#pragma unroll
                for (int ai = 0; ai < 2; ++ai)
#pragma unroll
                    for (int m = 0; m < 4; ++m) { float* rowp = LOGF + (size_t)(row0 + ai * HALF + m * 16) * 1024 + colw + bj * HALF; const float r = rs[ai][m];
                        const f32x4 s0 = sigmoid4(acc[ai][bj][m][0] * r + bv[bj][0]), s1 = sigmoid4(acc[ai][bj][m][1] * r + bv[bj][1]);
                        const f32x4 f0 = l0 + (1.0f - l0) * s0, f1 = l1 + (1.0f - l1) * s1; f32x4 o0, o1;
#pragma unroll
                        for (int e = 0; e < 4; ++e) { o0[e] = __logf(f0[e]); o1[e] = __logf(f1[e]); }
                        *(f32x4*)rowp = o0; *(f32x4*)(rowp + 4) = o1; } }
        } else {
            bf16_t* base = Q + (size_t)(sec - (sec > 0 ? 1 : 0)) * ((size_t)65536 * 1024) + colw;
#pragma unroll
            for (int ai = 0; ai < 2; ++ai)
#pragma unroll
                for (int m = 0; m < 4; ++m) { bf16_t* rowp = base + (size_t)(row0 + ai * HALF + m * 16) * 1024; const float r = rs[ai][m];
#pragma unroll
                    for (int bj = 0; bj < 2; ++bj) { f32x4 v0 = acc[ai][bj][m][0] * r + bv[bj][0], v1 = acc[ai][bj][m][1] * r + bv[bj][1];
                        if (sec == 3) { v0 = sigmoid4(v0); v1 = sigmoid4(v1); }
                        *(u32x4*)(rowp + bj * HALF) = pack8(v0, v1); } }
        }
    }
};
struct EpiGlIn {
    static constexpr bool PERM = true, AFTER_DRAIN = false; static constexpr int PROBE_ID = 4; unsigned char* wsp; __device__ __forceinline__ void* probe_ptr() const { return wsp + 512 * 1024; }
    bf16_t* Q; float* ALOW; RowScale R; const float* b2;
    typedef PrefIn Pref;
    __device__ __forceinline__ void prefetch(Pref& pf, const Unit& u, int tid) const { const float* bp = b2 + (size_t)(u.pm >> 3) * 3328 + u.pn * BM; R.fetch(pf, u, tid, bp, u.pn == 12 ? bp : bp + HALF); }
    __device__ __forceinline__ void operator()(const f32x4 (&acc)[2][2][4][2], const Unit& u, int wr, int wc, int fr, int fq, const Pref& pf, int tid) const {
        const int row0 = u.pm * BM + wr * 64 + fr, pn = u.pn;
        float rs[2][4]; f32x4 bv[2][2]; R.finish(rs, bv, pf, tid, wr, wc, fr, fq);
        if (pn == 12) {
            if (wc == 0 && fq < 2) { const f32x4 b0 = bv[0][0], b1 = bv[0][1];
#pragma unroll
                for (int ai = 0; ai < 2; ++ai)
#pragma unroll
                    for (int m = 0; m < 4; ++m) { float* rowp = ALOW + (size_t)(row0 + ai * HALF + m * 16) * 16 + 8 * fq; const float r = rs[ai][m];
                        *(f32x4*)rowp = acc[ai][0][m][0] * r + b0; *(f32x4*)(rowp + 4) = acc[ai][0][m][1] * r + b1; }
            }
            return;
        }
        const int g2 = pn >= 2 ? 1 : 0, g4 = pn >= 4 ? 1 : 0, g8 = pn >= 8 ? 1 : 0; const int ld = 512 + 512 * g4;
        bf16_t* base = Q + (size_t)(g2 + g4 + 2 * g8) * ((size_t)65536 * 512) + (pn - 2 * g2 - 2 * g4 - 4 * g8) * BM;
        base += wc * 32 + 8 * fq; const bool act = pn >= 8;
#pragma unroll
        for (int ai = 0; ai < 2; ++ai)
#pragma unroll
            for (int m = 0; m < 4; ++m) { bf16_t* rowp = base + (size_t)(row0 + ai * HALF + m * 16) * ld; const float r = rs[ai][m];
#pragma unroll
                for (int bj = 0; bj < 2; ++bj) { f32x4 v0 = acc[ai][bj][m][0] * r + bv[bj][0], v1 = acc[ai][bj][m][1] * r + bv[bj][1];
                    if (act) { v0 = silu4(v0); v1 = silu4(v1); }
                    *(u32x4*)(rowp + bj * HALF) = pack8(v0, v1); } }
    }
};
struct EpiResidParams { const float* base; float* out; const float* coef; const float* ss; bf16_t* An; const float* nwn; const float* scn; float* PS; int cstride; float fac; };
struct PrefRes { f32x4 a, c; };
struct EpiResid {
    static constexpr bool PERM = true, AFTER_DRAIN = false; static constexpr int PROBE_ID = 5; unsigned char* wsp; __device__ __forceinline__ void* probe_ptr() const { return wsp + 512 * 1024; }
    const PG8_LAS unsigned* pb; PG8_LAS float* tab;
    typedef __attribute__((address_space(1))) float gfl; typedef __attribute__((address_space(1))) bf16_t gbf; typedef __attribute__((address_space(1))) f32x4 gf4;
    typedef PrefRes Pref;
    __device__ __forceinline__ unsigned long long ld64(int i) const { const unsigned lo = __builtin_amdgcn_readfirstlane(pb[2 * i]), hi = __builtin_amdgcn_readfirstlane(pb[2 * i + 1]); return ((unsigned long long)hi << 32) | lo; }
    __device__ __forceinline__ void prefetch(Pref& pf, const Unit& u, int tid) const {
        asm volatile("" : "+v"(tid));
        const gfl* ss = (const gfl*)ld64(3); const int cstride = (int)__builtin_amdgcn_readfirstlane(pb[16]); const int wv = __builtin_amdgcn_readfirstlane(tid >> 6);
        pf.a = (f32x4){0.f, 0.f, 0.f, 0.f}; pf.c = pf.a;
        if (ss) pf.a = *(const gf4*)(ss + (size_t)(u.pm * BM + (tid >> 1)) * 8 + 4 * (tid & 1));
        const size_t boff = (size_t)(u.pm >> 3) * cstride + u.pn * BM + 4 * (tid & 63);
        if (wv == 0) pf.c = *(const gf4*)((const gfl*)ld64(2) + boff);
        else if (wv == 1) { if (ld64(4)) pf.c = *(const gf4*)((const gfl*)ld64(5) + u.pn * BM + 4 * (tid & 63)); }
        else if (wv == 2) { if (ld64(4)) pf.c = *(const gf4*)((const gfl*)ld64(6) + boff); }
    }
    __device__ __forceinline__ void operator()(const f32x4 (&acc)[2][2][4][2], const Unit& u, int wr, int wc, int fr, int fq, const Pref& pf, int tid) const {
        asm volatile("" : "+v"(fq), "+v"(fr), "+v"(tid));
        const gfl* base = (const gfl*)ld64(0); gfl* out = (gfl*)ld64(1); const bool hasss = ld64(3) != 0ull;
        gbf* An = (gbf*)ld64(4); gfl* PS = (gfl*)ld64(7);
        const float fac = __builtin_bit_cast(float, __builtin_amdgcn_readfirstlane(pb[17]));
        const int row0 = u.pm * BM + wr * 64 + fr, col0 = u.pn * BM + wc * 32 + 8 * fq;
        { float sr = (pf.a[0] + pf.a[1]) + (pf.a[2] + pf.a[3]); sr += __shfl_xor(sr, 1); if ((tid & 1) == 0) tab[tid >> 1] = hasss ? 1.0f / sqrtf(sr * (1.0f / 1024.0f) + 1e-6f) : 1.0f; }
        if (tid < 192) *(PG8_LAS f32x4*)(tab + 256 + 4 * tid) = tid < 64 ? pf.c * fac : pf.c;
        asm volatile("s_waitcnt lgkmcnt(0)" ::: "memory"); __builtin_amdgcn_s_barrier(); asm volatile("" ::: "memory");
        f32x4 cv[2][2], gv[2][2];
#pragma unroll
        for (int bj = 0; bj < 2; ++bj)
#pragma unroll
            for (int n = 0; n < 2; ++n) { const int c = bj * HALF + wc * 32 + 8 * fq + 4 * n; cv[bj][n] = *(const PG8_LAS f32x4*)(tab + 256 + c);
                gv[bj][n] = *(const PG8_LAS f32x4*)(tab + 512 + c) * (1.0f + *(const PG8_LAS f32x4*)(tab + 768 + c)); }
#pragma unroll
        for (int g = 0; g < 4; ++g) { const int ai = g >> 1, m0 = (g & 1) * 2;
            f32x4 pre[2][2][2]; float rs[2];
#pragma unroll
            for (int mm = 0; mm < 2; ++mm) { const int row = row0 + ai * HALF + (m0 + mm) * 16; const size_t off = (size_t)row * 1024 + col0;
#pragma unroll
                for (int bj = 0; bj < 2; ++bj)
#pragma unroll
                    for (int n = 0; n < 2; ++n) pre[mm][bj][n] = *(const gf4*)(base + off + bj * HALF + n * 4);
                rs[mm] = tab[ai * HALF + wr * 64 + (m0 + mm) * 16 + fr]; }
            asm volatile("" ::: "memory");
#pragma unroll
            for (int mm = 0; mm < 2; ++mm) { const int row = row0 + ai * HALF + (m0 + mm) * 16; const size_t off = (size_t)row * 1024 + col0; float sq = 0.f;
#pragma unroll
                for (int bj = 0; bj < 2; ++bj) { f32x4 xn[2];
#pragma unroll
                    for (int n = 0; n < 2; ++n) { xn[n] = pre[mm][bj][n] + (cv[bj][n] * rs[mm]) * acc[ai][bj][m0 + mm][n]; *(gf4*)(out + off + bj * HALF + n * 4) = xn[n];
                        sq += (xn[n][0] * xn[n][0] + xn[n][1] * xn[n][1]) + (xn[n][2] * xn[n][2] + xn[n][3] * xn[n][3]); }
                    if (An) *(__attribute__((address_space(1))) u32x4*)(An + off + bj * HALF) = pack8(xn[0] * gv[bj][0], xn[1] * gv[bj][1]); }
                if (An) { sq += __shfl_xor(sq, 16); sq += __shfl_xor(sq, 32); if (fq == 0) PS[(size_t)row * 16 + u.pn * 4 + wc] = sq; } }
            asm volatile("" ::: "memory");
        }
    }
};

template <class Epi, class Sched, bool ALIGN_EPI = false, bool SP2 = false>
__device__ __forceinline__ void gemm_phase(PG8_LAS unsigned char* lds, const Gemm g, const Sched& S, const Epi& E, const int wave_id) {
    int lid_; asm volatile("v_mbcnt_lo_u32_b32 %0, -1, 0\n\tv_mbcnt_hi_u32_b32 %0, -1, %0" : "=v"(lid_)); int wvl_ = wave_id; asm volatile("" : "+s"(wvl_)); const int tid_ = wvl_ * 64 + lid_;
    const int tid = tid_, wid = wvl_, lane = tid & 63, wr = wid >> 2, wc = wid & 3, fr = lane & 15, fq = lane >> 4;
    const int K = g.K, nt = K / BK;
    unsigned voffA[2], voffB[2];
#pragma unroll
    for (int i = 0; i < 2; ++i) { int R, C; stage_rc(tid * 16 + i * 8192, R, C); const int Rb = Epi::PERM ? ((R & ~31) + perm32(R & 31)) : R;
        voffA[i] = (unsigned)(R * K + C) * 2u; voffB[i] = (unsigned)(Rb * K + C) * 2u; }
    const size_t kstep = (size_t)(BK * 2);
    const size_t hstep = (size_t)HALF * K * 2;
    const size_t tstep = 2 * hstep;
    const unsigned ldsw = (unsigned)wid * 1024u;
    const int aoff = lds_byte(wr * 64 + fr, fq * 8), boff = lds_byte(wc * 32 + fr, fq * 8);
#define PG8_SA(b, h) (((b) * 2 + (h)) * HTB)
#define PG8_SB(b, h) ((4 + (b) * 2 + (h)) * HTB)
#define PG8_STAGE(bufoff, gbase, voff) do { _Pragma("unroll") for (int _i = 0; _i < 2; ++_i) \
        __builtin_amdgcn_global_load_lds((const unsigned*)((const char*)(gbase) + (voff)[_i]), (PG8_LAS unsigned*)(lds + (bufoff) + ldsw + _i * 8192), 16, 0, 0); } while (0)
#define PG8_LDA(dst, b, h) do { _Pragma("unroll") for (int m = 0; m < 4; ++m) _Pragma("unroll") for (int k = 0; k < 2; ++k) dst[m][k] = *(const PG8_LAS bf16x8*)(lds + PG8_SA(b, h) + aoff + m * 2048 + k * 1024); } while (0)
#define PG8_LDB(dst, b, h) do { _Pragma("unroll") for (int n = 0; n < 2; ++n) _Pragma("unroll") for (int k = 0; k < 2; ++k) dst[n][k] = *(const PG8_LAS bf16x8*)(lds + PG8_SB(b, h) + boff + n * 2048 + k * 1024); } while (0)
#define PG8_MMA(ai, bj, At, Bt) do { __builtin_amdgcn_s_setprio(1); _Pragma("unroll") for (int m = 0; m < 4; ++m) _Pragma("unroll") for (int n = 0; n < 2; ++n) _Pragma("unroll") for (int k = 0; k < 2; ++k) \
        acc[ai][bj][m][n] = __builtin_amdgcn_mfma_f32_16x16x32_bf16(Bt[n][k], At[m][k], acc[ai][bj][m][n], 0, 0, 0); __builtin_amdgcn_s_setprio(0); } while (0)
#define PG8_WAIT_V(n) asm volatile("s_waitcnt vmcnt(" #n ")" ::: "memory")
#define PG8_WAIT_L(n) asm volatile("s_waitcnt lgkmcnt(" #n ")" ::: "memory")
#define PG8_BAR __builtin_amdgcn_s_barrier()
#define PG8_SCHED __builtin_amdgcn_sched_barrier(0)
    Unit cur, nxt; int ui = 0;
    typename Epi::Pref pf;
    if (!S.next(0, cur)) return;
    f32x4 acc[2][2][4][2];
#pragma unroll
    for (int a = 0; a < 2; ++a)
#pragma unroll
        for (int b = 0; b < 2; ++b)
#pragma unroll
            for (int m = 0; m < 4; ++m)
#pragma unroll
                for (int n = 0; n < 2; ++n) acc[a][b][m][n] = (f32x4){0.f, 0.f, 0.f, 0.f};
    bf16x8 At[4][2], B0[2][2], B1[2][2];
    const char* cA = (const char*)g.A + (size_t)cur.pm * tstep; const char* cB = (const char*)g.Bt + (size_t)cur.pn * tstep;
    S.a_ready(cur);
    if constexpr (SP2) {
        PG8_STAGE(PG8_SB(0, 0), cB, voffB); PG8_STAGE(PG8_SB(0, 1), cB + hstep, voffB); PG8_STAGE(PG8_SA(0, 0), cA, voffA); PG8_STAGE(PG8_SA(0, 1), cA + hstep, voffA);
        if (wr == 1) PG8_BAR;
        PG8_WAIT_V(2); PG8_BAR;
        PG8_STAGE(PG8_SB(1, 0), cB + kstep, voffB); PG8_STAGE(PG8_SA(1, 0), cA + kstep, voffA); PG8_STAGE(PG8_SB(1, 1), cB + hstep + kstep, voffB);
        PG8_WAIT_V(6); PG8_BAR;
    } else {
        PG8_STAGE(PG8_SB(0, 0), cB, voffB); PG8_STAGE(PG8_SA(0, 0), cA, voffA); PG8_STAGE(PG8_SB(0, 1), cB + hstep, voffB); PG8_STAGE(PG8_SA(0, 1), cA + hstep, voffA);
        if (wr == 1) PG8_BAR;
        PG8_WAIT_V(4); PG8_BAR;
        PG8_STAGE(PG8_SB(1, 0), cB + kstep, voffB); PG8_STAGE(PG8_SA(1, 0), cA + kstep, voffA); PG8_STAGE(PG8_SB(1, 1), cB + hstep + kstep, voffB);
        PG8_WAIT_V(6); PG8_BAR;
    }
    for (;;) {
        const bool has_next = S.next(ui + 1, nxt);
        const char* nA = has_next ? (const char*)g.A + (size_t)nxt.pm * tstep : cA; const char* nB = has_next ? (const char*)g.Bt + (size_t)nxt.pn * tstep : cB;
        for (int t = 0; t < nt; t += 2) {
            const bool last = (t == nt - 2);
            const char* a1 = cA + (size_t)(t + 1) * kstep;
            const char* a2 = last ? nA : cA + (size_t)(t + 2) * kstep; const char* b2 = last ? nB : cB + (size_t)(t + 2) * kstep;
            const char* a3 = a2 + kstep; const char* b3 = b2 + kstep;
            if (last && has_next) S.a_ready(nxt);
            if (last) E.prefetch(pf, cur, tid);
            if constexpr (SP2) {
            PG8_LDB(B0, 0, 0); PG8_LDB(B1, 0, 1); PG8_SCHED; PG8_LDA(At, 0, 0); PG8_STAGE(PG8_SA(1, 1), a1 + hstep, voffA);
            PG8_WAIT_V(8); PG8_WAIT_L(0); PG8_BAR; PG8_MMA(0, 0, At, B0); PG8_MMA(0, 1, At, B1); PG8_BAR; PG8_SCHED;
            PG8_LDA(At, 0, 1); PG8_STAGE(PG8_SB(0, 0), b2, voffB); PG8_STAGE(PG8_SB(0, 1), b2 + hstep, voffB); PG8_STAGE(PG8_SA(0, 0), a2, voffA);
            PG8_WAIT_V(8); PG8_WAIT_L(0); PG8_BAR; PG8_MMA(1, 0, At, B0); PG8_MMA(1, 1, At, B1); PG8_BAR; PG8_SCHED;
            PG8_LDB(B0, 1, 0); PG8_LDB(B1, 1, 1); PG8_SCHED; PG8_LDA(At, 1, 0); PG8_STAGE(PG8_SA(0, 1), a2 + hstep, voffA);
            PG8_WAIT_V(8); PG8_WAIT_L(0); PG8_BAR; PG8_MMA(0, 0, At, B0); PG8_MMA(0, 1, At, B1); PG8_BAR; PG8_SCHED;
            PG8_LDA(At, 1, 1); PG8_STAGE(PG8_SB(1, 0), b3, voffB); PG8_STAGE(PG8_SB(1, 1), b3 + hstep, voffB); PG8_STAGE(PG8_SA(1, 0), a3, voffA);
            PG8_WAIT_V(8); PG8_WAIT_L(0); PG8_BAR; PG8_MMA(1, 0, At, B0); PG8_MMA(1, 1, At, B1); PG8_BAR; PG8_SCHED;
            } else {
            PG8_LDB(B0, 0, 0); PG8_SCHED; PG8_LDA(At, 0, 0); PG8_STAGE(PG8_SA(1, 1), a1 + hstep, voffA);
            PG8_WAIT_L(8); PG8_BAR; PG8_WAIT_L(0); PG8_MMA(0, 0, At, B0); PG8_BAR; PG8_SCHED;
            PG8_LDB(B1, 0, 1); PG8_STAGE(PG8_SB(0, 0), b2, voffB);
            PG8_BAR; PG8_WAIT_L(0); PG8_MMA(0, 1, At, B1); PG8_BAR;
            PG8_LDA(At, 0, 1); PG8_STAGE(PG8_SA(0, 0), a2, voffA);
            PG8_BAR; PG8_WAIT_L(0); PG8_MMA(1, 0, At, B0); PG8_BAR; PG8_SCHED;
            PG8_STAGE(PG8_SB(0, 1), b2 + hstep, voffB);
            PG8_WAIT_V(6); PG8_BAR; PG8_MMA(1, 1, At, B1); PG8_BAR;
            PG8_LDB(B0, 1, 0); PG8_SCHED; PG8_LDA(At, 1, 0); PG8_STAGE(PG8_SA(0, 1), a2 + hstep, voffA);
            PG8_WAIT_L(8); PG8_BAR; PG8_WAIT_L(0); PG8_MMA(0, 0, At, B0); PG8_BAR; PG8_SCHED;
            PG8_LDB(B1, 1, 1); PG8_STAGE(PG8_SB(1, 0), b3, voffB);
            PG8_BAR; PG8_WAIT_L(0); PG8_MMA(0, 1, At, B1); PG8_BAR;
            PG8_LDA(At, 1, 1); PG8_STAGE(PG8_SA(1, 0), a3, voffA);
            PG8_BAR; PG8_WAIT_L(0); PG8_MMA(1, 0, At, B0); PG8_BAR; PG8_SCHED;
            PG8_STAGE(PG8_SB(1, 1), b3 + hstep, voffB);
            PG8_WAIT_V(6); PG8_BAR; PG8_MMA(1, 1, At, B1); PG8_BAR;
            }
        }
        if constexpr (ALIGN_EPI) { if (wr == 0) PG8_BAR; }
#ifdef PROBE_EPI
        unsigned long long te0_ = 0; if (Epi::PROBE_ID == PROBE_EPI) te0_ = __builtin_amdgcn_s_memrealtime();
#endif
        if constexpr (!Epi::AFTER_DRAIN) { E(acc, cur, wr, wc, fr, fq, pf, tid); S.done(cur); }
#ifdef PROBE_EPI
        if (Epi::PROBE_ID == PROBE_EPI && blockIdx.x == 0 && tid == 0) { volatile unsigned long long* tp_ = (volatile unsigned long long*)E.probe_ptr(); tp_[1] = tp_[1] + (__builtin_amdgcn_s_memrealtime() - te0_); }
#endif
        if (!has_next) break;
#pragma unroll
        for (int a = 0; a < 2; ++a)
#pragma unroll
            for (int b = 0; b < 2; ++b)
#pragma unroll
                for (int m = 0; m < 4; ++m)
#pragma unroll
                    for (int n = 0; n < 2; ++n) acc[a][b][m][n] = (f32x4){0.f, 0.f, 0.f, 0.f};
        cur = nxt; cA = nA; cB = nB; ++ui;
        if constexpr (ALIGN_EPI) { if (wr == 1) PG8_BAR; }
    }
    PG8_WAIT_V(0);
    if constexpr (!ALIGN_EPI) { if (wr == 0) PG8_BAR; }
    PG8_BAR;
    if constexpr (Epi::AFTER_DRAIN) { E.fused(acc, cur, wr, wc, fr, fq, lds, wid, lane); S.done(cur); }
#undef PG8_SA
#undef PG8_SB
#undef PG8_STAGE
#undef PG8_LDA
#undef PG8_LDB
#undef PG8_MMA
#undef PG8_WAIT_V
#undef PG8_WAIT_L
#undef PG8_BAR
#undef PG8_SCHED
}
}
constexpr int NWAVES = 8;
constexpr int BATCH = 32, SEQ = 2048, D = 1024, M = BATCH * SEQ, FF = 2816, DEPTH = 4, NMOD = 9;
constexpr int GLA_IN = 3088, GLA_INP = 3328;
constexpr float EPS = 1e-6f;
constexpr size_t MiB = 1u << 20;
constexpr size_t WS_CTL = 0, CTL_ZERO_BYTES = 1 * MiB;
constexpr size_t WS_MOD = 2 * MiB;
constexpr size_t WS_LB = 6 * MiB + 512 * 1024;
constexpr size_t WS_SS = 7 * MiB;
constexpr size_t WS_W13 = 10 * MiB, W13_BYTES = (size_t)2 * FF * D * 2;
constexpr size_t WS_W2 = 98 * MiB, W2_BYTES = (size_t)D * FF * 2;
constexpr size_t WS_RGIN = 142 * MiB, RGIN_BYTES = (size_t)2048 * D * 2;
constexpr size_t WS_RGG = 150 * MiB, RGG_BYTES = (size_t)8 * 256 * 128 * 2;
constexpr size_t WS_RGOUT = 151 * MiB, SQ_BYTES = (size_t)D * D * 2;
constexpr size_t WS_HGIN = 155 * MiB;
constexpr size_t WS_HGOUT = 163 * MiB;
constexpr size_t WS_GLIN = 165 * MiB;
constexpr size_t WS_GLOUT = 172 * MiB;
constexpr size_t WS_H = 176 * MiB;
constexpr size_t WS_SCR = 304 * MiB;
constexpr size_t ACT_BYTES = (size_t)M * D * 2;
constexpr size_t WS_B2 = WS_SCR + 5 * ACT_BYTES;
constexpr size_t B2_BYTES = (size_t)32 * 5632 * 4;
constexpr size_t WS_PS = WS_B2 + 9 * MiB;
constexpr size_t WS_MODT = WS_PS + 4 * MiB;
constexpr size_t WS_END = WS_MODT + 5 * MiB;
static_assert(12 * B2_BYTES <= 9 * MiB, "bias2 fits");
static_assert(WS_W13 + 8 * W13_BYTES <= WS_W2 && WS_W2 + 8 * W2_BYTES <= WS_RGIN && WS_RGIN + 2 * RGIN_BYTES <= WS_RGG && WS_RGG + 2 * RGG_BYTES <= WS_RGOUT && WS_RGOUT + 2 * SQ_BYTES <= WS_HGIN, "ws map 1");
static_assert(WS_HGIN + 4 * SQ_BYTES <= WS_HGOUT && WS_HGOUT + SQ_BYTES <= WS_GLIN && WS_GLIN + (size_t)GLA_INP * D * 2 <= WS_GLOUT && WS_GLOUT + SQ_BYTES <= WS_H && WS_H + ACT_BYTES <= WS_SCR, "ws map 2");
static_assert((size_t)M * FF * 2 <= 5 * ACT_BYTES, "hid fits");
constexpr int CW_TMO = 0, CW_BAR = 4096;
constexpr int RING_BYTES = 131072, LDSCTL_OFF = RING_BYTES, MISC_OFF = LDSCTL_OFF + 320, LDS_BYTES = 147456;

#define GAS __attribute__((address_space(1)))
#define LAS __attribute__((address_space(3)))
typedef unsigned short bf16;
typedef unsigned v4u __attribute__((ext_vector_type(4)));
typedef unsigned v2u __attribute__((ext_vector_type(2)));
typedef float f32x4 __attribute__((ext_vector_type(4)));
typedef float f32x16 __attribute__((ext_vector_type(16)));
typedef short bf16x8 __attribute__((ext_vector_type(8)));
typedef GAS unsigned gu32;
#define RLX_AGENT __ATOMIC_RELAXED, __HIP_MEMORY_SCOPE_AGENT
#define LDS_WAIT() asm volatile("s_waitcnt lgkmcnt(0)" ::: "memory")
#define VM_WAIT() asm volatile("s_waitcnt vmcnt(0)" ::: "memory")
__device__ __forceinline__ unsigned pk2(float lo, float hi) { return pg8::cvt_pk_bf16(lo, hi); }
__device__ __forceinline__ unsigned f2bf(float f) { return pg8::cvt_pk_bf16(f, 0.f) & 0xffffu; }
__device__ __forceinline__ float bf2f(unsigned h) { return __builtin_bit_cast(float, h << 16); }
__device__ __forceinline__ float sigmoidf_(float x) { return 1.0f / (1.0f + expf(-x)); }

__device__ __forceinline__ int lane_id() { int l; asm volatile("v_mbcnt_lo_u32_b32 %0, -1, 0\n\tv_mbcnt_hi_u32_b32 %0, -1, %0" : "=v"(l)); return l; }
#define XB_TMO      128
#define XB_XCNT(j)  (256  + 64 * (j))
#define XB_XSUB(j)  (1280 + 64 * (j))
#define XB_XGEN(j)  (2304 + 64 * (j))
#define XB_TOP      3328
#define XB_TOPGEN   3392
#define XCD_BAR_WORDS 3456
#define XB_SPIN_CAP (1u << 18)

__device__ __forceinline__ unsigned xb_ld(unsigned* p)              { return __hip_atomic_load(p, __ATOMIC_RELAXED, __HIP_MEMORY_SCOPE_AGENT); }
__device__ __forceinline__ unsigned xb_add(unsigned* p, unsigned v) { return __hip_atomic_fetch_add(p, v, __ATOMIC_RELAXED, __HIP_MEMORY_SCOPE_AGENT); }
__device__ __forceinline__ unsigned xb_xcc_id() { return (unsigned)__builtin_amdgcn_s_getreg((3 << 11) | 20) & 0xFu; }
#define XB_SPIN(cond, bar) do { unsigned _sp = 0; while (cond) { __builtin_amdgcn_s_sleep(1); \
    if ((++_sp & 255u) == 0u) { if (xb_ld(&(bar)[XB_TMO])) break; if (_sp > XB_SPIN_CAP) { atomicAdd(&(bar)[XB_TMO], 1u); break; } } } } while (0)

struct XcdBarrier {
    unsigned* bar; unsigned x; int wave;
    volatile LAS unsigned* st;
};

__device__ __forceinline__ XcdBarrier xcd_barrier_post(unsigned* bar, volatile LAS unsigned* st) {
    XcdBarrier b; b.bar = bar; b.x = xb_xcc_id(); b.st = st;
    if (threadIdx.x == 0) (void)xb_add(&bar[XB_XCNT(b.x)], 1u);
    return b;
}
__device__ __forceinline__ void xcd_barrier_complete(unsigned* bar, unsigned x, unsigned& nloc, unsigned& nx) {
    const unsigned G = gridDim.x * gridDim.y * gridDim.z;
    unsigned sum, cnt, mine, sp = 0u;
    for (;;) {
        sum = 0u; cnt = 0u; mine = 0u;
#pragma unroll
        for (unsigned j = 0; j < 16; ++j) { const unsigned c = xb_ld(&bar[XB_XCNT(j)]); sum += c; cnt += (c > 0u) ? 1u : 0u; mine = (j == x) ? c : mine; }
        if (sum == G) break;
        __builtin_amdgcn_s_sleep(1);
        if ((++sp & 255u) == 0u) { if (xb_ld(&bar[XB_TMO])) break; if (sp > XB_SPIN_CAP) { atomicAdd(&bar[XB_TMO], 1u); break; } }
    }
    nloc = mine > 0u ? mine : 1u; nx = cnt > 0u ? cnt : 1u;
}

__device__ __forceinline__ void xcd_barrier(const XcdBarrier& b) {
    asm volatile("s_waitcnt vmcnt(0)" ::: "memory");
    __syncthreads();
    int xl_; asm volatile("v_mbcnt_lo_u32_b32 %0, -1, 0\n\tv_mbcnt_hi_u32_b32 %0, -1, %0" : "=v"(xl_));
    if (b.wave == 0 && xl_ == 0) {
        unsigned* bar = b.bar; unsigned bx_ = b.x; asm volatile("" : "+s"(bar), "+s"(bx_));
        __builtin_amdgcn_s_waitcnt(0);
        unsigned nloc = b.st[0], nx = b.st[1];
        if (nloc == 0u) { xcd_barrier_complete(bar, bx_, nloc, nx); b.st[0] = nloc; b.st[1] = nx; }
        const unsigned old = xb_add(&bar[XB_XSUB(bx_)], 1u);
        const unsigned gen = old / nloc;
        if (old + 1u == (gen + 1u) * nloc) {
            __builtin_amdgcn_fence(__ATOMIC_RELEASE, "agent");
            asm volatile("s_waitcnt vmcnt(0)" ::: "memory");
            const unsigned og = xb_add(&bar[XB_TOP], 1u);
            const unsigned tg = og / nx;
            if (og + 1u == (tg + 1u) * nx) xb_add(&bar[XB_TOPGEN], 1u);
            else XB_SPIN(xb_ld(&bar[XB_TOPGEN]) == tg, bar);
            __builtin_amdgcn_fence(__ATOMIC_ACQUIRE, "agent");
            xb_add(&bar[XB_XGEN(bx_)], 1u);
            asm volatile("s_waitcnt vmcnt(0)" ::: "memory");
        } else {
            XB_SPIN(xb_ld(&bar[XB_XGEN(bx_)]) == gen, bar);
            __builtin_amdgcn_fence(__ATOMIC_ACQUIRE, "agent");
            asm volatile("s_waitcnt vmcnt(0)" ::: "memory");
        }
    }
    __syncthreads();
}
struct Frame {
    LAS unsigned char* lds;
    volatile LAS unsigned* MISC;
    gu32* ctl;
    int wave, vcu, G;
};
__device__ __forceinline__ float wave_sum(float v) {
#pragma unroll
    for (int o = 1; o < 64; o <<= 1) v += __shfl_xor(v, o);
    return v;
}
__device__ __forceinline__ void conv_item(const float* W, int N, int k0, int n0, int nvalid, bf16* WT, int Kd, int drow0, LAS float* scr, int lane) {
    const bool ok = (lane & 31) < nvalid;
#pragma unroll 8
    for (int i = 0; i < 32; ++i) { const int kk = 2 * i + (lane >> 5); scr[kk * 33 + (lane & 31)] = ok ? W[(size_t)(k0 + kk) * N + n0 + (lane & 31)] : 0.f; }
    LDS_WAIT(); asm volatile("" ::: "memory");
    const int c = lane & 7;
#pragma unroll
    for (int j = 0; j < 4; ++j) { const int n = (lane >> 3) + 8 * j; const LAS float* s = scr + (8 * c) * 33 + n;
        v4u o; o.x = pk2(s[0 * 33], s[1 * 33]); o.y = pk2(s[2 * 33], s[3 * 33]); o.z = pk2(s[4 * 33], s[5 * 33]); o.w = pk2(s[6 * 33], s[7 * 33]);
        *(GAS v4u*)(WT + (size_t)(drow0 + n) * Kd + k0 + 8 * c) = o; }
    LDS_WAIT(); asm volatile("" ::: "memory");
}
struct ProIn { const float *c, *ada_w, *ada_b, *w13, *w2, *rg_w_in, *rg_gate_w, *rg_w_out, *hg_w_in, *hg_lb, *hg_w_out, *gla_w_in, *gla_w_out; };
__device__ __forceinline__ void p0_prologue(Frame& F, const ProIn& P, unsigned char* ws) {
    int lane_ = lane_id(); asm volatile("" : "+v"(lane_)); const int lane = lane_;
    int gw_ = F.wave * F.G + F.vcu; asm volatile("" : "+s"(gw_)); const int gw = gw_, NGW = F.G * NWAVES;
    float* MOD = (float*)(ws + WS_MOD); float* MODT = (float*)(ws + WS_MODT);
    { LAS float* CT = (LAS float*)F.lds;
        for (int idx = F.wave * 64 + lane; idx < BATCH * D; idx += NWAVES * 64) { const int b = idx >> 10, k = idx & 1023; const float cv = P.c[idx]; CT[k * 32 + (b ^ (k & 31))] = cv / (1.0f + expf(-cv)); }
        __syncthreads();
        for (int blk = gw; blk < DEPTH * NMOD * D / 32; blk += NGW) {
            const int n0 = blk * 32, l = n0 / (NMOD * D), nn = n0 % (NMOD * D);
            const float* Wp = P.ada_w + (size_t)l * D * (NMOD * D) + nn + (lane & 31) + (size_t)(lane >> 5) * (NMOD * D);
            f32x16 acc = {};
            for (int k0 = 0; k0 < D; k0 += 32) {
                float wv[16];
#pragma unroll
                for (int i = 0; i < 16; ++i) wv[i] = Wp[(size_t)(k0 + 2 * i) * (NMOD * D)];
#pragma unroll
                for (int i = 0; i < 16; ++i) { const int k = k0 + 2 * i + (lane >> 5); acc = __builtin_amdgcn_mfma_f32_32x32x2f32(CT[k * 32 + ((lane & 31) ^ (k & 31))], wv[i], acc, 0, 0, 0); }
            }
            const float bias = P.ada_b[(size_t)l * (NMOD * D) + nn + (lane & 31)];
#pragma unroll
            for (int r = 0; r < 16; ++r) { const int b = (r & 3) + 8 * (r >> 2) + 4 * (lane >> 5); MOD[((size_t)l * BATCH + b) * (NMOD * D) + nn + (lane & 31)] = acc[r] + bias; }
#pragma unroll
            for (int g4 = 0; g4 < 4; ++g4) *(f32x4*)(MODT + ((size_t)l * (NMOD * D) + nn + (lane & 31)) * 32 + 8 * g4 + 4 * (lane >> 5)) = (f32x4){acc[4 * g4] + bias, acc[4 * g4 + 1] + bias, acc[4 * g4 + 2] + bias, acc[4 * g4 + 3] + bias};
        }
        __syncthreads();
    }
    if (F.vcu == 0) { float* LB = (float*)(ws + WS_LB);
        for (int ch = F.wave * 64 + lane; ch < D; ch += NWAVES * 64) { const float g0 = P.hg_lb[ch], g1 = P.hg_lb[D + ch], g2 = P.hg_lb[2 * D + ch], g3 = P.hg_lb[3 * D + ch];
            const float mx = fmaxf(fmaxf(g0, g1), fmaxf(g2, g3)); const float e0 = expf(g0 - mx), e1 = expf(g1 - mx), e2 = expf(g2 - mx), e3 = expf(g3 - mx);
            LB[ch] = e1 / (e0 + e1 + e2 + e3); } }
    LAS float* scr = (LAS float*)(F.lds + F.wave * 16384);
    int gw2_ = F.vcu * NWAVES + F.wave; asm volatile("" : "+s"(gw2_)); const int gw2 = gw2_;
    constexpr int I_W13 = 16 * 176, I_W2 = 44 * 32, I_RGIN = 16 * 64, I_RGG = 2 * 8, I_SQ = 16 * 32, I_HGIN = 16 * 128, I_GLIN = 16 * (GLA_INP / 32);
    constexpr int T0 = 8 * I_W13, T1 = T0 + 8 * I_W2, T2 = T1 + 2 * I_RGIN, T3 = T2 + 16 * I_RGG, T4 = T3 + 2 * I_SQ, T5 = T4 + I_HGIN, T6 = T5 + I_SQ, T7 = T6 + I_GLIN, T8 = T7 + I_SQ;
    for (int it = gw2; it < T8; it += NGW) {
        int r = it;
        if (r < T0) { const int mi = r / I_W13, q = r % I_W13, kb = q / 176, nb = q % 176, n0 = nb * 32;
            const int drow = n0 < FF ? (n0 / 128) * 256 + (n0 % 128) : ((n0 - FF) / 128) * 256 + 128 + ((n0 - FF) % 128);
            conv_item(P.w13 + (size_t)mi * D * 2 * FF, 2 * FF, kb * 64, n0, 32, (bf16*)(ws + WS_W13 + mi * W13_BYTES), D, drow, scr, lane); continue; }
        r -= T0;
        if (r < 8 * I_W2) { const int mi = r / I_W2, q = r % I_W2, kb = q / 32, nb = q % 32;
            conv_item(P.w2 + (size_t)mi * FF * D, D, kb * 64, nb * 32, 32, (bf16*)(ws + WS_W2 + mi * W2_BYTES), FF, nb * 32, scr, lane); continue; }
        r -= 8 * I_W2;
        if (r < 2 * I_RGIN) { const int mi = r / I_RGIN, q = r % I_RGIN, kb = q / 64, nb = q % 64;
            conv_item(P.rg_w_in + (size_t)mi * D * 2048, 2048, kb * 64, nb * 32, 32, (bf16*)(ws + WS_RGIN + mi * RGIN_BYTES), D, nb * 32, scr, lane); continue; }
        r -= 2 * I_RGIN;
        if (r < 16 * I_RGG) { const int mi = r / I_RGG, q = r % I_RGG, kb = q / 8, nb = q % 8;
            conv_item(P.rg_gate_w + (size_t)mi * 128 * 256, 256, kb * 64, nb * 32, 32, (bf16*)(ws + WS_RGG) + (size_t)mi * 256 * 128, 128, nb * 32, scr, lane); continue; }
        r -= 16 * I_RGG;
        if (r < 2 * I_SQ) { const int mi = r / I_SQ, q = r % I_SQ, kb = q / 32, nb = q % 32;
            conv_item(P.rg_w_out + (size_t)mi * D * D, D, kb * 64, nb * 32, 32, (bf16*)(ws + WS_RGOUT + mi * SQ_BYTES), D, nb * 32, scr, lane); continue; }
        r -= 2 * I_SQ;
        if (r < I_HGIN) { const int kb = r / 128, nb = r % 128;
            conv_item(P.hg_w_in, 4096, kb * 64, nb * 32, 32, (bf16*)(ws + WS_HGIN), D, nb * 32, scr, lane); continue; }
        r -= I_HGIN;
        if (r < I_SQ) { const int kb = r / 32, nb = r % 32;
            conv_item(P.hg_w_out, D, kb * 64, nb * 32, 32, (bf16*)(ws + WS_HGOUT), D, nb * 32, scr, lane); continue; }
        r -= I_SQ;
        if (r < I_GLIN) { const int kb = r / (GLA_INP / 32), nb = r % (GLA_INP / 32), n0 = nb * 32; const int nv = GLA_IN - n0 < 0 ? 0 : (GLA_IN - n0 > 32 ? 32 : GLA_IN - n0);
            conv_item(P.gla_w_in, GLA_IN, kb * 64, nv > 0 ? n0 : 0, nv, (bf16*)(ws + WS_GLIN), D, n0, scr, lane); continue; }
        r -= I_GLIN;
        { const int kb = r / 32, nb = r % 32;
            conv_item(P.gla_w_out, D, kb * 64, nb * 32, 32, (bf16*)(ws + WS_GLOUT), D, nb * 32, scr, lane); }
    }
}
__device__ __forceinline__ void norm_phase(Frame& F, const float* x, const float* nw, const float* shift, const float* scale, bf16* H) {
    int lane_ = lane_id(); asm volatile("" : "+v"(lane_)); const int lane = lane_;
    int gw_ = F.vcu * NWAVES + F.wave; asm volatile("" : "+s"(gw_)); const int gw = gw_, NGW = F.G * NWAVES;
    for (int strip = gw; strip < M / 32; strip += NGW) {
        const int b = (strip * 32) / SEQ;
        f32x4 gv[4], sv[4];
#pragma unroll
        for (int j = 0; j < 4; ++j) { const int col = 4 * lane + 256 * j;
            gv[j] = *(const f32x4*)(nw + col) * (1.0f + *(const f32x4*)(scale + (size_t)b * (NMOD * D) + col)); sv[j] = *(const f32x4*)(shift + (size_t)b * (NMOD * D) + col); }
        for (int rr = 0; rr < 32; ++rr) { const size_t row = (size_t)strip * 32 + rr;
            const GAS f32x4* xr = (const GAS f32x4*)(x + row * D) + lane;
            f32x4 v[4]; float s = 0.f;
#pragma unroll
            for (int j = 0; j < 4; ++j) { v[j] = xr[64 * j]; s += (v[j].x * v[j].x + v[j].y * v[j].y) + (v[j].z * v[j].z + v[j].w * v[j].w); }
            const float rstd = 1.0f / sqrtf(wave_sum(s) * (1.f / D) + EPS);
            GAS v2u* o8 = (GAS v2u*)(H + row * D) + lane;
#pragma unroll
            for (int j = 0; j < 4; ++j) { const f32x4 o = v[j] * rstd * gv[j] + sv[j]; v2u w; w.x = pk2(o.x, o.y); w.y = pk2(o.z, o.w); o8[64 * j] = w; }
        }
    }
}

struct Pro2In { const float *x, *norm_w; };
__device__ __forceinline__ void p1_prologue(Frame& F, const Pro2In& P, unsigned char* ws) {
    int lane_ = lane_id(); asm volatile("" : "+v"(lane_)); const int lane = lane_;
    int gw_ = F.wave * F.G + F.vcu; asm volatile("" : "+s"(gw_)); const int gw = gw_, NGW = F.G * NWAVES;
    const float* MOD = (const float*)(ws + WS_MOD);
    constexpr int NB_FF = 176, NB_RG = 64, NB_HG = 128, NB_GL = GLA_INP / 32, NBT = 8 * NB_FF + 2 * NB_RG + NB_HG + NB_GL;
    for (int blk = gw; blk < NBT; blk += NGW) {
        int j, rb, pitch; const bf16* Bt; bool ffn = false;
        if (blk < 8 * NB_FF) { const int fi = blk / NB_FF; rb = blk % NB_FF; j = (fi >> 1) * 3 + (fi & 1) * 2; pitch = 5632; Bt = (const bf16*)(ws + WS_W13 + fi * W13_BYTES); ffn = true; }
        else if (blk < 8 * NB_FF + 2 * NB_RG) { const int r = blk - 8 * NB_FF, mi = r / NB_RG; rb = r % NB_RG; j = (mi * 3) * 3 + 1; pitch = 2048; Bt = (const bf16*)(ws + WS_RGIN + mi * RGIN_BYTES); }
        else if (blk < 8 * NB_FF + 2 * NB_RG + NB_HG) { rb = blk - 8 * NB_FF - 2 * NB_RG; j = 1 * 3 + 1; pitch = 4096; Bt = (const bf16*)(ws + WS_HGIN); }
        else { rb = blk - 8 * NB_FF - 2 * NB_RG - NB_HG; j = 2 * 3 + 1; pitch = GLA_INP; Bt = (const bf16*)(ws + WS_GLIN); }
        const int l = j / 3, s = j % 3, r = rb * 32 + (lane & 31);
        const bf16* Bp = Bt + (size_t)r * D + 8 * (lane >> 5);
        const float* Sp = MOD + ((size_t)l * BATCH + (lane & 31)) * (NMOD * D) + (3 * s) * D + 8 * (lane >> 5);
        f32x16 acc = {};
        for (int k0 = 0; k0 < D; k0 += 128) {
            bf16x8 bf[8]; f32x4 s0[8], s1[8];
#pragma unroll
            for (int i = 0; i < 8; ++i) { bf[i] = *(const bf16x8*)(Bp + k0 + 16 * i); s0[i] = *(const f32x4*)(Sp + k0 + 16 * i); s1[i] = *(const f32x4*)(Sp + k0 + 16 * i + 4); }
#pragma unroll
            for (int i = 0; i < 8; ++i) acc = __builtin_amdgcn_mfma_f32_32x32x16_bf16(__builtin_bit_cast(bf16x8, pg8::pack8(s0[i], s1[i])), bf[i], acc, 0, 0, 0);
        }
        const int w = r & 255, n = ffn ? ((w < 128) ? (r >> 8) * 128 + w : FF + (r >> 8) * 128 + (w - 128)) : r;
        float* B2 = (float*)(ws + WS_B2 + (size_t)j * B2_BYTES);
#pragma unroll
        for (int rr = 0; rr < 16; ++rr) { const int b = (rr & 3) + 8 * (rr >> 2) + 4 * (lane >> 5); B2[(size_t)b * pitch + n] = acc[rr]; }
    }
    const int gw2 = F.vcu * NWAVES + F.wave;
    bf16* H = (bf16*)(ws + WS_H); float* PS = (float*)(ws + WS_PS);
    for (int strip = gw2; strip < M / 32; strip += NGW) {
        const int b = (strip * 32) / SEQ;
        f32x4 gv[4];
#pragma unroll
        for (int jj = 0; jj < 4; ++jj) { const int col = 4 * lane + 256 * jj; gv[jj] = *(const f32x4*)(P.norm_w + col) * (1.0f + *(const f32x4*)(MOD + (size_t)b * (NMOD * D) + D + col)); }
        for (int rr = 0; rr < 32; ++rr) { const size_t row = (size_t)strip * 32 + rr;
            const GAS f32x4* xr = (const GAS f32x4*)(P.x + row * D) + lane;
            f32x4 v[4]; float sq = 0.f;
#pragma unroll
            for (int jj = 0; jj < 4; ++jj) { v[jj] = xr[64 * jj]; sq += (v[jj].x * v[jj].x + v[jj].y * v[jj].y) + (v[jj].z * v[jj].z + v[jj].w * v[jj].w); }
            sq = wave_sum(sq);
            GAS v2u* o8 = (GAS v2u*)(H + row * D) + lane;
#pragma unroll
            for (int jj = 0; jj < 4; ++jj) { const f32x4 o = v[jj] * gv[jj]; v2u w; w.x = pk2(o.x, o.y); w.y = pk2(o.z, o.w); o8[64 * jj] = w; }
            if (lane < 16) PS[row * 16 + lane] = lane == 0 ? sq : 0.f;
        }
    }
}
__device__ __forceinline__ void final_norm_phase(Frame& F, const float* x, const float* w, float* out) {
    int lane_ = lane_id(); asm volatile("" : "+v"(lane_)); const int lane = lane_;
    int gw_ = F.vcu * NWAVES + F.wave; asm volatile("" : "+s"(gw_)); const int gw = gw_, NGW = F.G * NWAVES;
    f32x4 gv[4];
#pragma unroll
    for (int j = 0; j < 4; ++j) gv[j] = *(const f32x4*)(w + 4 * lane + 256 * j);
    for (int strip = gw; strip < M / 32; strip += NGW) {
        for (int rr = 0; rr < 32; ++rr) { const size_t row = (size_t)strip * 32 + rr;
            const GAS f32x4* xr = (const GAS f32x4*)(x + row * D) + lane;
            f32x4 v[4]; float s = 0.f;
#pragma unroll
            for (int j = 0; j < 4; ++j) { v[j] = xr[64 * j]; s += (v[j].x * v[j].x + v[j].y * v[j].y) + (v[j].z * v[j].z + v[j].w * v[j].w); }
            const float rstd = 1.0f / sqrtf(wave_sum(s) * (1.f / D) + EPS);
            GAS f32x4* o = (GAS f32x4*)(out + row * D) + lane;
#pragma unroll
            for (int j = 0; j < 4; ++j) o[64 * j] = v[j] * rstd * gv[j];
        }
    }
}
#define MFMA16(a, b, c) __builtin_amdgcn_mfma_f32_16x16x32_bf16((a), (b), (c), 0, 0, 0)
__device__ __forceinline__ bf16x8 ld_b128(const LAS unsigned char* p) { return *(const LAS bf16x8*)p; }
__device__ __forceinline__ bf16x8 ld_2xb64(const LAS unsigned char* p0, const LAS unsigned char* p1) { const v2u a = *(const LAS v2u*)p0, b = *(const LAS v2u*)p1; v4u w; w.x = a.x; w.y = a.y; w.z = b.x; w.w = b.y; return __builtin_bit_cast(bf16x8, w); }
__device__ __forceinline__ bf16x8 pack8f(const f32x4 a, const f32x4 b) { return __builtin_bit_cast(bf16x8, pg8::pack8(a, b)); }
#define LOG2E 1.4426950408889634f
#define LN2 0.6931471805599453f
__device__ __forceinline__ float fexp2(float x) { return __builtin_amdgcn_exp2f(x); }
__device__ __forceinline__ float frcp(float x) { return __builtin_amdgcn_rcpf(x); }
__device__ __forceinline__ float fsigm(float x) { return frcp(1.0f + fexp2(-LOG2E * x)); }
#ifndef DBG_R4
#define DBG_R4 4
#endif
typedef __amdgpu_buffer_rsrc_t rsrc_t;
__device__ __forceinline__ rsrc_t mk_rsrc(const void* p) { return __builtin_amdgcn_make_buffer_rsrc((void*)p, 0, 0x7fffffff, 0x00020000); }
__device__ __forceinline__ float bld_bf(rsrc_t r, unsigned voff, unsigned soff) { const unsigned w = __builtin_amdgcn_raw_buffer_load_b32(r, voff & ~3u, soff, 0); return __builtin_bit_cast(float, (voff & 2u) ? (w & 0xffff0000u) : (w << 16)); }
__device__ __forceinline__ unsigned bld_raw(rsrc_t r, unsigned voff, unsigned soff) { return __builtin_amdgcn_raw_buffer_load_b32(r, voff & ~3u, soff, 0); }
__device__ __forceinline__ float half_bf(unsigned w, unsigned voff) { return __builtin_bit_cast(float, (voff & 2u) ? (w & 0xffff0000u) : (w << 16)); }
__device__ __forceinline__ unsigned half_u16(unsigned w, unsigned voff) { return (voff & 2u) ? (w >> 16) : (w & 0xffffu); }
__device__ __forceinline__ unsigned short bld_u16(rsrc_t r, unsigned voff, unsigned soff) { const unsigned w = __builtin_amdgcn_raw_buffer_load_b32(r, voff & ~3u, soff, 0); return (unsigned short)((voff & 2u) ? (w >> 16) : (w & 0xffffu)); }
__device__ __forceinline__ float bld_f32(rsrc_t r, unsigned voff, unsigned soff) { return __builtin_bit_cast(float, __builtin_amdgcn_raw_buffer_load_b32(r, voff, soff, 0)); }
__device__ __forceinline__ v4u bld_b128(rsrc_t r, unsigned voff, unsigned soff) { return __builtin_amdgcn_raw_buffer_load_b128(r, voff, soff, 0); }
struct RgArgs { const bf16* Y; const bf16* XB; bf16* HY; const bf16* WgT; const float *gate_b, *lam, *conv_w, *conv_b; };
#define LDS_BARRIER() do { asm volatile("s_waitcnt lgkmcnt(0)" ::: "memory"); __builtin_amdgcn_s_barrier(); asm volatile("" ::: "memory"); } while (0)
#define WAVE_SYNC() asm volatile("" ::: "memory")
__device__ __forceinline__ void rg_scan_phase(Frame& F, const RgArgs A) {
    LAS unsigned char* L = F.lds;
    int tid_ = F.wave * 64 + lane_id(); asm volatile("" : "+v"(tid_));
    const int tid = tid_, lane = tid & 63, wave = F.wave, q = lane >> 4, l15 = lane & 15;
    const int cch = tid & 127, tg = wave >> 1, chl = 16 * wave + l15;
    typedef float f32x2v __attribute__((ext_vector_type(2)));
    LAS f32x2v* AU = (LAS f32x2v*)(L + 50176 + wave * 4608);
    LAS f32x2v* PH = (LAS f32x2v*)(L + 50176 + wave * 4608 + 4096);
    for (int unit = blockIdx.x; unit < BATCH * 8; unit += gridDim.x) {
        const int b = unit >> 3, hd = unit & 7, colbase = hd * 128; const size_t rowbase = (size_t)b * SEQ;
        const bf16* Wg = A.WgT + (size_t)hd * 256 * 128;
        bf16x8 Bx[4], Ba[4];
#pragma unroll
        for (int s = 0; s < 4; ++s) { Bx[s] = *(const bf16x8*)(Wg + (size_t)chl * 128 + 32 * s + 8 * q); Ba[s] = *(const bf16x8*)(Wg + (size_t)(128 + chl) * 128 + 32 * s + 8 * q); }
        const float bx = A.gate_b[hd * 256 + chl], ba = A.gate_b[hd * 256 + 128 + chl];
        const float lamv = A.lam[colbase + chl]; const float sp8 = 8.0f * (fmaxf(-lamv, 0.f) + log1pf(expf(-fabsf(lamv))));
        const float cw0 = A.conv_w[colbase + cch], cw1 = A.conv_w[D + colbase + cch], cw2 = A.conv_w[2 * D + colbase + cch], cw3 = A.conv_w[3 * D + colbase + cch], cb = A.conv_b[colbase + cch];
        float h = 0.f;
        const rsrc_t rxb = mk_rsrc(A.XB + rowbase * D + colbase), ry = mk_rsrc(A.Y + rowbase * D + colbase), rhy = mk_rsrc(A.HY + rowbase * D + colbase);
        const unsigned vo = (unsigned)(8 * tg * D + cch) * 2u;
        const unsigned voy = (unsigned)(8 * q * D + chl) * 2u;
        unsigned xw[11], yw[8];
#pragma unroll
        for (int i = 0; i < 11; ++i) { const int t = 8 * tg - 3 + i; const unsigned w = bld_raw(rxb, (unsigned)cch * 2u, (unsigned)(t < 0 ? 0 : t) * 2048u); xw[i] = t >= 0 ? w : 0u; }
#pragma unroll
        for (int i = 0; i < 8; ++i) yw[i] = bld_raw(ry, voy, (unsigned)i * 2048u);
        for (int step = 0; step < SEQ / 32; ++step) {
            const int t0 = step * 32;
            LAS float* XC = (LAS float*)(L + (step & 1) * 25088); LAS unsigned char* XCB = L + (step & 1) * 25088 + 16384;
            float xb[11], yv[8];
#pragma unroll
            for (int i = 0; i < 11; ++i) xb[i] = half_bf(xw[i], (unsigned)cch * 2u);
#pragma unroll
            for (int i = 0; i < 8; ++i) yv[i] = half_bf(yw[i], voy);
#pragma unroll
            for (int i = 0; i < 8; ++i) { const float xc = cb + cw0 * xb[i] + cw1 * xb[i + 1] + cw2 * xb[i + 2] + cw3 * xb[i + 3];
                XC[(8 * tg + i) * 128 + cch] = xc; *(LAS unsigned short*)(XCB + (8 * tg + i) * 272 + cch * 2) = (unsigned short)f2bf(xc); }
            if (step + 1 < SEQ / 32) {
#pragma unroll
                for (int i = 0; i < 11; ++i) xw[i] = bld_raw(rxb, vo, (unsigned)(t0 + 32 - 3 + i) * 2048u);
#pragma unroll
                for (int i = 0; i < 8; ++i) yw[i] = bld_raw(ry, voy, (unsigned)(t0 + 32 + i) * 2048u);
            }
            LDS_BARRIER();
            f32x4 ax[2], aa[2];
#pragma unroll
            for (int tb = 0; tb < 2; ++tb) { ax[tb] = (f32x4){0.f, 0.f, 0.f, 0.f}; aa[tb] = (f32x4){0.f, 0.f, 0.f, 0.f};
#pragma unroll
                for (int s = 0; s < 4; ++s) { const bf16x8 a = ld_b128(XCB + (16 * tb + l15) * 272 + 64 * s + 16 * q); ax[tb] = MFMA16(a, Bx[s], ax[tb]); aa[tb] = MFMA16(a, Ba[s], aa[tb]); } }
#pragma unroll
            for (int tb = 0; tb < 2; ++tb)
#pragma unroll
                for (int r = 0; r < 4; ++r) { const int t = 16 * tb + 4 * q + r;
                    const float gx = ax[tb][r] + bx, ga = aa[tb][r] + ba;
                    const float la = -fsigm(ga) * sp8; const float a = fexp2(LOG2E * la);
                    const float x2 = 2.0f * la;
                    const float ser = -x2 * (1.0f + x2 * (0.5f + x2 * (0.16666667f + x2 * (0.041666668f + x2 * 0.008333334f))));
                    float m2 = x2 > -0.25f ? ser : 1.0f - a * a; float mult = __builtin_amdgcn_sqrtf(m2); if (t0 + t == 0) mult = 1.0f;
                    AU[t * 16 + l15] = (f32x2v){a, fsigm(gx) * XC[t * 128 + chl] * mult}; }
            WAVE_SYNC();
            float av[8], uv[8]; float P = 1.0f, Hl = 0.f;
#pragma unroll
            for (int i = 0; i < 8; ++i) { const f32x2v au = AU[(8 * q + i) * 16 + l15]; av[i] = au.x; uv[i] = au.y; Hl = av[i] * Hl + uv[i]; P *= av[i]; }
            PH[q * 16 + l15] = (f32x2v){P, Hl};
            WAVE_SYNC();
            { const f32x2v m0 = PH[l15], m1 = PH[16 + l15], m2_ = PH[32 + l15], m3 = PH[48 + l15];
                const float c1 = m0.x * h + m0.y, c2 = m1.x * c1 + m1.y, c3 = m2_.x * c2 + m2_.y, c4 = m3.x * c3 + m3.y;
                float hh = q == 0 ? h : (q == 1 ? c1 : (q == 2 ? c2 : c3)); h = c4;
#pragma unroll
                for (int i = 0; i < 8; ++i) { hh = av[i] * hh + uv[i]; __builtin_amdgcn_raw_buffer_store_b16((unsigned short)f2bf(hh * yv[i]), rhy, voy, (unsigned)(t0 + i) * 2048u, 0); } }
            WAVE_SYNC();
        }
        __syncthreads();
    }
}
struct GlaArgs { const bf16* Q; const bf16* K; const float* LOGF; const bf16* V; const bf16* G; const float* ALOW; const float *w2, *gb, *nw; bf16* OUT; float* SS; };
template <int DV, bool GLA>
__device__ __forceinline__ void gla_scan_phase(Frame& F, const GlaArgs A) {
    constexpr int NH = GLA ? 4 : 8, NCB = DV / 128, QLD = GLA ? 512 : 1024, NV = DV / 16, VTG = 512 / DV  , VTOK = 32 / VTG;
    LAS unsigned char* L = F.lds;
    LAS unsigned char* QT = L;
    LAS unsigned char* KT = L + 8704;
    LAS unsigned char* KHT = L + 17408;
    LAS unsigned char* VT = L + 27648;
    LAS float* DEC = (LAS float*)(L + 48128);
    LAS float* GT = (LAS float*)(L + 48640);
    LAS float* OB = (LAS float*)(L + 50688);
    LAS float* ALS = (LAS float*)(L + 83456);
    LAS float* NWL = (LAS float*)(L + 87552);
    int tid_ = F.wave * 64 + lane_id(); asm volatile("" : "+v"(tid_));
    const int tid = tid_, lane = tid & 63, wave = F.wave, q = lane >> 4, l15 = lane & 15;
    const int kc = tid & 127, tg = wave >> 1, vdv = tid & (DV - 1), vtg = wave / (DV / 64), ot = tid >> 4, oc = tid & 15;
    for (int unit = blockIdx.x; unit < BATCH * NH; unit += gridDim.x) {
        const int b = unit / NH, hd = unit % NH; const size_t rowbase = (size_t)b * SEQ;
        f32x4 S[NCB][8];
#pragma unroll
        for (int cb = 0; cb < NCB; ++cb)
#pragma unroll
            for (int kt = 0; kt < 8; ++kt) S[cb][kt] = (f32x4){0.f, 0.f, 0.f, 0.f};
        const rsrc_t rq = mk_rsrc(A.Q + rowbase * QLD + hd * 128), rk = mk_rsrc(GLA ? (const void*)(A.K + rowbase * QLD + hd * 128) : (const void*)(A.LOGF + rowbase * D + hd * 128));
        const rsrc_t rv = mk_rsrc(A.V + rowbase * D + hd * DV), rg = mk_rsrc(A.G + rowbase * D + hd * DV), ro = mk_rsrc(A.OUT + rowbase * D + hd * DV), ral = mk_rsrc(GLA ? A.ALOW + rowbase * 16 : nullptr);
        const unsigned voq = (unsigned)(8 * tg * QLD + kc) * 2u, vok = GLA ? voq : (unsigned)(8 * tg * D + kc) * 4u, vov = (unsigned)(VTOK * vtg * D + vdv) * 2u, vog = (unsigned)(ot * D + oc * NV) * 2u;
        constexpr unsigned QST = QLD * 2u, KST = GLA ? QLD * 2u : D * 4u, VST = D * 2u;
        float w2r[16]; float gbv = 0.f;
        if (GLA) {
#pragma unroll
            for (int r = 0; r < 16; ++r) w2r[r] = A.w2[r * 512 + hd * 128 + kc];
            gbv = A.gb[hd * 128 + kc]; }
        if (tid < DV) NWL[tid] = A.nw[(GLA ? 0 : hd * 128) + tid];
        unsigned qw[8], kw[8], vw[VTOK]; float alv = 0.f; v4u gg[NV / 8], ggn[NV / 8];
#pragma unroll
        for (int i = 0; i < 8; ++i) { qw[i] = bld_raw(rq, voq, (unsigned)i * QST); kw[i] = bld_raw(rk, vok, (unsigned)i * KST); }
#pragma unroll
        for (int i = 0; i < VTOK; ++i) vw[i] = bld_raw(rv, vov, (unsigned)i * VST);
#pragma unroll
        for (int e = 0; e < NV / 8; ++e) gg[e] = bld_b128(rg, vog + 16u * e, 0u);
        if (GLA) { ALS[tid] = bld_f32(ral, (unsigned)tid * 4u, 0u); alv = bld_f32(ral, (unsigned)tid * 4u, 32u * 64u); }
        __syncthreads();
        for (int n = 0; n < SEQ / 32; ++n) {
            const unsigned r0 = (unsigned)n * 32u;
            float qv[8], kv[8]; unsigned vv[VTOK];
#pragma unroll
            for (int i = 0; i < 8; ++i) { qv[i] = half_bf(qw[i], voq); kv[i] = GLA ? half_bf(kw[i], vok) : __builtin_bit_cast(float, kw[i]); }
#pragma unroll
            for (int i = 0; i < VTOK; ++i) vv[i] = half_u16(vw[i], vov);
            if (n + 1 < SEQ / 32) { const unsigned rn = r0 + 32u;
#pragma unroll
                for (int i = 0; i < 8; ++i) { qw[i] = bld_raw(rq, voq, (rn + i) * QST); kw[i] = bld_raw(rk, vok, (rn + i) * KST); }
#pragma unroll
                for (int i = 0; i < VTOK; ++i) vw[i] = bld_raw(rv, vov, (rn + i) * VST);
#pragma unroll
                for (int e = 0; e < NV / 8; ++e) ggn[e] = bld_b128(rg, vog + 16u * e, rn * VST); }
            float bl[8], kt_[8];
            { float c = 0.f;
#pragma unroll
                for (int i = 0; i < 8; ++i) { float g2;
                    if (GLA) { const LAS float* al = ALS + (n & 1) * 512 + (8 * tg + i) * 16; float z = gbv;
#pragma unroll
                        for (int r4 = 0; r4 < 4; ++r4) { const f32x4 a4 = *(const LAS f32x4*)(al + 4 * r4); z += a4[0] * w2r[4 * r4] + a4[1] * w2r[4 * r4 + 1] + a4[2] * w2r[4 * r4 + 2] + a4[3] * w2r[4 * r4 + 3]; }
                        g2 = (fminf(z, 0.f) * LOG2E - __builtin_amdgcn_logf(1.0f + fexp2(-LOG2E * fabsf(z)))) * (1.0f / 16.0f); kt_[i] = kv[i]; }
                    else { g2 = kv[i] * LOG2E; kt_[i] = 1.0f - fexp2(g2); }
                    c += g2; bl[i] = c; }
                GT[tg * 128 + kc] = c; }
            LDS_BARRIER();
            { const float g0 = GT[kc], g1 = GT[128 + kc], g2 = GT[256 + kc], g3 = GT[384 + kc];
                const float off = (tg > 0 ? g0 : 0.f) + (tg > 1 ? g1 : 0.f) + (tg > 2 ? g2 : 0.f), tot = (g0 + g1) + (g2 + g3);
                const float qs = GLA ? 0.08838834764831845f : 1.0f, etot = fexp2(tot);
                float kh[8];
#pragma unroll
                for (int i = 0; i < 8; ++i) { const float bb = bl[i] + off; const int t = 8 * tg + i; const float e1 = fexp2(bb), e2 = frcp(e1);
                    *(LAS unsigned short*)(QT + t * 272 + kc * 2) = (unsigned short)f2bf(qv[i] * qs * e1);
                    const float k2 = kt_[i] * e2;
                    *(LAS unsigned short*)(KT + t * 272 + kc * 2) = (unsigned short)f2bf(k2);
                    kh[i] = k2 * etot; }
                v4u w; w.x = pk2(kh[0], kh[1]); w.y = pk2(kh[2], kh[3]); w.z = pk2(kh[4], kh[5]); w.w = pk2(kh[6], kh[7]);
                *(LAS v4u*)(KHT + kc * 80 + 16 * tg) = w;
                if (tg == 0) DEC[kc] = etot; }
#pragma unroll
            for (int i8 = 0; i8 < VTOK / 8; ++i8) { v4u w; w.x = vv[8 * i8] | (vv[8 * i8 + 1] << 16); w.y = vv[8 * i8 + 2] | (vv[8 * i8 + 3] << 16); w.z = vv[8 * i8 + 4] | (vv[8 * i8 + 5] << 16); w.w = vv[8 * i8 + 6] | (vv[8 * i8 + 7] << 16);
                *(LAS v4u*)(VT + vdv * 80 + (VTOK * vtg + 8 * i8) * 2) = w; }
            LDS_BARRIER();
            if (GLA) { ALS[((n + 1) & 1) * 512 + tid] = alv; if (n + 2 < SEQ / 32) alv = bld_f32(ral, (unsigned)tid * 4u, (r0 + 64u) * 64u); }
            f32x4 P00 = {0.f, 0.f, 0.f, 0.f}, P01 = P00, P11 = P00;
#pragma unroll
            for (int s = 0; s < 4; ++s) { const bf16x8 KA0 = ld_b128(KT + l15 * 272 + 64 * s + 16 * q), KA1 = ld_b128(KT + (16 + l15) * 272 + 64 * s + 16 * q);
                const bf16x8 QB0 = ld_b128(QT + l15 * 272 + 64 * s + 16 * q), QB1 = ld_b128(QT + (16 + l15) * 272 + 64 * s + 16 * q);
                P00 = MFMA16(KA0, QB0, P00); P01 = MFMA16(KA0, QB1, P01); P11 = MFMA16(KA1, QB1, P11); }
#pragma unroll
            for (int r = 0; r < 4; ++r) if (l15 < 4 * q + r) { P00[r] = 0.f; P11[r] = 0.f; }
            const bf16x8 PA0 = pack8f(P00, (f32x4){0.f, 0.f, 0.f, 0.f}), PA1 = pack8f(P01, P11);
            bf16x8 VB[NCB];
#pragma unroll
            for (int cb = 0; cb < NCB; ++cb) { const LAS unsigned char* vr = VT + (16 * (wave * NCB + cb) + l15) * 80 + 8 * q; VB[cb] = ld_2xb64(vr, vr + 32); }
            f32x4 O[NCB][2];
#pragma unroll
            for (int cb = 0; cb < NCB; ++cb)
#pragma unroll
                for (int tb = 0; tb < 2; ++tb) O[cb][tb] = (f32x4){0.f, 0.f, 0.f, 0.f};
#pragma unroll
            for (int s = 0; s < 4; ++s) {
                bf16x8 QA[2];
#pragma unroll
                for (int tb = 0; tb < 2; ++tb) { const LAS unsigned char* qr = QT + (16 * tb + l15) * 272 + 64 * s + 8 * q; QA[tb] = ld_2xb64(qr, qr + 32); }
#pragma unroll
                for (int cb = 0; cb < NCB; ++cb) { const bf16x8 SB = pack8f(S[cb][2 * s], S[cb][2 * s + 1]);
                    O[cb][0] = MFMA16(QA[0], SB, O[cb][0]); O[cb][1] = MFMA16(QA[1], SB, O[cb][1]); } }
#pragma unroll
            for (int cb = 0; cb < NCB; ++cb) { O[cb][0] = MFMA16(PA0, VB[cb], O[cb][0]); O[cb][1] = MFMA16(PA1, VB[cb], O[cb][1]); }
#pragma unroll
            for (int kt = 0; kt < 8; ++kt) { const f32x4 dec = *(const LAS f32x4*)(DEC + 16 * kt + 4 * q);
                const LAS unsigned char* kr = KHT + (16 * kt + l15) * 80 + 8 * q; const bf16x8 KH = ld_2xb64(kr, kr + 32);
#pragma unroll
                for (int cb = 0; cb < NCB; ++cb) S[cb][kt] = MFMA16(KH, VB[cb], S[cb][kt] * dec); }
#pragma unroll
            for (int cb = 0; cb < NCB; ++cb)
#pragma unroll
                for (int tb = 0; tb < 2; ++tb)
#pragma unroll
                    for (int r = 0; r < 4; ++r) OB[(16 * tb + 4 * q + r) * DV + 16 * (wave * NCB + cb) + l15] = O[cb][tb][r];
#ifdef DBG_TRIVIAL
#pragma unroll
            for (int cb = 0; cb < NCB; ++cb)
#pragma unroll
                for (int tb = 0; tb < 2; ++tb)
#pragma unroll
                    for (int r = 0; r < 4; ++r) { const int t = 16 * tb + 4 * q + r, dv = 16 * (wave * NCB + cb) + l15;
                        float vsum = 0.f; if (DBG_TRIVIAL & 1) vsum += bf2f(*(const LAS unsigned short*)(VT + dv * 80 + t * 2)); if (DBG_TRIVIAL & 2) vsum += bf2f(*(const LAS unsigned short*)(QT + t * 272 + (dv & 127) * 2)); if (DBG_TRIVIAL & 4) vsum += bf2f(*(const LAS unsigned short*)(KHT + (dv & 127) * 80 + t * 2)); if (DBG_TRIVIAL & 8) vsum += 1.0f + 0.001f * (float)(t + dv);
                        OB[t * DV + dv] = vsum; }
#endif
            LDS_BARRIER();
            { float o[NV]; float ss = 0.f;
#pragma unroll
                for (int e4 = 0; e4 < NV / 4; ++e4) { const f32x4 v = *(const LAS f32x4*)(OB + ot * DV + oc * NV + 4 * e4); o[4 * e4] = v[0]; o[4 * e4 + 1] = v[1]; o[4 * e4 + 2] = v[2]; o[4 * e4 + 3] = v[3]; ss += (v[0] * v[0] + v[1] * v[1]) + (v[2] * v[2] + v[3] * v[3]); }
                ss += __shfl_xor(ss, 1); ss += __shfl_xor(ss, 2); ss += __shfl_xor(ss, 4); ss += __shfl_xor(ss, 8);
                float rs = 1.0f;
                if (GLA) rs = 1.0f / sqrtf(ss * (1.0f / DV) + EPS); else if (oc == 0) A.SS[(rowbase + r0 + ot) * 8 + hd] = ss;
#pragma unroll
                for (int e8 = 0; e8 < NV / 8; ++e8) { const v4u gw_ = gg[e8]; float gf[8]; float nwr[NV];
                    { const f32x4 n0 = *(const LAS f32x4*)(NWL + oc * NV + 8 * e8), n1 = *(const LAS f32x4*)(NWL + oc * NV + 8 * e8 + 4); nwr[8 * e8] = n0[0]; nwr[8 * e8 + 1] = n0[1]; nwr[8 * e8 + 2] = n0[2]; nwr[8 * e8 + 3] = n0[3]; nwr[8 * e8 + 4] = n1[0]; nwr[8 * e8 + 5] = n1[1]; nwr[8 * e8 + 6] = n1[2]; nwr[8 * e8 + 7] = n1[3]; }
                    gf[0] = bf2f(gw_.x & 0xffffu); gf[1] = bf2f(gw_.x >> 16); gf[2] = bf2f(gw_.y & 0xffffu); gf[3] = bf2f(gw_.y >> 16); gf[4] = bf2f(gw_.z & 0xffffu); gf[5] = bf2f(gw_.z >> 16); gf[6] = bf2f(gw_.w & 0xffffu); gf[7] = bf2f(gw_.w >> 16);
                    v4u w; w.x = pk2(o[8 * e8] * rs * nwr[8 * e8] * gf[0], o[8 * e8 + 1] * rs * nwr[8 * e8 + 1] * gf[1]); w.y = pk2(o[8 * e8 + 2] * rs * nwr[8 * e8 + 2] * gf[2], o[8 * e8 + 3] * rs * nwr[8 * e8 + 3] * gf[3]);
                    w.z = pk2(o[8 * e8 + 4] * rs * nwr[8 * e8 + 4] * gf[4], o[8 * e8 + 5] * rs * nwr[8 * e8 + 5] * gf[5]); w.w = pk2(o[8 * e8 + 6] * rs * nwr[8 * e8 + 6] * gf[6], o[8 * e8 + 7] * rs * nwr[8 * e8 + 7] * gf[7]);
                    __builtin_amdgcn_raw_buffer_store_b128(w, ro, vog + 16u * e8, r0 * VST, 0); gg[e8] = ggn[e8]; } }
        }
        __syncthreads();
    }
}
constexpr int NPH = 2 + DEPTH * 7 + 1;
struct Args { const float* in[24]; float* out; unsigned char* ws; int ph_lo, ph_hi; };
#define AS4 __attribute__((address_space(4)))
#define KARG() ({ const AS4 Args* _p = (const AS4 Args*)__builtin_amdgcn_kernarg_segment_ptr(); asm volatile("" : "+s"(_p)); _p; })
#define KIN(i) ((const float*)KARG()->in[i])
#define KWS() ((unsigned char*)KARG()->ws)
__global__ void __launch_bounds__(NWAVES * 64, 2) mk_fwd(Args args_unused) {
    extern __shared__ __attribute__((aligned(16))) unsigned char lds[];
    Frame F;
    F.lds = (LAS unsigned char*)lds;
    F.MISC = (volatile LAS unsigned*)(F.lds + MISC_OFF);
    F.wave = __builtin_amdgcn_readfirstlane((int)threadIdx.x >> 6);
    F.G = gridDim.x; { const int bx = blockIdx.x; F.vcu = (F.G % 8 == 0) ? (bx % 8) * (F.G / 8) + bx / 8 : bx; }
    F.ctl = (gu32*)(KWS() + WS_CTL);
    for (int u = threadIdx.x; u < (LDS_BYTES - LDSCTL_OFF) / 4; u += NWAVES * 64) ((LAS unsigned*)(F.lds + LDSCTL_OFF))[u] = 0u;
    __syncthreads();
    XcdBarrier bar = xcd_barrier_post((unsigned*)(F.ctl + CW_BAR), F.MISC + 8); bar.wave = F.wave;
#ifdef PROBE_CLK
#define PB(kind) do { if ((kind) == PROBE_CLK && blockIdx.x == 0 && F.wave == 0 && lane_id() == 0) { volatile unsigned long long* tp_ = (volatile unsigned long long*)(KWS() + 512 * 1024); tp_[0] = __builtin_amdgcn_s_memrealtime(); tp_[2] = __builtin_amdgcn_s_memtime(); } } while (0)
#define PE(kind) do { if ((kind) == PROBE_CLK && blockIdx.x == 0 && F.wave == 0 && lane_id() == 0) { volatile unsigned long long* tp_ = (volatile unsigned long long*)(KWS() + 512 * 1024); tp_[3] = tp_[3] + (__builtin_amdgcn_s_memtime() - tp_[2]); tp_[4] = tp_[4] + (__builtin_amdgcn_s_memrealtime() - tp_[0]); tp_[1] = 100ull * 100ull * tp_[3] / tp_[4]; } } while (0)
#define PROBE_MUL 1
#elif defined(PROBE_KIND)
#define PB(kind) do { if (((1 << (kind)) & PROBE_KIND) && blockIdx.x == 0 && F.wave == 0 && lane_id() == 0) { volatile unsigned long long* tp_ = (volatile unsigned long long*)(KWS() + 512 * 1024); tp_[0] = __builtin_amdgcn_s_memrealtime(); } } while (0)
#define PE(kind) do { if (((1 << (kind)) & PROBE_KIND) && blockIdx.x == 0 && F.wave == 0 && lane_id() == 0) { volatile unsigned long long* tp_ = (volatile unsigned long long*)(KWS() + 512 * 1024); tp_[1] = tp_[1] + (__builtin_amdgcn_s_memrealtime() - tp_[0]); } } while (0)
#else
#define PB(kind) do {} while (0)
#define PE(kind) do {} while (0)
#endif
#if MK_N_LAUNCHES == 1
#define RUN() true
#define SEAM() xcd_barrier(bar)
#else
    int pi = 0;
#define RUN() (KARG()->ph_lo == pi)
#define SEAM() (++pi)
#endif
    PB(0);
    if (RUN()) { const AS4 Args* a = KARG(); ProIn P{a->in[1], a->in[2], a->in[3], a->in[6], a->in[7], a->in[8], a->in[11], a->in[14], a->in[15], a->in[16], a->in[18], a->in[19], a->in[23]};
        p0_prologue(F, P, KWS()); }
    SEAM(); PE(0); PB(10);
    if (RUN()) { const AS4 Args* a = KARG(); Pro2In P{a->in[0], a->in[4]};
        p1_prologue(F, P, KWS()); }
    SEAM(); PE(10);
    for (int l = 0; l < DEPTH; ++l) {
        for (int s = 0; s < 3; ++s) {
            PB(s != 1 ? 2 : 4);
            if (RUN()) { unsigned char* ws = KWS(); unsigned char* SCR = ws + WS_SCR; const int mx = l % 3, mi = l / 3;
                const size_t ainoff = s == 2 ? WS_SCR : WS_H; const bf16* Ain = (const bf16*)(ws + ainoff);
                const pg8::RowScale R{(const float*)(ws + WS_PS), (LAS float*)(F.lds + LDSCTL_OFF + 2048)}; const float* b2 = (const float*)(ws + WS_B2 + (size_t)(l * 3 + s) * B2_BYTES);
                if (s != 1) { const int fi = l * 2 + (s >> 1);
                    pg8::Gemm g{Ain, (const bf16*)(ws + WS_W13 + fi * W13_BYTES), M, 2 * FF, D}; pg8::StaticOrder S; S.init(M, 2 * FF, F.G, (int)blockIdx.x);
                    pg8::EpiSwiglu E{ws, (bf16*)(SCR + ACT_BYTES), FF, R, b2};
                    pg8::gemm_phase<pg8::EpiSwiglu, pg8::StaticOrder, true, true>(F.lds, g, S, E, F.wave);
                }
                else if (mx == 0) {
                    pg8::Gemm g{Ain, (const bf16*)(ws + WS_RGIN + mi * RGIN_BYTES), M, 2048, D}; pg8::StaticOrder S; S.init(M, 2048, F.G, (int)blockIdx.x);
                    pg8::EpiRgIn E{ws, (bf16*)SCR, R, b2};
                    pg8::gemm_phase<pg8::EpiRgIn, pg8::StaticOrder, true, true>(F.lds, g, S, E, F.wave);
                } else if (mx == 1) {
                    pg8::Gemm g{Ain, (const bf16*)(ws + WS_HGIN), M, 4096, D}; pg8::StaticOrder S; S.init(M, 4096, F.G, (int)blockIdx.x);
                    pg8::EpiHgIn E{ws, (bf16*)SCR, (float*)(SCR + 3 * ACT_BYTES), (const float*)(ws + WS_LB), R, b2};
                    pg8::gemm_phase<pg8::EpiHgIn, pg8::StaticOrder, true, true>(F.lds, g, S, E, F.wave);
                } else {
                    pg8::Gemm g{Ain, (const bf16*)(ws + WS_GLIN), M, GLA_INP, D}; pg8::StaticOrder S; S.init(M, GLA_INP, F.G, (int)blockIdx.x);
                    pg8::EpiGlIn E{ws, (bf16*)SCR, (float*)(SCR + 3 * ACT_BYTES), R, b2};
                    pg8::gemm_phase<pg8::EpiGlIn, pg8::StaticOrder, true, true>(F.lds, g, S, E, F.wave);
                }
            }
            SEAM(); PE(s != 1 ? 2 : 4);
            if (s == 1) {
                PB(5 + l % 3);
                if (RUN()) {
                    unsigned char* ws = KWS(); bf16* H = (bf16*)(ws + WS_H); unsigned char* SCR = ws + WS_SCR; const int mx = l % 3, mi = l / 3;
                    if (mx == 0) { RgArgs A{(const bf16*)SCR, (const bf16*)(SCR + ACT_BYTES), H, (const bf16*)(ws + WS_RGG + mi * RGG_BYTES), KIN(12) + (size_t)mi * 8 * 256, KIN(13) + (size_t)mi * D, KIN(9) + (size_t)mi * 4 * D, KIN(10) + (size_t)mi * D};
                        rg_scan_phase(F, A); }
                    else if (mx == 1) { GlaArgs A{(const bf16*)SCR, nullptr, (const float*)(SCR + 3 * ACT_BYTES), (const bf16*)(SCR + ACT_BYTES), (const bf16*)(SCR + 2 * ACT_BYTES), nullptr, nullptr, nullptr, KIN(17), H, (float*)(ws + WS_SS)};
                        gla_scan_phase<128, false>(F, A); }
                    else { GlaArgs A{(const bf16*)SCR, (const bf16*)(SCR + ACT_BYTES / 2), nullptr, (const bf16*)(SCR + ACT_BYTES), (const bf16*)(SCR + 2 * ACT_BYTES), (const float*)(SCR + 3 * ACT_BYTES), KIN(20), KIN(21), KIN(22), H, nullptr};
                        gla_scan_phase<256, true>(F, A); }
                }
                SEAM(); PE(5 + l % 3);
            }
            PB(s != 1 ? 3 : 8);
            if (RUN()) { unsigned char* ws = KWS(); const int mx = l % 3, mi = l / 3;
                const float* xcur = (l == 0 && s == 0) ? KIN(0) : (const float*)KARG()->out;
                const float* modl = (const float*)(ws + WS_MOD) + (size_t)l * BATCH * (NMOD * D);
                const bf16* Ap; const bf16* Bp; int K; float fac; const float* ssp = nullptr;
                if (s != 1) { Ap = (const bf16*)(ws + WS_SCR + ACT_BYTES); Bp = (const bf16*)(ws + WS_W2 + (l * 2 + (s >> 1)) * W2_BYTES); K = FF; fac = 0.5f; }
                else { Ap = (const bf16*)(ws + WS_H); K = D; fac = 1.0f;
                    if (mx == 0) Bp = (const bf16*)(ws + WS_RGOUT + mi * SQ_BYTES); else if (mx == 1) { Bp = (const bf16*)(ws + WS_HGOUT); ssp = (const float*)(ws + WS_SS); } else Bp = (const bf16*)(ws + WS_GLOUT); }
                const bool last = (l == DEPTH - 1 && s == 2); const int ln = s == 2 ? l + 1 : l, sn = s == 2 ? 0 : s + 1;
                const size_t anoff = s == 1 ? WS_SCR : WS_H; bf16* An = (bf16*)(ws + anoff); if (last) An = nullptr;
                const float* nwn = KIN(4) + ((size_t)(last ? 0 : ln) * 3 + sn) * D;
                const float* scn = (const float*)(ws + WS_MOD) + (size_t)(last ? 0 : ln) * BATCH * (NMOD * D) + (3 * sn + 1) * D;
                pg8::Gemm g{Ap, Bp, M, D, K}; pg8::StaticOrder S; S.init(M, D, F.G, (int)blockIdx.x);
                { LAS pg8::EpiResidParams* pp = (LAS pg8::EpiResidParams*)(F.lds + LDSCTL_OFF + 1024);
                  int cs_ = NMOD * D; asm volatile("" : "+s"(ssp), "+s"(An), "+s"(nwn), "+s"(scn), "+s"(xcur), "+s"(cs_), "+s"(fac));
                  if (F.wave == 0 && lane_id() == 0) { pp->base = xcur; pp->out = KARG()->out; pp->coef = modl + (3 * s + 2) * D; pp->ss = ssp; pp->An = An; pp->nwn = nwn; pp->scn = scn; pp->PS = (float*)(ws + WS_PS); pp->cstride = cs_; pp->fac = fac; }
                  __syncthreads(); }
                pg8::EpiResid E{ws, (const LAS unsigned*)(F.lds + LDSCTL_OFF + 1024), (LAS float*)(F.lds + LDSCTL_OFF + 4096)};
                pg8::gemm_phase<pg8::EpiResid, pg8::StaticOrder, true, true>(F.lds, g, S, E, F.wave);
            }
            SEAM(); PE(s != 1 ? 3 : 8);
        }
    }
    PB(9);
    if (RUN()) { float* xo = KARG()->out; final_norm_phase(F, xo, KIN(5), xo); }
    PE(9);
#if defined(PROBE_KIND) || defined(PROBE_EPI) || defined(PROBE_CLK)
    if (blockIdx.x == 0 && F.wave == 0 && lane_id() == 0) { volatile unsigned long long* tp_ = (volatile unsigned long long*)(KWS() + 512 * 1024); const unsigned long long want = tp_[1] * PROBE_MUL, t0_ = __builtin_amdgcn_s_memrealtime();
        while (__builtin_amdgcn_s_memrealtime() - t0_ < want) __builtin_amdgcn_s_sleep(8); }
#endif
#undef RUN
#undef SEAM
}

extern "C" void kernel_launch(void* const* d_in, const int* in_sizes, int n_in, void* d_out, int out_size, void* d_ws, size_t ws_size, hipStream_t stream) {
    static int grid = 0;
    if (grid == 0) {
        if (n_in != 24 || in_sizes[0] != M * D || out_size != M * D || ws_size < WS_END) { fprintf(stderr, "kernel_launch: unexpected shapes (n_in %d, in0 %d, out %d, ws %zu < %zu); nothing launched\n", n_in, n_in > 0 ? in_sizes[0] : -1, out_size, ws_size, (size_t)WS_END); grid = -1; return; }
        int dev = 0, cus = 0, per_cu = 0;
        if (hipGetDevice(&dev) != hipSuccess || hipDeviceGetAttribute(&cus, hipDeviceAttributeMultiprocessorCount, dev) != hipSuccess) { grid = -1; return; }
        if (hipFuncSetAttribute((const void*)mk_fwd, hipFuncAttributeMaxDynamicSharedMemorySize, LDS_BYTES) != hipSuccess) { fprintf(stderr, "kernel_launch: hipFuncSetAttribute failed\n"); grid = -1; return; }
        if (hipOccupancyMaxActiveBlocksPerMultiprocessor(&per_cu, (const void*)mk_fwd, NWAVES * 64, LDS_BYTES) != hipSuccess || per_cu < 1)
            fprintf(stderr, "kernel_launch: note: occupancy query reports %d workgroups per CU\n", per_cu);
        (void)hipGetLastError();
        grid = cus;
    }
    if (grid < 0) return;
    if (hipMemsetAsync((char*)d_ws + WS_CTL, 0, CTL_ZERO_BYTES, stream) != hipSuccess) return;
    Args a{};
    for (int i = 0; i < 24; ++i) a.in[i] = (const float*)d_in[i];
    a.out = (float*)d_out; a.ws = (unsigned char*)d_ws;
#if MK_N_LAUNCHES == 1
    a.ph_lo = 0; a.ph_hi = NPH;
    hipLaunchKernelGGL(mk_fwd, dim3(grid), dim3(NWAVES * 64), LDS_BYTES, stream, a);
#else
    for (int p = 0; p < NPH; ++p) { a.ph_lo = p; a.ph_hi = p + 1; hipLaunchKernelGGL(mk_fwd, dim3(grid), dim3(NWAVES * 64), LDS_BYTES, stream, a); }
#endif
}
```

```cpp
#include <hip/hip_runtime.h>
#include <cstdio>
#include <cstdint>
#include <cmath>
#ifndef MK_N_LAUNCHES
#define MK_N_LAUNCHES 1
#endif
namespace pg8 {
#define PG8_LAS __attribute__((address_space(3)))
typedef unsigned short bf16_t;
typedef short bf16x8 __attribute__((ext_vector_type(8)));
typedef float f32x4 __attribute__((ext_vector_type(4)));
typedef unsigned u32x4 __attribute__((ext_vector_type(4)));
constexpr int BM = 256, BK = 64, HALF = 128, HTB = HALF * BK * 2  , STAGE_BYTES = 8 * HTB, NXCD = 8, WGM = 8;

__host__ __device__ __forceinline__ int lds_byte(int r, int c) { const int st = (r >> 4) * 2 + (c >> 5), rr = r & 15, cc = c & 31, ob = rr * 64 + cc * 2; return st * 1024 + (ob ^ (((ob >> 9) & 1) << 5)); }
__host__ __device__ __forceinline__ void stage_rc(int b, int& R, int& C) { const int st = b / 1024, sb = b % 1024, swz = sb ^ (((sb >> 9) & 1) << 5); R = (st >> 1) * 16 + swz / 64; C = (st & 1) * 32 + (swz % 64) / 2; }
__host__ __device__ __forceinline__ int perm32(int rho) { const int n = rho >> 4, i = rho & 15; return 8 * (i >> 2) + 4 * n + (i & 3); }

struct Unit { int pm, pn; };
struct Gemm { const bf16_t* A; const bf16_t* Bt; int M, N, K; };

struct StaticOrder {
    int nM, nN, nwg, G, c, rev;
    __host__ __device__ void init(int M, int N, int G_, int c_, int rev_ = 0) { nM = M / BM; nN = N / BM; nwg = nM * nN; G = G_; c = c_; rev = rev_; }
    __host__ __device__ bool next(int i, Unit& u) const {
        const int L = i * G + c; if (L >= nwg) return false;
        int wgid = L; { const int q = nwg / NXCD, r = nwg % NXCD, xcd = wgid % NXCD, off = wgid / NXCD; wgid = (xcd < r ? xcd * (q + 1) : r * (q + 1) + (xcd - r) * q) + off; }
        const int nig = WGM * nN, gid = wgid / nig, fm = gid * WGM, gsz = (nM - fm) < WGM ? (nM - fm) : WGM;
        u.pm = fm + ((wgid % nig) % gsz); u.pn = (wgid % nig) / gsz; if (rev) u.pm = nM - 1 - u.pm; return true;
    }
    __device__ __forceinline__ void a_ready(const Unit&) const {}
    __device__ __forceinline__ void done(const Unit&) const {}
};

typedef float f32x2_t __attribute__((ext_vector_type(2))); typedef __bf16 bf16x2_t __attribute__((ext_vector_type(2)));
__device__ __forceinline__ unsigned cvt_pk_bf16(float lo, float hi) { const f32x2_t v = {lo, hi}; const bf16x2_t b = __builtin_convertvector(v, bf16x2_t); return __builtin_bit_cast(unsigned, b); }
__device__ __forceinline__ u32x4 pack8(const f32x4 a, const f32x4 b) { u32x4 w; w.x = cvt_pk_bf16(a[0], a[1]); w.y = cvt_pk_bf16(a[2], a[3]); w.z = cvt_pk_bf16(b[0], b[1]); w.w = cvt_pk_bf16(b[2], b[3]); return w; }
__device__ __forceinline__ float fast_sigmoid(float x) { return __builtin_amdgcn_rcpf(1.0f + __builtin_amdgcn_exp2f(-1.4426950408889634f * x)); }
__device__ __forceinline__ f32x4 sigmoid4(const f32x4 v) { f32x4 o; o[0] = fast_sigmoid(v[0]); o[1] = fast_sigmoid(v[1]); o[2] = fast_sigmoid(v[2]); o[3] = fast_sigmoid(v[3]); return o; }
__device__ __forceinline__ f32x4 silu4(const f32x4 v) { return v * sigmoid4(v); }
__device__ __forceinline__ f32x4 gelu_tanh4(const f32x4 v) { const f32x4 z = v * (1.5957691216057308f + 0.07135481627260025f * (v * v)); return v * sigmoid4(z); }

struct PrefIn { f32x4 p0, p1, b; };
struct RowScale {
    const float* PS; PG8_LAS float* tab;
    __device__ __forceinline__ void fetch(PrefIn& pf, const Unit& u, int tid, const float* bsrc0, const float* bsrc1) const {
        asm volatile("" : "+v"(tid));
        const float* pp = PS + (size_t)(u.pm * BM + (tid >> 1)) * 16 + 8 * (tid & 1);
        pf.p0 = *(const f32x4*)pp; pf.p1 = *(const f32x4*)(pp + 4);
        if (tid < 64) pf.b = *(const f32x4*)((tid < 32 ? bsrc0 : bsrc1) + 4 * (tid & 31));
    }
    __device__ __forceinline__ void finish(float (&rs)[2][4], f32x4 (&bv)[2][2], const PrefIn& pf, int tid, int wr, int wc, int fr, int fq) const {
        float s = ((pf.p0[0] + pf.p0[1]) + (pf.p0[2] + pf.p0[3])) + ((pf.p1[0] + pf.p1[1]) + (pf.p1[2] + pf.p1[3])); s += __shfl_xor(s, 1);
        if ((tid & 1) == 0) tab[tid >> 1] = 1.0f / sqrtf(s * (1.0f / 1024.0f) + 1e-6f);
        if (tid < 64) *(PG8_LAS f32x4*)(tab + 256 + 4 * tid) = pf.b;
        asm volatile("s_waitcnt lgkmcnt(0)" ::: "memory"); __builtin_amdgcn_s_barrier(); asm volatile("" ::: "memory");
#pragma unroll
        for (int ai = 0; ai < 2; ++ai)
#pragma unroll
            for (int m = 0; m < 4; ++m) rs[ai][m] = tab[ai * HALF + wr * 64 + m * 16 + fr];
#pragma unroll
        for (int bj = 0; bj < 2; ++bj)
#pragma unroll
            for (int n = 0; n < 2; ++n) bv[bj][n] = *(const PG8_LAS f32x4*)(tab + 256 + bj * HALF + wc * 32 + 8 * fq + 4 * n);
    }
};
typedef unsigned u32x2v __attribute__((ext_vector_type(2))); typedef _Float16 h16x4 __attribute__((ext_vector_type(4)));
__device__ __forceinline__ f32x4 h4_to_f4(const u32x2v w) { const h16x4 h = __builtin_bit_cast(h16x4, w); return (f32x4){(float)h[0], (float)h[1], (float)h[2], (float)h[3]}; }
__device__ __forceinline__ u32x2v f4_to_h4(const f32x4 v) { const h16x4 h = {(_Float16)v[0], (_Float16)v[1], (_Float16)v[2], (_Float16)v[3]}; return __builtin_bit_cast(u32x2v, h); }
struct EpiSwiglu {
    static constexpr bool PERM = true, AFTER_DRAIN = false; static constexpr int PROBE_ID = 1; unsigned char* wsp; __device__ __forceinline__ void* probe_ptr() const { return wsp + 512 * 1024; }
    bf16_t* O; int ldc; RowScale R; const float* b2;
    typedef PrefIn Pref;
    __device__ __forceinline__ void prefetch(Pref& pf, const Unit& u, int tid) const { const float* bp = b2 + (size_t)(u.pm >> 3) * 5632 + u.pn * HALF; R.fetch(pf, u, tid, bp, bp + 2816); }
    __device__ __forceinline__ void operator()(const f32x4 (&acc)[2][2][4][2], const Unit& u, int wr, int wc, int fr, int fq, const Pref& pf, int tid) const {
        const int row0 = u.pm * BM + wr * 64 + fr, col0 = u.pn * HALF + wc * 32 + 8 * fq;
        float rs[2][4]; f32x4 bv[2][2]; R.finish(rs, bv, pf, tid, wr, wc, fr, fq);
        const f32x4 bg0 = bv[0][0], bg1 = bv[0][1], bu0 = bv[1][0], bu1 = bv[1][1];
#pragma unroll
        for (int ai = 0; ai < 2; ++ai)
#pragma unroll
            for (int m = 0; m < 4; ++m) { bf16_t* rowp = O + (size_t)(row0 + ai * HALF + m * 16) * ldc + col0; const float r = rs[ai][m];
                const f32x4 v0 = silu4(acc[ai][0][m][0] * r + bg0) * (acc[ai][1][m][0] * r + bu0), v1 = silu4(acc[ai][0][m][1] * r + bg1) * (acc[ai][1][m][1] * r + bu1);
                *(u32x4*)rowp = pack8(v0, v1); }
    }
};
struct EpiRgIn {
    static constexpr bool PERM = true, AFTER_DRAIN = false; static constexpr int PROBE_ID = 2; unsigned char* wsp; __device__ __forceinline__ void* probe_ptr() const { return wsp + 512 * 1024; }
    bf16_t* Y; RowScale R; const float* b2;
    typedef PrefIn Pref;
    __device__ __forceinline__ void prefetch(Pref& pf, const Unit& u, int tid) const { const float* bp = b2 + (size_t)(u.pm >> 3) * 2048 + u.pn * BM; R.fetch(pf, u, tid, bp, bp + HALF); }
    __device__ __forceinline__ void operator()(const f32x4 (&acc)[2][2][4][2], const Unit& u, int wr, int wc, int fr, int fq, const Pref& pf, int tid) const {
        const int row0 = u.pm * BM + wr * 64 + fr; const bool isy = u.pn < 4;
        float rs[2][4]; f32x4 bv[2][2]; R.finish(rs, bv, pf, tid, wr, wc, fr, fq);
        bf16_t* base = Y + (size_t)(isy ? 0 : 1) * ((size_t)65536 * 1024) + (u.pn & 3) * BM + wc * 32 + 8 * fq;
#pragma unroll
        for (int ai = 0; ai < 2; ++ai)
#pragma unroll
            for (int m = 0; m < 4; ++m) { bf16_t* rowp = base + (size_t)(row0 + ai * HALF + m * 16) * 1024; const float r = rs[ai][m];
#pragma unroll
                for (int bj = 0; bj < 2; ++bj) { f32x4 v0 = acc[ai][bj][m][0] * r + bv[bj][0], v1 = acc[ai][bj][m][1] * r + bv[bj][1];
                    if (isy) { v0 = gelu_tanh4(v0); v1 = gelu_tanh4(v1); }
                    *(u32x4*)(rowp + bj * HALF) = pack8(v0, v1); } }
    }
};
struct EpiHgIn {
    static constexpr bool PERM = true, AFTER_DRAIN = false; static constexpr int PROBE_ID = 3; unsigned char* wsp; __device__ __forceinline__ void* probe_ptr() const { return wsp + 512 * 1024; }
    bf16_t* Q; _Float16* LOGF; const float* lb; RowScale R; const float* b2;
    typedef PrefIn Pref;
    __device__ __forceinline__ void prefetch(Pref& pf, const Unit& u, int tid) const { const float* bp = b2 + (size_t)(u.pm >> 3) * 4096 + u.pn * BM; R.fetch(pf, u, tid, bp, bp + HALF); }
    __device__ __forceinline__ void operator()(const f32x4 (&acc)[2][2][4][2], const Unit& u, int wr, int wc, int fr, int fq, const Pref& pf, int tid) const {
        const int row0 = u.pm * BM + wr * 64 + fr, sec = u.pn >> 2, colw = (u.pn & 3) * BM + wc * 32 + 8 * fq;
        float rs[2][4]; f32x4 bv[2][2]; R.finish(rs, bv, pf, tid, wr, wc, fr, fq);
        if (sec == 1) {
#pragma unroll
            for (int bj = 0; bj < 2; ++bj) { const f32x4 l0 = *(const f32x4*)(lb + colw + bj * HALF), l1 = *(const f32x4*)(lb + colw + bj * HALF + 4);
#pragma unroll
                for (int ai = 0; ai < 2; ++ai)
#pragma unroll
                    for (int m = 0; m < 4; ++m) { _Float16* rowp = LOGF + (size_t)(row0 + ai * HALF + m * 16) * 1024 + colw + bj * HALF; const float r = rs[ai][m];
                        const f32x4 s0 = sigmoid4(acc[ai][bj][m][0] * r + bv[bj][0]), s1 = sigmoid4(acc[ai][bj][m][1] * r + bv[bj][1]);
                        const f32x4 f0 = l0 + (1.0f - l0) * s0, f1 = l1 + (1.0f - l1) * s1; f32x4 o0, o1;
#pragma unroll
                        for (int e = 0; e < 4; ++e) { o0[e] = __logf(f0[e]); o1[e] = __logf(f1[e]); }
                        { const u32x2v h0 = f4_to_h4(o0), h1 = f4_to_h4(o1); u32x4 w; w.x = h0.x; w.y = h0.y; w.z = h1.x; w.w = h1.y; *(u32x4*)rowp = w; } } }
        } else {
            bf16_t* base = Q + (size_t)(sec - (sec > 0 ? 1 : 0)) * ((size_t)65536 * 1024) + colw;
#pragma unroll
            for (int ai = 0; ai < 2; ++ai)
#pragma unroll
                for (int m = 0; m < 4; ++m) { bf16_t* rowp = base + (size_t)(row0 + ai * HALF + m * 16) * 1024; const float r = rs[ai][m];
#pragma unroll
                    for (int bj = 0; bj < 2; ++bj) { f32x4 v0 = acc[ai][bj][m][0] * r + bv[bj][0], v1 = acc[ai][bj][m][1] * r + bv[bj][1];
                        if (sec == 3) { v0 = sigmoid4(v0); v1 = sigmoid4(v1); }
                        *(u32x4*)(rowp + bj * HALF) = pack8(v0, v1); } }
        }
    }
};
struct EpiGlIn {
    static constexpr bool PERM = true, AFTER_DRAIN = false; static constexpr int PROBE_ID = 4; unsigned char* wsp; __device__ __forceinline__ void* probe_ptr() const { return wsp + 512 * 1024; }
    bf16_t* Q; float* ALOW; RowScale R; const float* b2;
    typedef PrefIn Pref;
    __device__ __forceinline__ void prefetch(Pref& pf, const Unit& u, int tid) const { const float* bp = b2 + (size_t)(u.pm >> 3) * 3328 + u.pn * BM; R.fetch(pf, u, tid, bp, u.pn == 12 ? bp : bp + HALF); }
    __device__ __forceinline__ void operator()(const f32x4 (&acc)[2][2][4][2], const Unit& u, int wr, int wc, int fr, int fq, const Pref& pf, int tid) const {
        const int row0 = u.pm * BM + wr * 64 + fr, pn = u.pn;
        float rs[2][4]; f32x4 bv[2][2]; R.finish(rs, bv, pf, tid, wr, wc, fr, fq);
        if (pn == 12) {
            if (wc == 0 && fq < 2) { const f32x4 b0 = bv[0][0], b1 = bv[0][1];
#pragma unroll
                for (int ai = 0; ai < 2; ++ai)
#pragma unroll
                    for (int m = 0; m < 4; ++m) { float* rowp = ALOW + (size_t)(row0 + ai * HALF + m * 16) * 16 + 8 * fq; const float r = rs[ai][m];
                        *(f32x4*)rowp = acc[ai][0][m][0] * r + b0; *(f32x4*)(rowp + 4) = acc[ai][0][m][1] * r + b1; }
            }
            return;
        }
        const int g2 = pn >= 2 ? 1 : 0, g4 = pn >= 4 ? 1 : 0, g8 = pn >= 8 ? 1 : 0; const int ld = 512 + 512 * g4;
        bf16_t* base = Q + (size_t)(g2 + g4 + 2 * g8) * ((size_t)65536 * 512) + (pn - 2 * g2 - 2 * g4 - 4 * g8) * BM;
        base += wc * 32 + 8 * fq; const bool act = pn >= 8;
#pragma unroll
        for (int ai = 0; ai < 2; ++ai)
#pragma unroll
            for (int m = 0; m < 4; ++m) { bf16_t* rowp = base + (size_t)(row0 + ai * HALF + m * 16) * ld; const float r = rs[ai][m];
#pragma unroll
                for (int bj = 0; bj < 2; ++bj) { f32x4 v0 = acc[ai][bj][m][0] * r + bv[bj][0], v1 = acc[ai][bj][m][1] * r + bv[bj][1];
                    if (act) { v0 = silu4(v0); v1 = silu4(v1); }
                    *(u32x4*)(rowp + bj * HALF) = pack8(v0, v1); } }
    }
};
struct EpiResidParams { const _Float16* base; _Float16* out; const float* coef; const float* ss; bf16_t* An; const float* nwn; const float* scn; float* PS; int cstride; float fac; };
struct PrefRes { f32x4 a, c; };
struct EpiResid {
    static constexpr bool PERM = true, AFTER_DRAIN = false; static constexpr int PROBE_ID = 5; unsigned char* wsp; __device__ __forceinline__ void* probe_ptr() const { return wsp + 512 * 1024; }
    const PG8_LAS unsigned* pb; PG8_LAS float* tab;
    typedef __attribute__((address_space(1))) float gfl; typedef __attribute__((address_space(1))) bf16_t gbf; typedef __attribute__((address_space(1))) f32x4 gf4;
    typedef PrefRes Pref;
    __device__ __forceinline__ unsigned long long ld64(int i) const { const unsigned lo = __builtin_amdgcn_readfirstlane(pb[2 * i]), hi = __builtin_amdgcn_readfirstlane(pb[2 * i + 1]); return ((unsigned long long)hi << 32) | lo; }
    __device__ __forceinline__ void prefetch(Pref& pf, const Unit& u, int tid) const {
        asm volatile("" : "+v"(tid));
        const gfl* ss = (const gfl*)ld64(3); const int cstride = (int)__builtin_amdgcn_readfirstlane(pb[16]); const int wv = __builtin_amdgcn_readfirstlane(tid >> 6);
        pf.a = (f32x4){0.f, 0.f, 0.f, 0.f}; pf.c = pf.a;
        if (ss) pf.a = *(const gf4*)(ss + (size_t)(u.pm * BM + (tid >> 1)) * 8 + 4 * (tid & 1));
        const size_t boff = (size_t)(u.pm >> 3) * cstride + u.pn * BM + 4 * (tid & 63);
        if (wv == 0) pf.c = *(const gf4*)((const gfl*)ld64(2) + boff);
        else if (wv == 1) { if (ld64(4)) pf.c = *(const gf4*)((const gfl*)ld64(5) + u.pn * BM + 4 * (tid & 63)); }
        else if (wv == 2) { if (ld64(4)) pf.c = *(const gf4*)((const gfl*)ld64(6) + boff); }
    }
    __device__ __forceinline__ void operator()(const f32x4 (&acc)[2][2][4][2], const Unit& u, int wr, int wc, int fr, int fq, const Pref& pf, int tid) const {
        { int l_; asm volatile("v_mbcnt_lo_u32_b32 %0, -1, 0\n\tv_mbcnt_hi_u32_b32 %0, -1, %0" : "=v"(l_)); fr = l_ & 15; fq = l_ >> 4; tid = (wr * 4 + wc) * 64 + l_; }
        typedef __attribute__((address_space(1))) u32x2v gu2; const gu2* base = (const gu2*)ld64(0); gu2* out = (gu2*)ld64(1); const bool hasss = ld64(3) != 0ull;
        gbf* An = (gbf*)ld64(4); gfl* PS = (gfl*)ld64(7);
        const float fac = __builtin_bit_cast(float, __builtin_amdgcn_readfirstlane(pb[17]));
        const int row0 = u.pm * BM + wr * 64 + fr, col0 = u.pn * BM + wc * 32 + 8 * fq;
        { float sr = (pf.a[0] + pf.a[1]) + (pf.a[2] + pf.a[3]); sr += __shfl_xor(sr, 1); if ((tid & 1) == 0) tab[tid >> 1] = hasss ? 1.0f / sqrtf(sr * (1.0f / 1024.0f) + 1e-6f) : 1.0f; }
        if (tid < 192) *(PG8_LAS f32x4*)(tab + 256 + 4 * tid) = tid < 64 ? pf.c * fac : pf.c;
        asm volatile("s_waitcnt lgkmcnt(0)" ::: "memory"); __builtin_amdgcn_s_barrier(); asm volatile("" ::: "memory");
        const PG8_LAS float* tc = tab + wc * 32 + 8 * fq;
        u32x2v cur[2][2][2], nxt[2][2][2];
#define RES_LOAD(dst, g_) do { const int ai_ = (g_) >> 1, m0_ = ((g_) & 1) * 2; _Pragma("unroll") for (int mm = 0; mm < 2; ++mm) { const unsigned off_ = (unsigned)(row0 + ai_ * HALF + (m0_ + mm) * 16) * 1024u + (unsigned)col0; \
            _Pragma("unroll") for (int bj = 0; bj < 2; ++bj) _Pragma("unroll") for (int n = 0; n < 2; ++n) dst[mm][bj][n] = base[(off_ + bj * HALF + n * 4) >> 2]; } } while (0)
        RES_LOAD(cur, 0);
#pragma unroll
        for (int g = 0; g < 4; ++g) { const int ai = g >> 1, m0 = (g & 1) * 2;
            if (g < 3) RES_LOAD(nxt, g + 1);
            asm volatile("" ::: "memory");
#pragma unroll
            for (int mm = 0; mm < 2; ++mm) { const int row = row0 + ai * HALF + (m0 + mm) * 16; const unsigned off = (unsigned)row * 1024u + (unsigned)col0; float sq = 0.f;
                const float rsm = tab[ai * HALF + wr * 64 + (m0 + mm) * 16 + fr];
#pragma unroll
                for (int bj = 0; bj < 2; ++bj) { f32x4 xn[2];
#pragma unroll
                    for (int n = 0; n < 2; ++n) { const f32x4 cvv = *(const PG8_LAS f32x4*)(tc + 256 + bj * HALF + 4 * n);
                        xn[n] = h4_to_f4(cur[mm][bj][n]) + (cvv * rsm) * acc[ai][bj][m0 + mm][n]; out[(off + bj * HALF + n * 4) >> 2] = f4_to_h4(xn[n]);
                        sq += (xn[n][0] * xn[n][0] + xn[n][1] * xn[n][1]) + (xn[n][2] * xn[n][2] + xn[n][3] * xn[n][3]); }
                    if (An) { const f32x4 g0 = *(const PG8_LAS f32x4*)(tc + 512 + bj * HALF) * (1.0f + *(const PG8_LAS f32x4*)(tc + 768 + bj * HALF)), g1 = *(const PG8_LAS f32x4*)(tc + 512 + bj * HALF + 4) * (1.0f + *(const PG8_LAS f32x4*)(tc + 768 + bj * HALF + 4));
                        *(__attribute__((address_space(1))) u32x4*)(An + off + bj * HALF) = pack8(xn[0] * g0, xn[1] * g1); } }
                if (An) { sq += __shfl_xor(sq, 16); sq += __shfl_xor(sq, 32); if (fq == 0) PS[(size_t)row * 16 + u.pn * 4 + wc] = sq; } }
            asm volatile("" ::: "memory");
            if (g < 3) {
#pragma unroll
                for (int mm = 0; mm < 2; ++mm)
#pragma unroll
                    for (int bj = 0; bj < 2; ++bj)
#pragma unroll
                        for (int n = 0; n < 2; ++n) cur[mm][bj][n] = nxt[mm][bj][n]; }
        }
#undef RES_LOAD
    }
};

template <class Epi, class Sched, bool ALIGN_EPI = false, bool SP2 = false>
__device__ __forceinline__ void gemm_phase(PG8_LAS unsigned char* lds, const Gemm g, const Sched& S, const Epi& E, const int wave_id) {
    int lid_; asm volatile("v_mbcnt_lo_u32_b32 %0, -1, 0\n\tv_mbcnt_hi_u32_b32 %0, -1, %0" : "=v"(lid_)); int wvl_ = wave_id; asm volatile("" : "+s"(wvl_)); const int tid_ = wvl_ * 64 + lid_;
    const int tid = tid_, wid = wvl_, lane = tid & 63, wr = wid >> 2, wc = wid & 3, fr = lane & 15, fq = lane >> 4;
    const int K = g.K, nt = K / BK;
    unsigned voffA[2], voffB[2];
#pragma unroll
    for (int i = 0; i < 2; ++i) { int R, C; stage_rc(tid * 16 + i * 8192, R, C); const int Rb = Epi::PERM ? ((R & ~31) + perm32(R & 31)) : R;
        voffA[i] = (unsigned)(R * K + C) * 2u; voffB[i] = (unsigned)(Rb * K + C) * 2u; }
    const size_t kstep = (size_t)(BK * 2);
    const size_t hstep = (size_t)HALF * K * 2;
    const size_t tstep = 2 * hstep;
    const unsigned ldsw = (unsigned)wid * 1024u;
    const int aoff = lds_byte(wr * 64 + fr, fq * 8), boff = lds_byte(wc * 32 + fr, fq * 8);
#define PG8_SA(b, h) (((b) * 2 + (h)) * HTB)
#define PG8_SB(b, h) ((4 + (b) * 2 + (h)) * HTB)
#define PG8_STAGE(bufoff, gbase, voff) do { _Pragma("unroll") for (int _i = 0; _i < 2; ++_i) \
        __builtin_amdgcn_global_load_lds((const unsigned*)((const char*)(gbase) + (voff)[_i]), (PG8_LAS unsigned*)(lds + (bufoff) + ldsw + _i * 8192), 16, 0, 0); } while (0)
#define PG8_LDA(dst, b, h) do { _Pragma("unroll") for (int m = 0; m < 4; ++m) _Pragma("unroll") for (int k = 0; k < 2; ++k) dst[m][k] = *(const PG8_LAS bf16x8*)(lds + PG8_SA(b, h) + aoff + m * 2048 + k * 1024); } while (0)
#define PG8_LDB(dst, b, h) do { _Pragma("unroll") for (int n = 0; n < 2; ++n) _Pragma("unroll") for (int k = 0; k < 2; ++k) dst[n][k] = *(const PG8_LAS bf16x8*)(lds + PG8_SB(b, h) + boff + n * 2048 + k * 1024); } while (0)
#define PG8_MMA(ai, bj, At, Bt) do { __builtin_amdgcn_s_setprio(1); _Pragma("unroll") for (int m = 0; m < 4; ++m) _Pragma("unroll") for (int n = 0; n < 2; ++n) _Pragma("unroll") for (int k = 0; k < 2; ++k) \
        acc[ai][bj][m][n] = __builtin_amdgcn_mfma_f32_16x16x32_bf16(Bt[n][k], At[m][k], acc[ai][bj][m][n], 0, 0, 0); __builtin_amdgcn_s_setprio(0); } while (0)
#define PG8_WAIT_V(n) asm volatile("s_waitcnt vmcnt(" #n ")" ::: "memory")
#define PG8_WAIT_L(n) asm volatile("s_waitcnt lgkmcnt(" #n ")" ::: "memory")
#define PG8_BAR __builtin_amdgcn_s_barrier()
#define PG8_SCHED __builtin_amdgcn_sched_barrier(0)
    Unit cur, nxt; int ui = 0;
    typename Epi::Pref pf;
    if (!S.next(0, cur)) return;
    f32x4 acc[2][2][4][2];
#pragma unroll
    for (int a = 0; a < 2; ++a)
#pragma unroll
        for (int b = 0; b < 2; ++b)
#pragma unroll
            for (int m = 0; m < 4; ++m)
#pragma unroll
                for (int n = 0; n < 2; ++n) acc[a][b][m][n] = (f32x4){0.f, 0.f, 0.f, 0.f};
    bf16x8 At[4][2], B0[2][2], B1[2][2];
    const char* cA = (const char*)g.A + (size_t)cur.pm * tstep; const char* cB = (const char*)g.Bt + (size_t)cur.pn * tstep;
    S.a_ready(cur);
    if constexpr (SP2) {
        PG8_STAGE(PG8_SB(0, 0), cB, voffB); PG8_STAGE(PG8_SB(0, 1), cB + hstep, voffB); PG8_STAGE(PG8_SA(0, 0), cA, voffA); PG8_STAGE(PG8_SA(0, 1), cA + hstep, voffA);
        if (wr == 1) PG8_BAR;
        PG8_WAIT_V(2); PG8_BAR;
        PG8_STAGE(PG8_SB(1, 0), cB + kstep, voffB); PG8_STAGE(PG8_SA(1, 0), cA + kstep, voffA); PG8_STAGE(PG8_SB(1, 1), cB + hstep + kstep, voffB);
        PG8_WAIT_V(6); PG8_BAR;
    } else {
        PG8_STAGE(PG8_SB(0, 0), cB, voffB); PG8_STAGE(PG8_SA(0, 0), cA, voffA); PG8_STAGE(PG8_SB(0, 1), cB + hstep, voffB); PG8_STAGE(PG8_SA(0, 1), cA + hstep, voffA);
        if (wr == 1) PG8_BAR;
        PG8_WAIT_V(4); PG8_BAR;
        PG8_STAGE(PG8_SB(1, 0), cB + kstep, voffB); PG8_STAGE(PG8_SA(1, 0), cA + kstep, voffA); PG8_STAGE(PG8_SB(1, 1), cB + hstep + kstep, voffB);
        PG8_WAIT_V(6); PG8_BAR;
    }
    for (;;) {
        const bool has_next = S.next(ui + 1, nxt);
        const char* nA = has_next ? (const char*)g.A + (size_t)nxt.pm * tstep : cA; const char* nB = has_next ? (const char*)g.Bt + (size_t)nxt.pn * tstep : cB;
        for (int t = 0; t < nt; t += 2) {
            const bool last = (t == nt - 2);
            const char* a1 = cA + (size_t)(t + 1) * kstep;
            const char* a2 = last ? nA : cA + (size_t)(t + 2) * kstep; const char* b2 = last ? nB : cB + (size_t)(t + 2) * kstep;
            const char* a3 = a2 + kstep; const char* b3 = b2 + kstep;
            if (last && has_next) S.a_ready(nxt);
            if (last) E.prefetch(pf, cur, tid);
            if constexpr (SP2) {
            PG8_LDB(B0, 0, 0); PG8_LDB(B1, 0, 1); PG8_SCHED; PG8_LDA(At, 0, 0); PG8_STAGE(PG8_SA(1, 1), a1 + hstep, voffA);
            PG8_WAIT_V(8); PG8_WAIT_L(0); PG8_BAR; PG8_MMA(0, 0, At, B0); PG8_MMA(0, 1, At, B1); PG8_BAR; PG8_SCHED;
            PG8_LDA(At, 0, 1); PG8_STAGE(PG8_SB(0, 0), b2, voffB); PG8_STAGE(PG8_SB(0, 1), b2 + hstep, voffB); PG8_STAGE(PG8_SA(0, 0), a2, voffA);
            PG8_WAIT_V(8); PG8_WAIT_L(0); PG8_BAR; PG8_MMA(1, 0, At, B0); PG8_MMA(1, 1, At, B1); PG8_BAR; PG8_SCHED;
            PG8_LDB(B0, 1, 0); PG8_LDB(B1, 1, 1); PG8_SCHED; PG8_LDA(At, 1, 0); PG8_STAGE(PG8_SA(0, 1), a2 + hstep, voffA);
            PG8_WAIT_V(8); PG8_WAIT_L(0); PG8_BAR; PG8_MMA(0, 0, At, B0); PG8_MMA(0, 1, At, B1); PG8_BAR; PG8_SCHED;
            PG8_LDA(At, 1, 1); PG8_STAGE(PG8_SB(1, 0), b3, voffB); PG8_STAGE(PG8_SB(1, 1), b3 + hstep, voffB); PG8_STAGE(PG8_SA(1, 0), a3, voffA);
            PG8_WAIT_V(8); PG8_WAIT_L(0); PG8_BAR; PG8_MMA(1, 0, At, B0); PG8_MMA(1, 1, At, B1); PG8_BAR; PG8_SCHED;
            } else {
            PG8_LDB(B0, 0, 0); PG8_SCHED; PG8_LDA(At, 0, 0); PG8_STAGE(PG8_SA(1, 1), a1 + hstep, voffA);
            PG8_WAIT_L(8); PG8_BAR; PG8_WAIT_L(0); PG8_MMA(0, 0, At, B0); PG8_BAR; PG8_SCHED;
            PG8_LDB(B1, 0, 1); PG8_STAGE(PG8_SB(0, 0), b2, voffB);
            PG8_BAR; PG8_WAIT_L(0); PG8_MMA(0, 1, At, B1); PG8_BAR;
            PG8_LDA(At, 0, 1); PG8_STAGE(PG8_SA(0, 0), a2, voffA);
            PG8_BAR; PG8_WAIT_L(0); PG8_MMA(1, 0, At, B0); PG8_BAR; PG8_SCHED;
            PG8_STAGE(PG8_SB(0, 1), b2 + hstep, voffB);
            PG8_WAIT_V(6); PG8_BAR; PG8_MMA(1, 1, At, B1); PG8_BAR;
            PG8_LDB(B0, 1, 0); PG8_SCHED; PG8_LDA(At, 1, 0); PG8_STAGE(PG8_SA(0, 1), a2 + hstep, voffA);
            PG8_WAIT_L(8); PG8_BAR; PG8_WAIT_L(0); PG8_MMA(0, 0, At, B0); PG8_BAR; PG8_SCHED;
            PG8_LDB(B1, 1, 1); PG8_STAGE(PG8_SB(1, 0), b3, voffB);
            PG8_BAR; PG8_WAIT_L(0); PG8_MMA(0, 1, At, B1); PG8_BAR;
            PG8_LDA(At, 1, 1); PG8_STAGE(PG8_SA(1, 0), a3, voffA);
            PG8_BAR; PG8_WAIT_L(0); PG8_MMA(1, 0, At, B0); PG8_BAR; PG8_SCHED;
            PG8_STAGE(PG8_SB(1, 1), b3 + hstep, voffB);
            PG8_WAIT_V(6); PG8_BAR; PG8_MMA(1, 1, At, B1); PG8_BAR;
            }
        }
        if constexpr (ALIGN_EPI) { if (wr == 0) PG8_BAR; }
#ifdef PROBE_EPI
        unsigned long long te0_ = 0; if (Epi::PROBE_ID == PROBE_EPI) te0_ = __builtin_amdgcn_s_memrealtime();
#endif
        if constexpr (!Epi::AFTER_DRAIN) { E(acc, cur, wr, wc, fr, fq, pf, tid); S.done(cur); }
#ifdef PROBE_EPI
        if (Epi::PROBE_ID == PROBE_EPI && blockIdx.x == 0 && tid == 0) { volatile unsigned long long* tp_ = (volatile unsigned long long*)E.probe_ptr(); tp_[1] = tp_[1] + (__builtin_amdgcn_s_memrealtime() - te0_); }
#endif
        if (!has_next) break;
#pragma unroll
        for (int a = 0; a < 2; ++a)
#pragma unroll
            for (int b = 0; b < 2; ++b)
#pragma unroll
                for (int m = 0; m < 4; ++m)
#pragma unroll
                    for (int n = 0; n < 2; ++n) acc[a][b][m][n] = (f32x4){0.f, 0.f, 0.f, 0.f};
        cur = nxt; cA = nA; cB = nB; ++ui;
        if constexpr (ALIGN_EPI) { if (wr == 1) PG8_BAR; }
    }
    PG8_WAIT_V(0);
    if constexpr (!ALIGN_EPI) { if (wr == 0) PG8_BAR; }
    PG8_BAR;
    if constexpr (Epi::AFTER_DRAIN) { E.fused(acc, cur, wr, wc, fr, fq, lds, wid, lane); S.done(cur); }
#undef PG8_SA
#undef PG8_SB
#undef PG8_STAGE
#undef PG8_LDA
#undef PG8_LDB
#undef PG8_MMA
#undef PG8_WAIT_V
#undef PG8_WAIT_L
#undef PG8_BAR
#undef PG8_SCHED
}
}
constexpr int NWAVES = 8;
constexpr int BATCH = 32, SEQ = 2048, D = 1024, M = BATCH * SEQ, FF = 2816, DEPTH = 4, NMOD = 9;
constexpr int GLA_IN = 3088, GLA_INP = 3328;
constexpr float EPS = 1e-6f;
constexpr size_t MiB = 1u << 20;
constexpr size_t WS_CTL = 0, CTL_ZERO_BYTES = 1 * MiB;
constexpr size_t WS_MOD = 2 * MiB;
constexpr size_t WS_LB = 6 * MiB + 512 * 1024;
constexpr size_t WS_SS = 7 * MiB;
constexpr size_t WS_W13 = 10 * MiB, W13_BYTES = (size_t)2 * FF * D * 2;
constexpr size_t WS_W2 = 98 * MiB, W2_BYTES = (size_t)D * FF * 2;
constexpr size_t WS_RGIN = 142 * MiB, RGIN_BYTES = (size_t)2048 * D * 2;
constexpr size_t WS_RGG = 150 * MiB, RGG_BYTES = (size_t)8 * 256 * 128 * 2;
constexpr size_t WS_RGOUT = 151 * MiB, SQ_BYTES = (size_t)D * D * 2;
constexpr size_t WS_HGIN = 155 * MiB;
constexpr size_t WS_HGOUT = 163 * MiB;
constexpr size_t WS_GLIN = 165 * MiB;
constexpr size_t WS_GLOUT = 172 * MiB;
constexpr size_t WS_H = 176 * MiB;
constexpr size_t WS_SCR = 304 * MiB;
constexpr size_t ACT_BYTES = (size_t)M * D * 2;
constexpr size_t WS_B2 = WS_SCR + 4 * ACT_BYTES;
constexpr size_t B2_BYTES = (size_t)32 * 5632 * 4;
constexpr size_t WS_PS = WS_B2 + 9 * MiB;
constexpr size_t WS_X16 = WS_PS + 4 * MiB;
constexpr size_t WS_END = WS_X16 + ACT_BYTES;
static_assert(12 * B2_BYTES <= 9 * MiB, "bias2 fits");
static_assert(WS_W13 + 8 * W13_BYTES <= WS_W2 && WS_W2 + 8 * W2_BYTES <= WS_RGIN && WS_RGIN + 2 * RGIN_BYTES <= WS_RGG && WS_RGG + 2 * RGG_BYTES <= WS_RGOUT && WS_RGOUT + 2 * SQ_BYTES <= WS_HGIN, "ws map 1");
static_assert(WS_HGIN + 4 * SQ_BYTES <= WS_HGOUT && WS_HGOUT + SQ_BYTES <= WS_GLIN && WS_GLIN + (size_t)GLA_INP * D * 2 <= WS_GLOUT && WS_GLOUT + SQ_BYTES <= WS_H && WS_H + ACT_BYTES <= WS_SCR, "ws map 2");
static_assert(ACT_BYTES + (size_t)M * FF * 2 <= 4 * ACT_BYTES, "hid fits behind the mixer-output operand");
constexpr int CW_TMO = 0, CW_BAR = 4096;
constexpr int RING_BYTES = 131072, LDSCTL_OFF = RING_BYTES, MISC_OFF = LDSCTL_OFF + 320, LDS_BYTES = 147456;

#define GAS __attribute__((address_space(1)))
#define LAS __attribute__((address_space(3)))
typedef unsigned short bf16;
typedef unsigned v4u __attribute__((ext_vector_type(4)));
typedef unsigned v2u __attribute__((ext_vector_type(2)));
typedef float f32x4 __attribute__((ext_vector_type(4)));
typedef float f32x16 __attribute__((ext_vector_type(16)));
typedef short bf16x8 __attribute__((ext_vector_type(8)));
typedef GAS unsigned gu32;
#define RLX_AGENT __ATOMIC_RELAXED, __HIP_MEMORY_SCOPE_AGENT
#define LDS_WAIT() asm volatile("s_waitcnt lgkmcnt(0)" ::: "memory")
#define VM_WAIT() asm volatile("s_waitcnt vmcnt(0)" ::: "memory")
__device__ __forceinline__ unsigned pk2(float lo, float hi) { return pg8::cvt_pk_bf16(lo, hi); }
__device__ __forceinline__ unsigned f2bf(float f) { return pg8::cvt_pk_bf16(f, 0.f) & 0xffffu; }
__device__ __forceinline__ float bf2f(unsigned h) { return __builtin_bit_cast(float, h << 16); }
__device__ __forceinline__ float sigmoidf_(float x) { return 1.0f / (1.0f + expf(-x)); }

__device__ __forceinline__ int lane_id() { int l; asm volatile("v_mbcnt_lo_u32_b32 %0, -1, 0\n\tv_mbcnt_hi_u32_b32 %0, -1, %0" : "=v"(l)); return l; }
typedef _Float16 f16x2_t __attribute__((ext_vector_type(2))); typedef _Float16 f16x4_t __attribute__((ext_vector_type(4)));
__device__ __forceinline__ unsigned pkh2(float lo, float hi) { const f16x2_t h = {(_Float16)lo, (_Float16)hi}; return __builtin_bit_cast(unsigned, h); }
__device__ __forceinline__ f32x4 unpk_h4(const v2u w) { const f16x4_t h = __builtin_bit_cast(f16x4_t, w); return (f32x4){(float)h[0], (float)h[1], (float)h[2], (float)h[3]}; }
#define XB_TMO      128
#define XB_XCNT(j)  (256  + 64 * (j))
#define XB_XSUB(j)  (1280 + 64 * (j))
#define XB_XGEN(j)  (2304 + 64 * (j))
#define XB_TOP      3328
#define XB_TOPGEN   3392
#define XCD_BAR_WORDS 3456
#define XB_SPIN_CAP (1u << 18)

__device__ __forceinline__ unsigned xb_ld(unsigned* p)              { return __hip_atomic_load(p, __ATOMIC_RELAXED, __HIP_MEMORY_SCOPE_AGENT); }
__device__ __forceinline__ unsigned xb_add(unsigned* p, unsigned v) { return __hip_atomic_fetch_add(p, v, __ATOMIC_RELAXED, __HIP_MEMORY_SCOPE_AGENT); }
__device__ __forceinline__ unsigned xb_xcc_id() { return (unsigned)__builtin_amdgcn_s_getreg((3 << 11) | 20) & 0xFu; }
#define XB_SPIN(cond, bar) do { unsigned _sp = 0; while (cond) { __builtin_amdgcn_s_sleep(1); \
    if ((++_sp & 255u) == 0u) { if (xb_ld(&(bar)[XB_TMO])) break; if (_sp > XB_SPIN_CAP) { atomicAdd(&(bar)[XB_TMO], 1u); break; } } } } while (0)

struct XcdBarrier {
    unsigned* bar; unsigned x; int wave;
    volatile LAS unsigned* st;
};

__device__ __forceinline__ XcdBarrier xcd_barrier_post(unsigned* bar, volatile LAS unsigned* st) {
    XcdBarrier b; b.bar = bar; b.x = xb_xcc_id(); b.st = st;
    if (threadIdx.x == 0) (void)xb_add(&bar[XB_XCNT(b.x)], 1u);
    return b;
}
__device__ __forceinline__ void xcd_barrier_complete(unsigned* bar, unsigned x, unsigned& nloc, unsigned& nx) {
    const unsigned G = gridDim.x * gridDim.y * gridDim.z;
    unsigned sum, cnt, mine, sp = 0u;
    for (;;) {
        sum = 0u; cnt = 0u; mine = 0u;
#pragma unroll
        for (unsigned j = 0; j < 16; ++j) { const unsigned c = xb_ld(&bar[XB_XCNT(j)]); sum += c; cnt += (c > 0u) ? 1u : 0u; mine = (j == x) ? c : mine; }
        if (sum == G) break;
        __builtin_amdgcn_s_sleep(1);
        if ((++sp & 255u) == 0u) { if (xb_ld(&bar[XB_TMO])) break; if (sp > XB_SPIN_CAP) { atomicAdd(&bar[XB_TMO], 1u); break; } }
    }
    nloc = mine > 0u ? mine : 1u; nx = cnt > 0u ? cnt : 1u;
}

__device__ __forceinline__ void xcd_barrier(const XcdBarrier& b) {
    asm volatile("s_waitcnt vmcnt(0)" ::: "memory");
    __syncthreads();
    int xl_; asm volatile("v_mbcnt_lo_u32_b32 %0, -1, 0\n\tv_mbcnt_hi_u32_b32 %0, -1, %0" : "=v"(xl_));
    if (b.wave == 0 && xl_ == 0) {
        unsigned* bar = b.bar; unsigned bx_ = b.x; asm volatile("" : "+s"(bar), "+s"(bx_));
        __builtin_amdgcn_s_waitcnt(0);
        unsigned nloc = b.st[0], nx = b.st[1];
        if (nloc == 0u) { xcd_barrier_complete(bar, bx_, nloc, nx); b.st[0] = nloc; b.st[1] = nx; }
        const unsigned old = xb_add(&bar[XB_XSUB(bx_)], 1u);
        const unsigned gen = old / nloc;
        if (old + 1u == (gen + 1u) * nloc) {
            __builtin_amdgcn_fence(__ATOMIC_RELEASE, "agent");
            asm volatile("s_waitcnt vmcnt(0)" ::: "memory");
            const unsigned og = xb_add(&bar[XB_TOP], 1u);
            const unsigned tg = og / nx;
            if (og + 1u == (tg + 1u) * nx) xb_add(&bar[XB_TOPGEN], 1u);
            else XB_SPIN(xb_ld(&bar[XB_TOPGEN]) == tg, bar);
            __builtin_amdgcn_fence(__ATOMIC_ACQUIRE, "agent");
            xb_add(&bar[XB_XGEN(bx_)], 1u);
            asm volatile("s_waitcnt vmcnt(0)" ::: "memory");
        } else {
            XB_SPIN(xb_ld(&bar[XB_XGEN(bx_)]) == gen, bar);
            __builtin_amdgcn_fence(__ATOMIC_ACQUIRE, "agent");
            asm volatile("s_waitcnt vmcnt(0)" ::: "memory");
        }
    }
    __syncthreads();
}
struct Frame {
    LAS unsigned char* lds;
    volatile LAS unsigned* MISC;
    gu32* ctl;
    int wave, vcu, G;
};
__device__ __forceinline__ float wave_sum(float v) {
#pragma unroll
    for (int o = 1; o < 64; o <<= 1) v += __shfl_xor(v, o);
    return v;
}
__device__ __forceinline__ void conv_item(const float* W, int N, int k0, int n0, int nvalid, bf16* WT, int Kd, int drow0, LAS float* scr, int lane) {
    const bool ok = (lane & 31) < nvalid;
#pragma unroll 8
    for (int i = 0; i < 32; ++i) { const int kk = 2 * i + (lane >> 5); scr[kk * 33 + (lane & 31)] = ok ? W[(size_t)(k0 + kk) * N + n0 + (lane & 31)] : 0.f; }
    LDS_WAIT(); asm volatile("" ::: "memory");
    const int c = lane & 7;
#pragma unroll
    for (int j = 0; j < 4; ++j) { const int n = (lane >> 3) + 8 * j; const LAS float* s = scr + (8 * c) * 33 + n;
        v4u o; o.x = pk2(s[0 * 33], s[1 * 33]); o.y = pk2(s[2 * 33], s[3 * 33]); o.z = pk2(s[4 * 33], s[5 * 33]); o.w = pk2(s[6 * 33], s[7 * 33]);
        *(GAS v4u*)(WT + (size_t)(drow0 + n) * Kd + k0 + 8 * c) = o; }
    LDS_WAIT(); asm volatile("" ::: "memory");
}
struct ProIn { const float *c, *ada_w, *ada_b, *w13, *w2, *rg_w_in, *rg_gate_w, *rg_w_out, *hg_w_in, *hg_lb, *hg_w_out, *gla_w_in, *gla_w_out; };
__device__ __forceinline__ void p0_prologue(Frame& F, const ProIn& P, unsigned char* ws) {
    int lane_ = lane_id(); asm volatile("" : "+v"(lane_)); const int lane = lane_;
    int gw_ = F.wave * F.G + F.vcu; asm volatile("" : "+s"(gw_)); const int gw = gw_, NGW = F.G * NWAVES;
    float* MOD = (float*)(ws + WS_MOD);
    { LAS float* CT = (LAS float*)F.lds;
        for (int idx = F.wave * 64 + lane; idx < BATCH * D; idx += NWAVES * 64) { const int b = idx >> 10, k = idx & 1023; const float cv = P.c[idx]; CT[k * 32 + (b ^ (k & 31))] = cv / (1.0f + expf(-cv)); }
        __syncthreads();
        for (int blk = gw; blk < DEPTH * NMOD * D / 32; blk += NGW) {
            const int n0 = blk * 32, l = n0 / (NMOD * D), nn = n0 % (NMOD * D);
            const float* Wp = P.ada_w + (size_t)l * D * (NMOD * D) + nn + (lane & 31) + (size_t)(lane >> 5) * (NMOD * D);
            f32x16 acc = {};
            for (int k0 = 0; k0 < D; k0 += 32) {
                float wv[16];
#pragma unroll
                for (int i = 0; i < 16; ++i) wv[i] = Wp[(size_t)(k0 + 2 * i) * (NMOD * D)];
#pragma unroll
                for (int i = 0; i < 16; ++i) { const int k = k0 + 2 * i + (lane >> 5); acc = __builtin_amdgcn_mfma_f32_32x32x2f32(CT[k * 32 + ((lane & 31) ^ (k & 31))], wv[i], acc, 0, 0, 0); }
            }
            const float bias = P.ada_b[(size_t)l * (NMOD * D) + nn + (lane & 31)];
#pragma unroll
            for (int r = 0; r < 16; ++r) { const int b = (r & 3) + 8 * (r >> 2) + 4 * (lane >> 5); MOD[((size_t)l * BATCH + b) * (NMOD * D) + nn + (lane & 31)] = acc[r] + bias; }
        }
        __syncthreads();
    }
    if (F.vcu == 0) { float* LB = (float*)(ws + WS_LB);
        for (int ch = F.wave * 64 + lane; ch < D; ch += NWAVES * 64) { const float g0 = P.hg_lb[ch], g1 = P.hg_lb[D + ch], g2 = P.hg_lb[2 * D + ch], g3 = P.hg_lb[3 * D + ch];
            const float mx = fmaxf(fmaxf(g0, g1), fmaxf(g2, g3)); const float e0 = expf(g0 - mx), e1 = expf(g1 - mx), e2 = expf(g2 - mx), e3 = expf(g3 - mx);
            LB[ch] = e1 / (e0 + e1 + e2 + e3); } }
    LAS float* scr = (LAS float*)(F.lds + F.wave * 16384);
    int gw2_ = F.vcu * NWAVES + F.wave; asm volatile("" : "+s"(gw2_)); const int gw2 = gw2_;
    constexpr int I_W13 = 16 * 176, I_W2 = 44 * 32, I_RGIN = 16 * 64, I_RGG = 2 * 8, I_SQ = 16 * 32, I_HGIN = 16 * 128, I_GLIN = 16 * (GLA_INP / 32);
    constexpr int T0 = 8 * I_W13, T1 = T0 + 8 * I_W2, T2 = T1 + 2 * I_RGIN, T3 = T2 + 16 * I_RGG, T4 = T3 + 2 * I_SQ, T5 = T4 + I_HGIN, T6 = T5 + I_SQ, T7 = T6 + I_GLIN, T8 = T7 + I_SQ;
    for (int it = gw2; it < T8; it += NGW) {
        int r = it;
        if (r < T0) { const int mi = r / I_W13, q = r % I_W13, kb = q / 176, nb = q % 176, n0 = nb * 32;
            const int drow = n0 < FF ? (n0 / 128) * 256 + (n0 % 128) : ((n0 - FF) / 128) * 256 + 128 + ((n0 - FF) % 128);
            conv_item(P.w13 + (size_t)mi * D * 2 * FF, 2 * FF, kb * 64, n0, 32, (bf16*)(ws + WS_W13 + mi * W13_BYTES), D, drow, scr, lane); continue; }
        r -= T0;
        if (r < 8 * I_W2) { const int mi = r / I_W2, q = r % I_W2, kb = q / 32, nb = q % 32;
            conv_item(P.w2 + (size_t)mi * FF * D, D, kb * 64, nb * 32, 32, (bf16*)(ws + WS_W2 + mi * W2_BYTES), FF, nb * 32, scr, lane); continue; }
        r -= 8 * I_W2;
        if (r < 2 * I_RGIN) { const int mi = r / I_RGIN, q = r % I_RGIN, kb = q / 64, nb = q % 64;
            conv_item(P.rg_w_in + (size_t)mi * D * 2048, 2048, kb * 64, nb * 32, 32, (bf16*)(ws + WS_RGIN + mi * RGIN_BYTES), D, nb * 32, scr, lane); continue; }
        r -= 2 * I_RGIN;
        if (r < 16 * I_RGG) { const int mi = r / I_RGG, q = r % I_RGG, kb = q / 8, nb = q % 8;
            conv_item(P.rg_gate_w + (size_t)mi * 128 * 256, 256, kb * 64, nb * 32, 32, (bf16*)(ws + WS_RGG) + (size_t)mi * 256 * 128, 128, nb * 32, scr, lane); continue; }
        r -= 16 * I_RGG;
        if (r < 2 * I_SQ) { const int mi = r / I_SQ, q = r % I_SQ, kb = q / 32, nb = q % 32;
            conv_item(P.rg_w_out + (size_t)mi * D * D, D, kb * 64, nb * 32, 32, (bf16*)(ws + WS_RGOUT + mi * SQ_BYTES), D, nb * 32, scr, lane); continue; }
        r -= 2 * I_SQ;
        if (r < I_HGIN) { const int kb = r / 128, nb = r % 128;
            conv_item(P.hg_w_in, 4096, kb * 64, nb * 32, 32, (bf16*)(ws + WS_HGIN), D, nb * 32, scr, lane); continue; }
        r -= I_HGIN;
        if (r < I_SQ) { const int kb = r / 32, nb = r % 32;
            conv_item(P.hg_w_out, D, kb * 64, nb * 32, 32, (bf16*)(ws + WS_HGOUT), D, nb * 32, scr, lane); continue; }
        r -= I_SQ;
        if (r < I_GLIN) { const int kb = r / (GLA_INP / 32), nb = r % (GLA_INP / 32), n0 = nb * 32; const int nv = GLA_IN - n0 < 0 ? 0 : (GLA_IN - n0 > 32 ? 32 : GLA_IN - n0);
            conv_item(P.gla_w_in, GLA_IN, kb * 64, nv > 0 ? n0 : 0, nv, (bf16*)(ws + WS_GLIN), D, n0, scr, lane); continue; }
        r -= I_GLIN;
        { const int kb = r / 32, nb = r % 32;
            conv_item(P.gla_w_out, D, kb * 64, nb * 32, 32, (bf16*)(ws + WS_GLOUT), D, nb * 32, scr, lane); }
    }
}
__device__ __forceinline__ void norm_phase(Frame& F, const float* x, const float* nw, const float* shift, const float* scale, bf16* H) {
    int lane_ = lane_id(); asm volatile("" : "+v"(lane_)); const int lane = lane_;
    int gw_ = F.vcu * NWAVES + F.wave; asm volatile("" : "+s"(gw_)); const int gw = gw_, NGW = F.G * NWAVES;
    for (int strip = gw; strip < M / 32; strip += NGW) {
        const int b = (strip * 32) / SEQ;
        f32x4 gv[4], sv[4];
#pragma unroll
        for (int j = 0; j < 4; ++j) { const int col = 4 * lane + 256 * j;
            gv[j] = *(const f32x4*)(nw + col) * (1.0f + *(const f32x4*)(scale + (size_t)b * (NMOD * D) + col)); sv[j] = *(const f32x4*)(shift + (size_t)b * (NMOD * D) + col); }
        for (int rr = 0; rr < 32; ++rr) { const size_t row = (size_t)strip * 32 + rr;
            const GAS f32x4* xr = (const GAS f32x4*)(x + row * D) + lane;
            f32x4 v[4]; float s = 0.f;
#pragma unroll
            for (int j = 0; j < 4; ++j) { v[j] = xr[64 * j]; s += (v[j].x * v[j].x + v[j].y * v[j].y) + (v[j].z * v[j].z + v[j].w * v[j].w); }
            const float rstd = 1.0f / sqrtf(wave_sum(s) * (1.f / D) + EPS);
            GAS v2u* o8 = (GAS v2u*)(H + row * D) + lane;
#pragma unroll
            for (int j = 0; j < 4; ++j) { const f32x4 o = v[j] * rstd * gv[j] + sv[j]; v2u w; w.x = pk2(o.x, o.y); w.y = pk2(o.z, o.w); o8[64 * j] = w; }
        }
    }
}

struct Pro2In { const float *x, *norm_w; };
__device__ __forceinline__ void p1_prologue(Frame& F, const Pro2In& P, unsigned char* ws) {
    int lane_ = lane_id(); asm volatile("" : "+v"(lane_)); const int lane = lane_;
    int gw_ = F.wave * F.G + F.vcu; asm volatile("" : "+s"(gw_)); const int gw = gw_, NGW = F.G * NWAVES;
    const float* MOD = (const float*)(ws + WS_MOD);
    constexpr int NB_FF = 176, NB_RG = 64, NB_HG = 128, NB_GL = GLA_INP / 32, NBT = 8 * NB_FF + 2 * NB_RG + NB_HG + NB_GL;
    for (int blk = gw; blk < NBT; blk += NGW) {
        int j, rb, pitch; const bf16* Bt; bool ffn = false;
        if (blk < 8 * NB_FF) { const int fi = blk / NB_FF; rb = blk % NB_FF; j = (fi >> 1) * 3 + (fi & 1) * 2; pitch = 5632; Bt = (const bf16*)(ws + WS_W13 + fi * W13_BYTES); ffn = true; }
        else if (blk < 8 * NB_FF + 2 * NB_RG) { const int r = blk - 8 * NB_FF, mi = r / NB_RG; rb = r % NB_RG; j = (mi * 3) * 3 + 1; pitch = 2048; Bt = (const bf16*)(ws + WS_RGIN + mi * RGIN_BYTES); }
        else if (blk < 8 * NB_FF + 2 * NB_RG + NB_HG) { rb = blk - 8 * NB_FF - 2 * NB_RG; j = 1 * 3 + 1; pitch = 4096; Bt = (const bf16*)(ws + WS_HGIN); }
        else { rb = blk - 8 * NB_FF - 2 * NB_RG - NB_HG; j = 2 * 3 + 1; pitch = GLA_INP; Bt = (const bf16*)(ws + WS_GLIN); }
        const int l = j / 3, s = j % 3, r = rb * 32 + (lane & 31);
        const bf16* Bp = Bt + (size_t)r * D + 8 * (lane >> 5);
        const float* Sp = MOD + ((size_t)l * BATCH + (lane & 31)) * (NMOD * D) + (3 * s) * D + 8 * (lane >> 5);
        f32x16 acc = {};
        for (int k0 = 0; k0 < D; k0 += 128) {
            bf16x8 bf[8]; f32x4 s0[8], s1[8];
#pragma unroll
            for (int i = 0; i < 8; ++i) { bf[i] = *(const bf16x8*)(Bp + k0 + 16 * i); s0[i] = *(const f32x4*)(Sp + k0 + 16 * i); s1[i] = *(const f32x4*)(Sp + k0 + 16 * i + 4); }
#pragma unroll
            for (int i = 0; i < 8; ++i) acc = __builtin_amdgcn_mfma_f32_32x32x16_bf16(__builtin_bit_cast(bf16x8, pg8::pack8(s0[i], s1[i])), bf[i], acc, 0, 0, 0);
        }
        const int w = r & 255, n = ffn ? ((w < 128) ? (r >> 8) * 128 + w : FF + (r >> 8) * 128 + (w - 128)) : r;
        float* B2 = (float*)(ws + WS_B2 + (size_t)j * B2_BYTES);
#pragma unroll
        for (int rr = 0; rr < 16; ++rr) { const int b = (rr & 3) + 8 * (rr >> 2) + 4 * (lane >> 5); B2[(size_t)b * pitch + n] = acc[rr]; }
    }
    const int gw2 = F.vcu * NWAVES + F.wave;
    bf16* H = (bf16*)(ws + WS_H); float* PS = (float*)(ws + WS_PS);
    for (int strip = gw2; strip < M / 32; strip += NGW) {
        const int b = (strip * 32) / SEQ;
        f32x4 gv[4];
#pragma unroll
        for (int jj = 0; jj < 4; ++jj) { const int col = 4 * lane + 256 * jj; gv[jj] = *(const f32x4*)(P.norm_w + col) * (1.0f + *(const f32x4*)(MOD + (size_t)b * (NMOD * D) + D + col)); }
        for (int rr = 0; rr < 32; ++rr) { const size_t row = (size_t)strip * 32 + rr;
            const GAS f32x4* xr = (const GAS f32x4*)(P.x + row * D) + lane;
            f32x4 v[4]; float sq = 0.f;
#pragma unroll
            for (int jj = 0; jj < 4; ++jj) { v[jj] = xr[64 * jj]; sq += (v[jj].x * v[jj].x + v[jj].y * v[jj].y) + (v[jj].z * v[jj].z + v[jj].w * v[jj].w); }
            sq = wave_sum(sq);
            GAS v2u* o8 = (GAS v2u*)(H + row * D) + lane;
#pragma unroll
            for (int jj = 0; jj < 4; ++jj) { const f32x4 o = v[jj] * gv[jj]; v2u w; w.x = pk2(o.x, o.y); w.y = pk2(o.z, o.w); o8[64 * jj] = w; }
            if (lane < 16) PS[row * 16 + lane] = lane == 0 ? sq : 0.f;
            { GAS v2u* x8 = (GAS v2u*)((_Float16*)(ws + WS_X16) + row * D) + lane;
#pragma unroll
              for (int jj = 0; jj < 4; ++jj) { v2u w; w.x = pkh2(v[jj].x, v[jj].y); w.y = pkh2(v[jj].z, v[jj].w); x8[64 * jj] = w; } }
        }
    }
}
__device__ __forceinline__ void final_norm_phase(Frame& F, const _Float16* x, const float* w, float* out) {
    int lane_ = lane_id(); asm volatile("" : "+v"(lane_)); const int lane = lane_;
    int gw_ = F.vcu * NWAVES + F.wave; asm volatile("" : "+s"(gw_)); const int gw = gw_, NGW = F.G * NWAVES;
    f32x4 gv[4];
#pragma unroll
    for (int j = 0; j < 4; ++j) gv[j] = *(const f32x4*)(w + 4 * lane + 256 * j);
    for (int strip = gw; strip < M / 32; strip += NGW) {
        for (int rr = 0; rr < 32; ++rr) { const size_t row = (size_t)strip * 32 + rr;
            const GAS v2u* xr = (const GAS v2u*)(x + row * D) + lane;
            f32x4 v[4]; float s = 0.f;
#pragma unroll
            for (int j = 0; j < 4; ++j) { const v2u h = xr[64 * j]; v[j] = unpk_h4(h); s += (v[j].x * v[j].x + v[j].y * v[j].y) + (v[j].z * v[j].z + v[j].w * v[j].w); }
            const float rstd = 1.0f / sqrtf(wave_sum(s) * (1.f / D) + EPS);
            GAS f32x4* o = (GAS f32x4*)(out + row * D) + lane;
#pragma unroll
            for (int j = 0; j < 4; ++j) o[64 * j] = v[j] * rstd * gv[j];
        }
    }
}
#define MFMA16(a, b, c) __builtin_amdgcn_mfma_f32_16x16x32_bf16((a), (b), (c), 0, 0, 0)
__device__ __forceinline__ bf16x8 ld_b128(const LAS unsigned char* p) { return *(const LAS bf16x8*)p; }
__device__ __forceinline__ bf16x8 ld_2xb64(const LAS unsigned char* p0, const LAS unsigned char* p1) { const v2u a = *(const LAS v2u*)p0, b = *(const LAS v2u*)p1; v4u w; w.x = a.x; w.y = a.y; w.z = b.x; w.w = b.y; return __builtin_bit_cast(bf16x8, w); }
__device__ __forceinline__ bf16x8 pack8f(const f32x4 a, const f32x4 b) { return __builtin_bit_cast(bf16x8, pg8::pack8(a, b)); }
#define LOG2E 1.4426950408889634f
#define LN2 0.6931471805599453f
__device__ __forceinline__ float fexp2(float x) { return __builtin_amdgcn_exp2f(x); }
__device__ __forceinline__ float frcp(float x) { return __builtin_amdgcn_rcpf(x); }
__device__ __forceinline__ float fsigm(float x) { return frcp(1.0f + fexp2(-LOG2E * x)); }
#ifndef DBG_R4
#define DBG_R4 4
#endif
typedef __amdgpu_buffer_rsrc_t rsrc_t;
__device__ __forceinline__ rsrc_t mk_rsrc(const void* p) { return __builtin_amdgcn_make_buffer_rsrc((void*)p, 0, 0x7fffffff, 0x00020000); }
__device__ __forceinline__ float bld_bf(rsrc_t r, unsigned voff, unsigned soff) { const unsigned w = __builtin_amdgcn_raw_buffer_load_b32(r, voff & ~3u, soff, 0); return __builtin_bit_cast(float, (voff & 2u) ? (w & 0xffff0000u) : (w << 16)); }
__device__ __forceinline__ unsigned bld_raw(rsrc_t r, unsigned voff, unsigned soff) { return __builtin_amdgcn_raw_buffer_load_b32(r, voff & ~3u, soff, 0); }
__device__ __forceinline__ float half_bf(unsigned w, unsigned voff) { return __builtin_bit_cast(float, (voff & 2u) ? (w & 0xffff0000u) : (w << 16)); }
__device__ __forceinline__ unsigned half_u16(unsigned w, unsigned voff) { return (voff & 2u) ? (w >> 16) : (w & 0xffffu); }
__device__ __forceinline__ unsigned short bld_u16(rsrc_t r, unsigned voff, unsigned soff) { const unsigned w = __builtin_amdgcn_raw_buffer_load_b32(r, voff & ~3u, soff, 0); return (unsigned short)((voff & 2u) ? (w >> 16) : (w & 0xffffu)); }
__device__ __forceinline__ float bld_f32(rsrc_t r, unsigned voff, unsigned soff) { return __builtin_bit_cast(float, __builtin_amdgcn_raw_buffer_load_b32(r, voff, soff, 0)); }
__device__ __forceinline__ v4u bld_b128(rsrc_t r, unsigned voff, unsigned soff) { return __builtin_amdgcn_raw_buffer_load_b128(r, voff, soff, 0); }
struct RgArgs { const bf16* Y; const bf16* XB; bf16* HY; const bf16* WgT; const float *gate_b, *lam, *conv_w, *conv_b; };
#define LDS_BARRIER() do { asm volatile("s_waitcnt lgkmcnt(0)" ::: "memory"); __builtin_amdgcn_s_barrier(); asm volatile("" ::: "memory"); } while (0)
#define WAVE_SYNC() asm volatile("" ::: "memory")
__device__ __forceinline__ void rg_scan_phase(Frame& F, const RgArgs A) {
    LAS unsigned char* L = F.lds;
    int tid_ = F.wave * 64 + lane_id(); asm volatile("" : "+v"(tid_));
    const int tid = tid_, lane = tid & 63, wave = F.wave, q = lane >> 4, l15 = lane & 15;
    const int cch = tid & 127, tg = wave >> 1, chl = 16 * wave + l15;
    typedef float f32x2v __attribute__((ext_vector_type(2)));
    LAS f32x2v* AU = (LAS f32x2v*)(L + 50176 + wave * 4608);
    LAS f32x2v* PH = (LAS f32x2v*)(L + 50176 + wave * 4608 + 4096);
    for (int unit = blockIdx.x; unit < BATCH * 8; unit += gridDim.x) {
        const int b = unit >> 3, hd = unit & 7, colbase = hd * 128; const size_t rowbase = (size_t)b * SEQ;
        const bf16* Wg = A.WgT + (size_t)hd * 256 * 128;
        bf16x8 Bx[4], Ba[4];
#pragma unroll
        for (int s = 0; s < 4; ++s) { Bx[s] = *(const bf16x8*)(Wg + (size_t)chl * 128 + 32 * s + 8 * q); Ba[s] = *(const bf16x8*)(Wg + (size_t)(128 + chl) * 128 + 32 * s + 8 * q); }
        const float bx = A.gate_b[hd * 256 + chl], ba = A.gate_b[hd * 256 + 128 + chl];
        const float lamv = A.lam[colbase + chl]; const float sp8 = 8.0f * (fmaxf(-lamv, 0.f) + log1pf(expf(-fabsf(lamv))));
        const float cw0 = A.conv_w[colbase + cch], cw1 = A.conv_w[D + colbase + cch], cw2 = A.conv_w[2 * D + colbase + cch], cw3 = A.conv_w[3 * D + colbase + cch], cb = A.conv_b[colbase + cch];
        float h = 0.f;
        const rsrc_t rxb = mk_rsrc(A.XB + rowbase * D + colbase), ry = mk_rsrc(A.Y + rowbase * D + colbase), rhy = mk_rsrc(A.HY + rowbase * D + colbase);
        const unsigned vo = (unsigned)(8 * tg * D + cch) * 2u;
        const unsigned voy = (unsigned)(8 * q * D + chl) * 2u;
        unsigned xw[11], yw[8];
#pragma unroll
        for (int i = 0; i < 11; ++i) { const int t = 8 * tg - 3 + i; const unsigned w = bld_raw(rxb, (unsigned)cch * 2u, (unsigned)(t < 0 ? 0 : t) * 2048u); xw[i] = t >= 0 ? w : 0u; }
#pragma unroll
        for (int i = 0; i < 8; ++i) yw[i] = bld_raw(ry, voy, (unsigned)i * 2048u);
        for (int step = 0; step < SEQ / 32; ++step) {
            const int t0 = step * 32;
            LAS float* XC = (LAS float*)(L + (step & 1) * 25088); LAS unsigned char* XCB = L + (step & 1) * 25088 + 16384;
            float xb[11], yv[8];
#pragma unroll
            for (int i = 0; i < 11; ++i) xb[i] = half_bf(xw[i], (unsigned)cch * 2u);
#pragma unroll
            for (int i = 0; i < 8; ++i) yv[i] = half_bf(yw[i], voy);
#pragma unroll
            for (int i = 0; i < 8; ++i) { const float xc = cb + cw0 * xb[i] + cw1 * xb[i + 1] + cw2 * xb[i + 2] + cw3 * xb[i + 3];
                XC[(8 * tg + i) * 128 + cch] = xc; *(LAS unsigned short*)(XCB + (8 * tg + i) * 272 + cch * 2) = (unsigned short)f2bf(xc); }
            if (step + 1 < SEQ / 32) {
#pragma unroll
                for (int i = 0; i < 11; ++i) xw[i] = bld_raw(rxb, vo, (unsigned)(t0 + 32 - 3 + i) * 2048u);
#pragma unroll
                for (int i = 0; i < 8; ++i) yw[i] = bld_raw(ry, voy, (unsigned)(t0 + 32 + i) * 2048u);
            }
            LDS_BARRIER();
            f32x4 ax[2], aa[2];
#pragma unroll
            for (int tb = 0; tb < 2; ++tb) { ax[tb] = (f32x4){0.f, 0.f, 0.f, 0.f}; aa[tb] = (f32x4){0.f, 0.f, 0.f, 0.f};
#pragma unroll
                for (int s = 0; s < 4; ++s) { const bf16x8 a = ld_b128(XCB + (16 * tb + l15) * 272 + 64 * s + 16 * q); ax[tb] = MFMA16(a, Bx[s], ax[tb]); aa[tb] = MFMA16(a, Ba[s], aa[tb]); } }
#pragma unroll
            for (int tb = 0; tb < 2; ++tb)
#pragma unroll
                for (int r = 0; r < 4; ++r) { const int t = 16 * tb + 4 * q + r;
                    const float gx = ax[tb][r] + bx, ga = aa[tb][r] + ba;
                    const float la = -fsigm(ga) * sp8; const float a = fexp2(LOG2E * la);
                    const float x2 = 2.0f * la;
                    const float ser = -x2 * (1.0f + x2 * (0.5f + x2 * (0.16666667f + x2 * (0.041666668f + x2 * 0.008333334f))));
                    float m2 = x2 > -0.25f ? ser : 1.0f - a * a; float mult = __builtin_amdgcn_sqrtf(m2); if (t0 + t == 0) mult = 1.0f;
                    AU[t * 16 + l15] = (f32x2v){a, fsigm(gx) * XC[t * 128 + chl] * mult}; }
            WAVE_SYNC();
            float av[8], uv[8]; float P = 1.0f, Hl = 0.f;
#pragma unroll
            for (int i = 0; i < 8; ++i) { const f32x2v au = AU[(8 * q + i) * 16 + l15]; av[i] = au.x; uv[i] = au.y; Hl = av[i] * Hl + uv[i]; P *= av[i]; }
            PH[q * 16 + l15] = (f32x2v){P, Hl};
            WAVE_SYNC();
            { const f32x2v m0 = PH[l15], m1 = PH[16 + l15], m2_ = PH[32 + l15], m3 = PH[48 + l15];
                const float c1 = m0.x * h + m0.y, c2 = m1.x * c1 + m1.y, c3 = m2_.x * c2 + m2_.y, c4 = m3.x * c3 + m3.y;
                float hh = q == 0 ? h : (q == 1 ? c1 : (q == 2 ? c2 : c3)); h = c4;
#pragma unroll
                for (int i = 0; i < 8; ++i) { hh = av[i] * hh + uv[i]; __builtin_amdgcn_raw_buffer_store_b16((unsigned short)f2bf(hh * yv[i]), rhy, voy, (unsigned)(t0 + i) * 2048u, 0); } }
            WAVE_SYNC();
        }
        __syncthreads();
    }
}
struct GlaArgs { const bf16* Q; const bf16* K; const _Float16* LOGF; const bf16* V; const bf16* G; const float* ALOW; const float *w2, *gb, *nw; bf16* OUT; float* SS; };
template <int DV, bool GLA>
__device__ __forceinline__ void gla_scan_phase(Frame& F, const GlaArgs A) {
    constexpr int NH = GLA ? 4 : 8, NCB = DV / 128, QLD = GLA ? 512 : 1024, NV = DV / 16, VTG = 512 / DV  , VTOK = 32 / VTG;
    LAS unsigned char* L = F.lds;
    LAS unsigned char* QT = L;
    LAS unsigned char* KT = L + 8704;
    LAS unsigned char* KHT = L + 17408;
    LAS unsigned char* VT = L + 27648;
    LAS float* DEC = (LAS float*)(L + 48128);
    LAS float* GT = (LAS float*)(L + 48640);
    LAS float* OB = (LAS float*)(L + 50688);
    LAS float* ALS = (LAS float*)(L + 83456);
    LAS float* NWL = (LAS float*)(L + 87552);
    int tid_ = F.wave * 64 + lane_id(); asm volatile("" : "+v"(tid_));
    const int tid = tid_, lane = tid & 63, wave = F.wave, q = lane >> 4, l15 = lane & 15;
    const int kc = tid & 127, tg = wave >> 1, vdv = tid & (DV - 1), vtg = wave / (DV / 64), ot = tid >> 4, oc = tid & 15;
    for (int unit = blockIdx.x; unit < BATCH * NH; unit += gridDim.x) {
        const int b = unit / NH, hd = unit % NH; const size_t rowbase = (size_t)b * SEQ;
        f32x4 S[NCB][8];
#pragma unroll
        for (int cb = 0; cb < NCB; ++cb)
#pragma unroll
            for (int kt = 0; kt < 8; ++kt) S[cb][kt] = (f32x4){0.f, 0.f, 0.f, 0.f};
        const rsrc_t rq = mk_rsrc(A.Q + rowbase * QLD + hd * 128), rk = mk_rsrc(GLA ? (const void*)(A.K + rowbase * QLD + hd * 128) : (const void*)(A.LOGF + rowbase * D + hd * 128));
        const rsrc_t rv = mk_rsrc(A.V + rowbase * D + hd * DV), rg = mk_rsrc(A.G + rowbase * D + hd * DV), ro = mk_rsrc(A.OUT + rowbase * D + hd * DV), ral = mk_rsrc(GLA ? A.ALOW + rowbase * 16 : nullptr);
        const unsigned voq = (unsigned)(8 * tg * QLD + kc) * 2u, vok = GLA ? voq : (unsigned)(8 * tg * D + kc) * 2u, vov = (unsigned)(VTOK * vtg * D + vdv) * 2u, vog = (unsigned)(ot * D + oc * NV) * 2u;
        constexpr unsigned QST = QLD * 2u, KST = GLA ? QLD * 2u : D * 2u, VST = D * 2u;
        float w2r[16]; float gbv = 0.f;
        if (GLA) {
#pragma unroll
            for (int r = 0; r < 16; ++r) w2r[r] = A.w2[r * 512 + hd * 128 + kc];
            gbv = A.gb[hd * 128 + kc]; }
        if (tid < DV) NWL[tid] = A.nw[(GLA ? 0 : hd * 128) + tid];
        unsigned qw[8], kw[8], vw[VTOK]; float alv = 0.f; v4u gg[NV / 8], ggn[NV / 8];
#pragma unroll
        for (int i = 0; i < 8; ++i) { qw[i] = bld_raw(rq, voq, (unsigned)i * QST); kw[i] = bld_raw(rk, vok, (unsigned)i * KST); }
#pragma unroll
        for (int i = 0; i < VTOK; ++i) vw[i] = bld_raw(rv, vov, (unsigned)i * VST);
#pragma unroll
        for (int e = 0; e < NV / 8; ++e) gg[e] = bld_b128(rg, vog + 16u * e, 0u);
        if (GLA) { ALS[tid] = bld_f32(ral, (unsigned)tid * 4u, 0u); alv = bld_f32(ral, (unsigned)tid * 4u, 32u * 64u); }
        __syncthreads();
        for (int n = 0; n < SEQ / 32; ++n) {
            const unsigned r0 = (unsigned)n * 32u;
            float qv[8], kv[8]; unsigned vv[VTOK];
#pragma unroll
            for (int i = 0; i < 8; ++i) { qv[i] = half_bf(qw[i], voq); kv[i] = GLA ? half_bf(kw[i], vok) : (float)__builtin_bit_cast(_Float16, (unsigned short)half_u16(kw[i], vok)); }
#pragma unroll
            for (int i = 0; i < VTOK; ++i) vv[i] = half_u16(vw[i], vov);
            if (n + 1 < SEQ / 32) { const unsigned rn = r0 + 32u;
#pragma unroll
                for (int i = 0; i < 8; ++i) { qw[i] = bld_raw(rq, voq, (rn + i) * QST); kw[i] = bld_raw(rk, vok, (rn + i) * KST); }
#pragma unroll
                for (int i = 0; i < VTOK; ++i) vw[i] = bld_raw(rv, vov, (rn + i) * VST);
#pragma unroll
                for (int e = 0; e < NV / 8; ++e) ggn[e] = bld_b128(rg, vog + 16u * e, rn * VST); }
            float bl[8], kt_[8];
            { float c = 0.f;
#pragma unroll
                for (int i = 0; i < 8; ++i) { float g2;
                    if (GLA) { const LAS float* al = ALS + (n & 1) * 512 + (8 * tg + i) * 16; float z = gbv;
#pragma unroll
                        for (int r4 = 0; r4 < 4; ++r4) { const f32x4 a4 = *(const LAS f32x4*)(al + 4 * r4); z += a4[0] * w2r[4 * r4] + a4[1] * w2r[4 * r4 + 1] + a4[2] * w2r[4 * r4 + 2] + a4[3] * w2r[4 * r4 + 3]; }
                        g2 = (fminf(z, 0.f) * LOG2E - __builtin_amdgcn_logf(1.0f + fexp2(-LOG2E * fabsf(z)))) * (1.0f / 16.0f); kt_[i] = kv[i]; }
                    else { g2 = kv[i] * LOG2E; kt_[i] = 1.0f - fexp2(g2); }
                    c += g2; bl[i] = c; }
                GT[tg * 128 + kc] = c; }
            LDS_BARRIER();
            { const float g0 = GT[kc], g1 = GT[128 + kc], g2 = GT[256 + kc], g3 = GT[384 + kc];
                const float off = (tg > 0 ? g0 : 0.f) + (tg > 1 ? g1 : 0.f) + (tg > 2 ? g2 : 0.f), tot = (g0 + g1) + (g2 + g3);
                const float qs = GLA ? 0.08838834764831845f : 1.0f, etot = fexp2(tot);
                float kh[8];
#pragma unroll
                for (int i = 0; i < 8; ++i) { const float bb = bl[i] + off; const int t = 8 * tg + i; const float e1 = fexp2(bb), e2 = frcp(e1);
                    *(LAS unsigned short*)(QT + t * 272 + kc * 2) = (unsigned short)f2bf(qv[i] * qs * e1);
                    const float k2 = kt_[i] * e2;
                    *(LAS unsigned short*)(KT + t * 272 + kc * 2) = (unsigned short)f2bf(k2);
                    kh[i] = k2 * etot; }
                v4u w; w.x = pk2(kh[0], kh[1]); w.y = pk2(kh[2], kh[3]); w.z = pk2(kh[4], kh[5]); w.w = pk2(kh[6], kh[7]);
                *(LAS v4u*)(KHT + kc * 80 + 16 * tg) = w;
                if (tg == 0) DEC[kc] = etot; }
#pragma unroll
            for (int i8 = 0; i8 < VTOK / 8; ++i8) { v4u w; w.x = vv[8 * i8] | (vv[8 * i8 + 1] << 16); w.y = vv[8 * i8 + 2] | (vv[8 * i8 + 3] << 16); w.z = vv[8 * i8 + 4] | (vv[8 * i8 + 5] << 16); w.w = vv[8 * i8 + 6] | (vv[8 * i8 + 7] << 16);
                *(LAS v4u*)(VT + vdv * 80 + (VTOK * vtg + 8 * i8) * 2) = w; }
            LDS_BARRIER();
            if (GLA) { ALS[((n + 1) & 1) * 512 + tid] = alv; if (n + 2 < SEQ / 32) alv = bld_f32(ral, (unsigned)tid * 4u, (r0 + 64u) * 64u); }
            f32x4 P00 = {0.f, 0.f, 0.f, 0.f}, P01 = P00, P11 = P00;
#pragma unroll
            for (int s = 0; s < 4; ++s) { const bf16x8 KA0 = ld_b128(KT + l15 * 272 + 64 * s + 16 * q), KA1 = ld_b128(KT + (16 + l15) * 272 + 64 * s + 16 * q);
                const bf16x8 QB0 = ld_b128(QT + l15 * 272 + 64 * s + 16 * q), QB1 = ld_b128(QT + (16 + l15) * 272 + 64 * s + 16 * q);
                P00 = MFMA16(KA0, QB0, P00); P01 = MFMA16(KA0, QB1, P01); P11 = MFMA16(KA1, QB1, P11); }
#pragma unroll
            for (int r = 0; r < 4; ++r) if (l15 < 4 * q + r) { P00[r] = 0.f; P11[r] = 0.f; }
            const bf16x8 PA0 = pack8f(P00, (f32x4){0.f, 0.f, 0.f, 0.f}), PA1 = pack8f(P01, P11);
            bf16x8 VB[NCB];
#pragma unroll
            for (int cb = 0; cb < NCB; ++cb) { const LAS unsigned char* vr = VT + (16 * (wave * NCB + cb) + l15) * 80 + 8 * q; VB[cb] = ld_2xb64(vr, vr + 32); }
            f32x4 O[NCB][2];
#pragma unroll
            for (int cb = 0; cb < NCB; ++cb)
#pragma unroll
                for (int tb = 0; tb < 2; ++tb) O[cb][tb] = (f32x4){0.f, 0.f, 0.f, 0.f};
#pragma unroll
            for (int s = 0; s < 4; ++s) {
                bf16x8 QA[2];
#pragma unroll
                for (int tb = 0; tb < 2; ++tb) { const LAS unsigned char* qr = QT + (16 * tb + l15) * 272 + 64 * s + 8 * q; QA[tb] = ld_2xb64(qr, qr + 32); }
#pragma unroll
                for (int cb = 0; cb < NCB; ++cb) { const bf16x8 SB = pack8f(S[cb][2 * s], S[cb][2 * s + 1]);
                    O[cb][0] = MFMA16(QA[0], SB, O[cb][0]); O[cb][1] = MFMA16(QA[1], SB, O[cb][1]); } }
#pragma unroll
            for (int cb = 0; cb < NCB; ++cb) { O[cb][0] = MFMA16(PA0, VB[cb], O[cb][0]); O[cb][1] = MFMA16(PA1, VB[cb], O[cb][1]); }
#pragma unroll
            for (int kt = 0; kt < 8; ++kt) { const f32x4 dec = *(const LAS f32x4*)(DEC + 16 * kt + 4 * q);
                const LAS unsigned char* kr = KHT + (16 * kt + l15) * 80 + 8 * q; const bf16x8 KH = ld_2xb64(kr, kr + 32);
#pragma unroll
                for (int cb = 0; cb < NCB; ++cb) S[cb][kt] = MFMA16(KH, VB[cb], S[cb][kt] * dec); }
#pragma unroll
            for (int cb = 0; cb < NCB; ++cb)
#pragma unroll
                for (int tb = 0; tb < 2; ++tb)
#pragma unroll
                    for (int r = 0; r < 4; ++r) OB[(16 * tb + 4 * q + r) * DV + 16 * (wave * NCB + cb) + l15] = O[cb][tb][r];
#ifdef DBG_TRIVIAL
#pragma unroll
            for (int cb = 0; cb < NCB; ++cb)
#pragma unroll
                for (int tb = 0; tb < 2; ++tb)
#pragma unroll
                    for (int r = 0; r < 4; ++r) { const int t = 16 * tb + 4 * q + r, dv = 16 * (wave * NCB + cb) + l15;
                        float vsum = 0.f; if (DBG_TRIVIAL & 1) vsum += bf2f(*(const LAS unsigned short*)(VT + dv * 80 + t * 2)); if (DBG_TRIVIAL & 2) vsum += bf2f(*(const LAS unsigned short*)(QT + t * 272 + (dv & 127) * 2)); if (DBG_TRIVIAL & 4) vsum += bf2f(*(const LAS unsigned short*)(KHT + (dv & 127) * 80 + t * 2)); if (DBG_TRIVIAL & 8) vsum += 1.0f + 0.001f * (float)(t + dv);
                        OB[t * DV + dv] = vsum; }
#endif
            LDS_BARRIER();
            { float o[NV]; float ss = 0.f;
#pragma unroll
                for (int e4 = 0; e4 < NV / 4; ++e4) { const f32x4 v = *(const LAS f32x4*)(OB + ot * DV + oc * NV + 4 * e4); o[4 * e4] = v[0]; o[4 * e4 + 1] = v[1]; o[4 * e4 + 2] = v[2]; o[4 * e4 + 3] = v[3]; ss += (v[0] * v[0] + v[1] * v[1]) + (v[2] * v[2] + v[3] * v[3]); }
                ss += __shfl_xor(ss, 1); ss += __shfl_xor(ss, 2); ss += __shfl_xor(ss, 4); ss += __shfl_xor(ss, 8);
                float rs = 1.0f;
                if (GLA) rs = 1.0f / sqrtf(ss * (1.0f / DV) + EPS); else if (oc == 0) A.SS[(rowbase + r0 + ot) * 8 + hd] = ss;
#pragma unroll
                for (int e8 = 0; e8 < NV / 8; ++e8) { const v4u gw_ = gg[e8]; float gf[8]; float nwr[NV];
                    { const f32x4 n0 = *(const LAS f32x4*)(NWL + oc * NV + 8 * e8), n1 = *(const LAS f32x4*)(NWL + oc * NV + 8 * e8 + 4); nwr[8 * e8] = n0[0]; nwr[8 * e8 + 1] = n0[1]; nwr[8 * e8 + 2] = n0[2]; nwr[8 * e8 + 3] = n0[3]; nwr[8 * e8 + 4] = n1[0]; nwr[8 * e8 + 5] = n1[1]; nwr[8 * e8 + 6] = n1[2]; nwr[8 * e8 + 7] = n1[3]; }
                    gf[0] = bf2f(gw_.x & 0xffffu); gf[1] = bf2f(gw_.x >> 16); gf[2] = bf2f(gw_.y & 0xffffu); gf[3] = bf2f(gw_.y >> 16); gf[4] = bf2f(gw_.z & 0xffffu); gf[5] = bf2f(gw_.z >> 16); gf[6] = bf2f(gw_.w & 0xffffu); gf[7] = bf2f(gw_.w >> 16);
                    v4u w; w.x = pk2(o[8 * e8] * rs * nwr[8 * e8] * gf[0], o[8 * e8 + 1] * rs * nwr[8 * e8 + 1] * gf[1]); w.y = pk2(o[8 * e8 + 2] * rs * nwr[8 * e8 + 2] * gf[2], o[8 * e8 + 3] * rs * nwr[8 * e8 + 3] * gf[3]);
                    w.z = pk2(o[8 * e8 + 4] * rs * nwr[8 * e8 + 4] * gf[4], o[8 * e8 + 5] * rs * nwr[8 * e8 + 5] * gf[5]); w.w = pk2(o[8 * e8 + 6] * rs * nwr[8 * e8 + 6] * gf[6], o[8 * e8 + 7] * rs * nwr[8 * e8 + 7] * gf[7]);
                    __builtin_amdgcn_raw_buffer_store_b128(w, ro, vog + 16u * e8, r0 * VST, 0); gg[e8] = ggn[e8]; } }
        }
        __syncthreads();
    }
}
constexpr int NPH = 2 + DEPTH * 7 + 1;
struct Args { const float* in[24]; float* out; unsigned char* ws; int ph_lo, ph_hi; };
#define AS4 __attribute__((address_space(4)))
#define KARG() ({ const AS4 Args* _p = (const AS4 Args*)__builtin_amdgcn_kernarg_segment_ptr(); asm volatile("" : "+s"(_p)); _p; })
#define KIN(i) ((const float*)KARG()->in[i])
#define KWS() ((unsigned char*)KARG()->ws)
__global__ void __launch_bounds__(NWAVES * 64, 2) mk_fwd(Args args_unused) {
    extern __shared__ __attribute__((aligned(16))) unsigned char lds[];
    Frame F;
    F.lds = (LAS unsigned char*)lds;
    F.MISC = (volatile LAS unsigned*)(F.lds + MISC_OFF);
    F.wave = __builtin_amdgcn_readfirstlane((int)threadIdx.x >> 6);
    F.G = gridDim.x; { const int bx = blockIdx.x; F.vcu = (F.G % 8 == 0) ? (bx % 8) * (F.G / 8) + bx / 8 : bx; }
    F.ctl = (gu32*)(KWS() + WS_CTL);
    for (int u = threadIdx.x; u < (LDS_BYTES - LDSCTL_OFF) / 4; u += NWAVES * 64) ((LAS unsigned*)(F.lds + LDSCTL_OFF))[u] = 0u;
    __syncthreads();
    XcdBarrier bar = xcd_barrier_post((unsigned*)(F.ctl + CW_BAR), F.MISC + 8); bar.wave = F.wave;
#ifdef PROBE_CLK
#define PB(kind) do { if ((kind) == PROBE_CLK && blockIdx.x == 0 && F.wave == 0 && lane_id() == 0) { volatile unsigned long long* tp_ = (volatile unsigned long long*)(KWS() + 512 * 1024); tp_[0] = __builtin_amdgcn_s_memrealtime(); tp_[2] = __builtin_amdgcn_s_memtime(); } } while (0)
#define PE(kind) do { if ((kind) == PROBE_CLK && blockIdx.x == 0 && F.wave == 0 && lane_id() == 0) { volatile unsigned long long* tp_ = (volatile unsigned long long*)(KWS() + 512 * 1024); tp_[3] = tp_[3] + (__builtin_amdgcn_s_memtime() - tp_[2]); tp_[4] = tp_[4] + (__builtin_amdgcn_s_memrealtime() - tp_[0]); tp_[1] = 100ull * 100ull * tp_[3] / tp_[4]; } } while (0)
#define PROBE_MUL 1
#elif defined(PROBE_KIND)
#define PB(kind) do { if (((1 << (kind)) & PROBE_KIND) && blockIdx.x == 0 && F.wave == 0 && lane_id() == 0) { volatile unsigned long long* tp_ = (volatile unsigned long long*)(KWS() + 512 * 1024); tp_[0] = __builtin_amdgcn_s_memrealtime(); } } while (0)
#define PE(kind) do { if (((1 << (kind)) & PROBE_KIND) && blockIdx.x == 0 && F.wave == 0 && lane_id() == 0) { volatile unsigned long long* tp_ = (volatile unsigned long long*)(KWS() + 512 * 1024); tp_[1] = tp_[1] + (__builtin_amdgcn_s_memrealtime() - tp_[0]); } } while (0)
#else
#define PB(kind) do {} while (0)
#define PE(kind) do {} while (0)
#endif
#if MK_N_LAUNCHES == 1
#define RUN() true
#define SEAM() xcd_barrier(bar)
#else
    int pi = 0;
#define RUN() (KARG()->ph_lo == pi)
#define SEAM() (++pi)
#endif
    PB(0);
    if (RUN()) { const AS4 Args* a = KARG(); ProIn P{a->in[1], a->in[2], a->in[3], a->in[6], a->in[7], a->in[8], a->in[11], a->in[14], a->in[15], a->in[16], a->in[18], a->in[19], a->in[23]};
        p0_prologue(F, P, KWS()); }
    SEAM(); PE(0); PB(10);
    if (RUN()) { const AS4 Args* a = KARG(); Pro2In P{a->in[0], a->in[4]};
        p1_prologue(F, P, KWS()); }
    SEAM(); PE(10);
    for (int l = 0; l < DEPTH; ++l) {
        for (int s = 0; s < 3; ++s) {
            PB(s != 1 ? 2 : 4);
            if (RUN()) { unsigned char* ws = KWS(); unsigned char* SCR = ws + WS_SCR; const int mx = l % 3, mi = l / 3;
                const size_t ainoff = s == 2 ? WS_SCR : WS_H; const bf16* Ain = (const bf16*)(ws + ainoff);
                const pg8::RowScale R{(const float*)(ws + WS_PS), (LAS float*)(F.lds + LDSCTL_OFF + 2048)}; const float* b2 = (const float*)(ws + WS_B2 + (size_t)(l * 3 + s) * B2_BYTES);
                if (s != 1) { const int fi = l * 2 + (s >> 1);
                    pg8::Gemm g{Ain, (const bf16*)(ws + WS_W13 + fi * W13_BYTES), M, 2 * FF, D}; pg8::StaticOrder S; S.init(M, 2 * FF, F.G, (int)blockIdx.x);
                    pg8::EpiSwiglu E{ws, (bf16*)(SCR + ACT_BYTES), FF, R, b2};
                    pg8::gemm_phase<pg8::EpiSwiglu, pg8::StaticOrder, true, true>(F.lds, g, S, E, F.wave);
                }
                else if (mx == 0) {
                    pg8::Gemm g{Ain, (const bf16*)(ws + WS_RGIN + mi * RGIN_BYTES), M, 2048, D}; pg8::StaticOrder S; S.init(M, 2048, F.G, (int)blockIdx.x);
                    pg8::EpiRgIn E{ws, (bf16*)SCR, R, b2};
                    pg8::gemm_phase<pg8::EpiRgIn, pg8::StaticOrder, true, true>(F.lds, g, S, E, F.wave);
                } else if (mx == 1) {
                    pg8::Gemm g{Ain, (const bf16*)(ws + WS_HGIN), M, 4096, D}; pg8::StaticOrder S; S.init(M, 4096, F.G, (int)blockIdx.x);
                    pg8::EpiHgIn E{ws, (bf16*)SCR, (_Float16*)(SCR + 3 * ACT_BYTES), (const float*)(ws + WS_LB), R, b2};
                    pg8::gemm_phase<pg8::EpiHgIn, pg8::StaticOrder, true, true>(F.lds, g, S, E, F.wave);
                } else {
                    pg8::Gemm g{Ain, (const bf16*)(ws + WS_GLIN), M, GLA_INP, D}; pg8::StaticOrder S; S.init(M, GLA_INP, F.G, (int)blockIdx.x);
                    pg8::EpiGlIn E{ws, (bf16*)SCR, (float*)(SCR + 3 * ACT_BYTES), R, b2};
                    pg8::gemm_phase<pg8::EpiGlIn, pg8::StaticOrder, true, true>(F.lds, g, S, E, F.wave);
                }
            }
            SEAM(); PE(s != 1 ? 2 : 4);
            if (s == 1) {
                PB(5 + l % 3);
                if (RUN()) {
                    unsigned char* ws = KWS(); bf16* H = (bf16*)(ws + WS_H); unsigned char* SCR = ws + WS_SCR; const int mx = l % 3, mi = l / 3;
                    if (mx == 0) { RgArgs A{(const bf16*)SCR, (const bf16*)(SCR + ACT_BYTES), H, (const bf16*)(ws + WS_RGG + mi * RGG_BYTES), KIN(12) + (size_t)mi * 8 * 256, KIN(13) + (size_t)mi * D, KIN(9) + (size_t)mi * 4 * D, KIN(10) + (size_t)mi * D};
                        rg_scan_phase(F, A); }
                    else if (mx == 1) { GlaArgs A{(const bf16*)SCR, nullptr, (const _Float16*)(SCR + 3 * ACT_BYTES), (const bf16*)(SCR + ACT_BYTES), (const bf16*)(SCR + 2 * ACT_BYTES), nullptr, nullptr, nullptr, KIN(17), H, (float*)(ws + WS_SS)};
                        gla_scan_phase<128, false>(F, A); }
                    else { GlaArgs A{(const bf16*)SCR, (const bf16*)(SCR + ACT_BYTES / 2), nullptr, (const bf16*)(SCR + ACT_BYTES), (const bf16*)(SCR + 2 * ACT_BYTES), (const float*)(SCR + 3 * ACT_BYTES), KIN(20), KIN(21), KIN(22), H, nullptr};
                        gla_scan_phase<256, true>(F, A); }
                }
                SEAM(); PE(5 + l % 3);
            }
            PB(s != 1 ? 3 : 8);
            if (RUN()) { unsigned char* ws = KWS(); const int mx = l % 3, mi = l / 3;
                const _Float16* xcur = (const _Float16*)(ws + WS_X16);
                const float* modl = (const float*)(ws + WS_MOD) + (size_t)l * BATCH * (NMOD * D);
                const bf16* Ap; const bf16* Bp; int K; float fac; const float* ssp = nullptr;
                if (s != 1) { Ap = (const bf16*)(ws + WS_SCR + ACT_BYTES); Bp = (const bf16*)(ws + WS_W2 + (l * 2 + (s >> 1)) * W2_BYTES); K = FF; fac = 0.5f; }
                else { Ap = (const bf16*)(ws + WS_H); K = D; fac = 1.0f;
                    if (mx == 0) Bp = (const bf16*)(ws + WS_RGOUT + mi * SQ_BYTES); else if (mx == 1) { Bp = (const bf16*)(ws + WS_HGOUT); ssp = (const float*)(ws + WS_SS); } else Bp = (const bf16*)(ws + WS_GLOUT); }
                const bool last = (l == DEPTH - 1 && s == 2); const int ln = s == 2 ? l + 1 : l, sn = s == 2 ? 0 : s + 1;
                const size_t anoff = s == 1 ? WS_SCR : WS_H; bf16* An = (bf16*)(ws + anoff); if (last) An = nullptr;
                const float* nwn = KIN(4) + ((size_t)(last ? 0 : ln) * 3 + sn) * D;
                const float* scn = (const float*)(ws + WS_MOD) + (size_t)(last ? 0 : ln) * BATCH * (NMOD * D) + (3 * sn + 1) * D;
                pg8::Gemm g{Ap, Bp, M, D, K}; pg8::StaticOrder S; S.init(M, D, F.G, (int)blockIdx.x, 1);
                { LAS pg8::EpiResidParams* pp = (LAS pg8::EpiResidParams*)(F.lds + LDSCTL_OFF + 1024);
                  int cs_ = NMOD * D; asm volatile("" : "+s"(ssp), "+s"(An), "+s"(nwn), "+s"(scn), "+s"(xcur), "+s"(cs_), "+s"(fac));
                  if (F.wave == 0 && lane_id() == 0) { pp->base = xcur; pp->out = (_Float16*)(ws + WS_X16); pp->coef = modl + (3 * s + 2) * D; pp->ss = ssp; pp->An = An; pp->nwn = nwn; pp->scn = scn; pp->PS = (float*)(ws + WS_PS); pp->cstride = cs_; pp->fac = fac; }
                  __syncthreads(); }
                pg8::EpiResid E{ws, (const LAS unsigned*)(F.lds + LDSCTL_OFF + 1024), (LAS float*)(F.lds + LDSCTL_OFF + 4096)};
                pg8::gemm_phase<pg8::EpiResid, pg8::StaticOrder, true, true>(F.lds, g, S, E, F.wave);
            }
            SEAM(); PE(s != 1 ? 3 : 8);
        }
    }
    PB(9);
    if (RUN()) { final_norm_phase(F, (const _Float16*)(KWS() + WS_X16), KIN(5), KARG()->out); }
    PE(9);
#if defined(PROBE_KIND) || defined(PROBE_EPI) || defined(PROBE_CLK)
    if (blockIdx.x == 0 && F.wave == 0 && lane_id() == 0) { volatile unsigned long long* tp_ = (volatile unsigned long long*)(KWS() + 512 * 1024); const unsigned long long want = tp_[1] * PROBE_MUL, t0_ = __builtin_amdgcn_s_memrealtime();
        while (__builtin_amdgcn_s_memrealtime() - t0_ < want) __builtin_amdgcn_s_sleep(8); }
#endif
#undef RUN
#undef SEAM
}

extern "C" void kernel_launch(void* const* d_in, const int* in_sizes, int n_in, void* d_out, int out_size, void* d_ws, size_t ws_size, hipStream_t stream) {
    static int grid = 0;
    if (grid == 0) {
        if (n_in != 24 || in_sizes[0] != M * D || out_size != M * D || ws_size < WS_END) { fprintf(stderr, "kernel_launch: unexpected shapes (n_in %d, in0 %d, out %d, ws %zu < %zu); nothing launched\n", n_in, n_in > 0 ? in_sizes[0] : -1, out_size, ws_size, (size_t)WS_END); grid = -1; return; }
        int dev = 0, cus = 0, per_cu = 0;
        if (hipGetDevice(&dev) != hipSuccess || hipDeviceGetAttribute(&cus, hipDeviceAttributeMultiprocessorCount, dev) != hipSuccess) { grid = -1; return; }
        if (hipFuncSetAttribute((const void*)mk_fwd, hipFuncAttributeMaxDynamicSharedMemorySize, LDS_BYTES) != hipSuccess) { fprintf(stderr, "kernel_launch: hipFuncSetAttribute failed\n"); grid = -1; return; }
        if (hipOccupancyMaxActiveBlocksPerMultiprocessor(&per_cu, (const void*)mk_fwd, NWAVES * 64, LDS_BYTES) != hipSuccess || per_cu < 1)
            fprintf(stderr, "kernel_launch: note: occupancy query reports %d workgroups per CU\n", per_cu);
        (void)hipGetLastError();
        grid = cus;
    }
    if (grid < 0) return;
    if (hipMemsetAsync((char*)d_ws + WS_CTL, 0, CTL_ZERO_BYTES, stream) != hipSuccess) return;
    Args a{};
    for (int i = 0; i < 24; ++i) a.in[i] = (const float*)d_in[i];
    a.out = (float*)d_out; a.ws = (unsigned char*)d_ws;
#if MK_N_LAUNCHES == 1
    a.ph_lo = 0; a.ph_hi = NPH;
    hipLaunchKernelGGL(mk_fwd, dim3(grid), dim3(NWAVES * 64), LDS_BYTES, stream, a);
#else
    for (int p = 0; p < NPH; ++p) { a.ph_lo = p; a.ph_hi = p + 1; hipLaunchKernelGGL(mk_fwd, dim3(grid), dim3(NWAVES * 64), LDS_BYTES, stream, a); }
#endif
}
```
